# Optimizing an MI355X kernel written in HIP

```python
import math
import jax, jax.numpy as jnp
from jax import lax
import numpy as np

D_MODEL = 1024
BATCH = 4
SEQ = 8192
DEPTH = 4

CHUNK = 64
N_HEADS = 8
HEAD_DIM = 64
ATTN_W = N_HEADS * HEAD_DIM
KV_DIM = HEAD_DIM
IDX_HEADS = 4
IDX_DIM = 64
TOPK_MAX = 256
Q_BLOCK = 128
SSM_W = D_MODEL - ATTN_W
SSM_GROUP = 16
SSM_GROUPS = SSM_W // SSM_GROUP
SSM_STATE = 64
SCAN_BLOCK = 128
DT_MIN = 1e-3
DT_MAX = 1e-1
ROPE_THETA = 500000.0
ROT_DIM = HEAD_DIM // 4
D_FF = 2816
MIX_W = ATTN_W + SSM_W
EPS = 1e-6
N_MOD = 9
IN_COLS = ATTN_W + 2 * KV_DIM + IDX_HEADS * IDX_DIM + IDX_DIM + IDX_HEADS + SSM_W
IN_SPLITS = (
    ATTN_W,
    ATTN_W + KV_DIM,
    ATTN_W + 2 * KV_DIM,
    ATTN_W + 2 * KV_DIM + IDX_HEADS * IDX_DIM,
    ATTN_W + 2 * KV_DIM + IDX_HEADS * IDX_DIM + IDX_DIM,
    ATTN_W + 2 * KV_DIM + IDX_HEADS * IDX_DIM + IDX_DIM + IDX_HEADS,
)

kernel_name = 'hybrid_dsa_s5_macaron_adaln'


def rms_norm(x, g):
    xf = x.astype(jnp.float32)
    y = xf * lax.rsqrt(jnp.mean(xf * xf, axis=-1, keepdims=True) + EPS)
    return (y * g.astype(jnp.float32)).astype(x.dtype)


def modulate(h, shift, scale):
    return h * (1.0 + scale[:, None, :]) + shift[:, None, :]


def swiglu(h, w1, w3, w2):
    return (jax.nn.silu(h @ w1) * (h @ w3)) @ w2


def rope_tables(positions):
    inv_freq = 1.0 / (ROPE_THETA ** (jnp.arange(0, ROT_DIM, 2, dtype=jnp.float32) / ROT_DIM))
    ang = positions.astype(jnp.float32)[..., None] * inv_freq
    return jnp.cos(ang), jnp.sin(ang)


def apply_partial_rope(t, cos, sin):
    half = ROT_DIM // 2
    tf = t.astype(jnp.float32)
    t1 = tf[..., :half]
    t2 = tf[..., half:ROT_DIM]
    cs = cos[:, :, None, :]
    sn = sin[:, :, None, :]
    out = jnp.concatenate([t1 * cs - t2 * sn, t1 * sn + t2 * cs, tf[..., ROT_DIM:]], axis=-1)
    return out.astype(t.dtype)


def dsa_attention(q, k, v, qi, ki, wi):
    bsz, seq = q.shape[0], q.shape[1]
    topk = min(TOPK_MAX, seq // 4)
    nb = seq // Q_BLOCK
    key_chunk = jnp.arange(seq) // CHUNK
    idx_scale = IDX_DIM ** -0.5 * IDX_HEADS ** -0.5
    att_scale = HEAD_DIM ** -0.5
    gather = jax.vmap(lambda t, i: t[i])

    def to_blocks(t):
        return jnp.moveaxis(t.reshape((bsz, nb, Q_BLOCK) + t.shape[2:]), 1, 0)

    def block_fn(args):
        start, qb, qib, wb = args
        q_chunk = (start + jnp.arange(Q_BLOCK)) // CHUNK
        rel = jax.nn.relu(jnp.einsum('bqhd,bsd->bqhs', qib, ki, preferred_element_type=jnp.float32))
        score = jnp.einsum('bqhs,bqh->bqs', rel, wb.astype(jnp.float32)) * idx_scale
        admissible = key_chunk[None, :] <= q_chunk[:, None]
        score = jnp.where(admissible[None], score, -jnp.inf)
        vals, idx = lax.top_k(score, topk)
        k_sel = gather(k, idx)
        v_sel = gather(v, idx)
        logits = jnp.einsum('bqhd,bqkd->bqhk', qb, k_sel, preferred_element_type=jnp.float32) * att_scale
        logits = jnp.where(jnp.isfinite(vals)[:, :, None, :], logits, -jnp.inf)
        p = jax.nn.softmax(logits, axis=-1)
        return jnp.einsum('bqhk,bqkd->bqhd', p.astype(v_sel.dtype), v_sel)

    starts = jnp.arange(nb, dtype=jnp.int32) * Q_BLOCK
    out = lax.map(block_fn, (starts, to_blocks(q), to_blocks(qi), to_blocks(wi)))
    out = jnp.moveaxis(out, 0, 1).reshape(bsz, seq, N_HEADS * HEAD_DIM)
    return out


def s5_ssm(u, a_re, a_im, log_dt, b_re, b_im, c_re, c_im, d_skip):
    bsz, seq, _ = u.shape
    nb = seq // SCAN_BLOCK
    uf = u.astype(jnp.float32).reshape(bsz, nb, SCAN_BLOCK, SSM_GROUPS, SSM_GROUP)
    uf = uf.transpose(1, 2, 0, 3, 4)
    a = lax.complex(a_re.astype(jnp.float32), a_im.astype(jnp.float32))
    dt = jnp.exp(log_dt.astype(jnp.float32))[:, None]
    a_bar = jnp.exp(a * dt)
    b_bar = ((a_bar - 1.0) / a)[:, :, None] * lax.complex(b_re.astype(jnp.float32), b_im.astype(jnp.float32))
    c_mat = lax.complex(c_re.astype(jnp.float32), c_im.astype(jnp.float32))
    d_f = d_skip.astype(jnp.float32)
    a_elems = jnp.broadcast_to(a_bar, (SCAN_BLOCK, 1, SSM_GROUPS, SSM_STATE))

    def combine(e1, e2):
        a1, b1 = e1
        a2, b2 = e2
        return a1 * a2, a2 * b1 + b2

    def step(h, ub):
        bu = jnp.einsum('gpc,sbgc->sbgp', b_bar, ub.astype(jnp.complex64))
        a_cum, b_scan = lax.associative_scan(combine, (a_elems, bu), axis=0)
        states = a_cum * h[None] + b_scan
        y = jnp.einsum('gcp,sbgp->sbgc', c_mat, states).real + d_f * ub
        return states[-1], y

    h0 = jnp.zeros((bsz, SSM_GROUPS, SSM_STATE), jnp.complex64)
    _, ys = lax.scan(step, h0, uf)
    return ys.transpose(2, 0, 1, 3, 4).reshape(bsz, seq, SSM_W).astype(u.dtype)


def hybrid_mixer(h, cos, sin, w_in, w_out, attn_gain, ssm_gain, a_re, a_im, log_dt,
                 b_re, b_im, c_re, c_im, d_skip, glu_w, glu_b):
    bsz, seq, _ = h.shape
    proj = h @ w_in
    q, k, v, qi, ki, wi, u = jnp.split(proj, IN_SPLITS, axis=-1)
    q = apply_partial_rope(q.reshape(bsz, seq, N_HEADS, HEAD_DIM), cos, sin)
    k = apply_partial_rope(k[:, :, None, :], cos, sin)[:, :, 0, :]
    qi = apply_partial_rope(qi.reshape(bsz, seq, IDX_HEADS, IDX_DIM), cos, sin)
    ki = apply_partial_rope(ki[:, :, None, :], cos, sin)[:, :, 0, :]
    attn = dsa_attention(q, k, v, qi, ki, wi)
    y = s5_ssm(u, a_re, a_im, log_dt, b_re, b_im, c_re, c_im, d_skip)
    y = jax.nn.gelu(y)
    y = y * jax.nn.sigmoid(y @ glu_w + glu_b)
    mixed = jnp.concatenate([rms_norm(attn, attn_gain), rms_norm(y, ssm_gain)], axis=-1)
    return mixed @ w_out


def setup_inputs(seed: int = 0) -> dict:
    key = jax.random.key(seed)
    ks = jax.random.split(key, 32)
    f32 = jnp.float32

    def nrm(k, shape, scale):
        return jax.random.normal(k, shape, f32) * scale

    x = nrm(ks[0], (BATCH, SEQ, D_MODEL), 1.0)
    c = nrm(ks[1], (BATCH, D_MODEL), 1.0)
    offsets = jax.random.randint(ks[2], (BATCH,), 0, 64, dtype=jnp.int32) * CHUNK
    positions = jnp.arange(SEQ, dtype=jnp.int32)[None, :] + offsets[:, None]
    mod_w = nrm(ks[3], (DEPTH, D_MODEL, N_MOD * D_MODEL), 0.5 * D_MODEL ** -0.5)
    mod_b = nrm(ks[4], (DEPTH, N_MOD * D_MODEL), 0.02)
    norm_g = 1.0 + nrm(ks[5], (DEPTH, 3, D_MODEL), 0.02)
    ffn1_w1 = nrm(ks[6], (DEPTH, D_MODEL, D_FF), D_MODEL ** -0.5)
    ffn1_w3 = nrm(ks[7], (DEPTH, D_MODEL, D_FF), D_MODEL ** -0.5)
    ffn1_w2 = nrm(ks[8], (DEPTH, D_FF, D_MODEL), D_FF ** -0.5)
    ffn2_w1 = nrm(ks[9], (DEPTH, D_MODEL, D_FF), D_MODEL ** -0.5)
    ffn2_w3 = nrm(ks[10], (DEPTH, D_MODEL, D_FF), D_MODEL ** -0.5)
    ffn2_w2 = nrm(ks[11], (DEPTH, D_FF, D_MODEL), D_FF ** -0.5)
    w_in = nrm(ks[12], (DEPTH, D_MODEL, IN_COLS), D_MODEL ** -0.5)
    w_out = nrm(ks[13], (DEPTH, MIX_W, D_MODEL), MIX_W ** -0.5)
    attn_gain = 1.0 + nrm(ks[14], (DEPTH, ATTN_W), 0.02)
    ssm_gain = 1.0 + nrm(ks[15], (DEPTH, SSM_W), 0.02)
    gp = (DEPTH, SSM_GROUPS, SSM_STATE)
    ssm_a_re = -0.5 * jnp.exp(nrm(ks[16], gp, 0.02))
    ssm_a_im = math.pi * jnp.arange(SSM_STATE, dtype=f32)[None, None, :] + nrm(ks[17], gp, 0.01)
    ssm_log_dt = jax.random.uniform(ks[18], (DEPTH, SSM_GROUPS), f32, math.log(DT_MIN), math.log(DT_MAX))
    ssm_b_re = nrm(ks[19], (DEPTH, SSM_GROUPS, SSM_STATE, SSM_GROUP), (2 * SSM_GROUP) ** -0.5)
    ssm_b_im = nrm(ks[20], (DEPTH, SSM_GROUPS, SSM_STATE, SSM_GROUP), (2 * SSM_GROUP) ** -0.5)
    ssm_c_re = nrm(ks[21], (DEPTH, SSM_GROUPS, SSM_GROUP, SSM_STATE), SSM_STATE ** -0.5)
    ssm_c_im = nrm(ks[22], (DEPTH, SSM_GROUPS, SSM_GROUP, SSM_STATE), SSM_STATE ** -0.5)
    ssm_d = nrm(ks[23], (DEPTH, SSM_GROUPS, SSM_GROUP), 1.0)
    glu_w = nrm(ks[24], (DEPTH, SSM_W, SSM_W), SSM_W ** -0.5)
    glu_b = nrm(ks[25], (DEPTH, SSM_W), 0.02)
    final_g = 1.0 + nrm(ks[26], (D_MODEL,), 0.02)
    return {
        'x': x, 'c': c, 'positions': positions,
        'mod_w': mod_w, 'mod_b': mod_b, 'norm_g': norm_g,
        'ffn1_w1': ffn1_w1, 'ffn1_w3': ffn1_w3, 'ffn1_w2': ffn1_w2,
        'ffn2_w1': ffn2_w1, 'ffn2_w3': ffn2_w3, 'ffn2_w2': ffn2_w2,
        'w_in': w_in, 'w_out': w_out, 'attn_gain': attn_gain, 'ssm_gain': ssm_gain,
        'ssm_a_re': ssm_a_re, 'ssm_a_im': ssm_a_im, 'ssm_log_dt': ssm_log_dt,
        'ssm_b_re': ssm_b_re, 'ssm_b_im': ssm_b_im, 'ssm_c_re': ssm_c_re, 'ssm_c_im': ssm_c_im,
        'ssm_d': ssm_d, 'glu_w': glu_w, 'glu_b': glu_b, 'final_g': final_g,
    }


def reference(x, c, positions, mod_w, mod_b, norm_g, ffn1_w1, ffn1_w3, ffn1_w2,
              ffn2_w1, ffn2_w3, ffn2_w2, w_in, w_out, attn_gain, ssm_gain,
              ssm_a_re, ssm_a_im, ssm_log_dt, ssm_b_re, ssm_b_im, ssm_c_re, ssm_c_im,
              ssm_d, glu_w, glu_b, final_g):
    cos, sin = rope_tables(positions)
    for l in range(DEPTH):
        mod = jax.nn.silu(c) @ mod_w[l] + mod_b[l]
        sh1, sc1, g1, sh2, sc2, g2, sh3, sc3, g3 = jnp.split(mod, N_MOD, axis=-1)
        h = modulate(rms_norm(x, norm_g[l, 0]), sh1, sc1)
        x = x + 0.5 * g1[:, None, :] * swiglu(h, ffn1_w1[l], ffn1_w3[l], ffn1_w2[l])
        h = modulate(rms_norm(x, norm_g[l, 1]), sh2, sc2)
        x = x + g2[:, None, :] * hybrid_mixer(
            h, cos, sin, w_in[l], w_out[l], attn_gain[l], ssm_gain[l],
            ssm_a_re[l], ssm_a_im[l], ssm_log_dt[l], ssm_b_re[l], ssm_b_im[l],
            ssm_c_re[l], ssm_c_im[l], ssm_d[l], glu_w[l], glu_b[l])
        h = modulate(rms_norm(x, norm_g[l, 2]), sh3, sc3)
        x = x + 0.5 * g3[:, None, :] * swiglu(h, ffn2_w1[l], ffn2_w3[l], ffn2_w2[l])
    return rms_norm(x, final_g)
```

```cpp
#include <hip/hip_runtime.h>
#include <cstdio>
#include <cstdint>

#ifndef ATTN_FAST
#define ATTN_FAST 1
#endif
#ifndef PROBE_DUP
#define PROBE_DUP 0
#endif
#ifndef ATTN_SAMPLE
#define ATTN_SAMPLE 0
#endif
#ifndef SPEC_NUM
#define SPEC_NUM 704
#endif
#ifndef PROBE_FALLBACK
#define PROBE_FALLBACK 0
#endif
#ifndef DEBUG_STAT
#define DEBUG_STAT 0
#endif
#ifndef FFN_ALIGN
#define FFN_ALIGN true
#endif
#ifndef FFN_SP2
#define FFN_SP2 true
#endif
#ifndef MK_ONE_LAUNCH
#define MK_ONE_LAUNCH 1
#endif

constexpr int NB = 4, SEQ = 8192, DM = 1024, DEPTH = 4, MTOK = NB * SEQ;
constexpr int DFF = 2816, NFF1 = 2 * DFF;
constexpr int ATTN_W = 512, NH = 8, HD = 64, IDXH = 4, TOPK = 256;
constexpr int SSM_W = 512, SG = 32, GC = 16, SP = 64;
constexpr int LCH = 32, NCHK = MTOK / LCH, CHB = SEQ / LCH, KT = LCH * GC, KSS = KT + 2 * SP;
constexpr int INC = 1476, NWIN = 1536, NMOD = 9;
constexpr float EPS = 1e-6f, ATT_SCALE = 0.125f, IDX_SCALE = 0.0625f;

namespace pg8 {
#define PG8_LAS __attribute__((address_space(3)))
typedef unsigned short bf16_t;
typedef short bf16x8 __attribute__((ext_vector_type(8)));
typedef float f32x4 __attribute__((ext_vector_type(4)));
typedef unsigned u32x4 __attribute__((ext_vector_type(4)));
constexpr int BM = 256, BK = 64, HALF = 128, HTB = HALF * BK * 2, STAGE_BYTES = 8 * HTB, NXCD = 8, WGM = 8;

__host__ __device__ __forceinline__ int lds_byte(int r, int c) { const int st = (r >> 4) * 2 + (c >> 5), rr = r & 15, cc = c & 31, ob = rr * 64 + cc * 2; return st * 1024 + (ob ^ (((ob >> 9) & 1) << 5)); }
__host__ __device__ __forceinline__ void stage_rc(int b, int& R, int& C) { const int st = b / 1024, sb = b % 1024, swz = sb ^ (((sb >> 9) & 1) << 5); R = (st >> 1) * 16 + swz / 64; C = (st & 1) * 32 + (swz % 64) / 2; }
__host__ __device__ __forceinline__ int perm32(int rho) { const int n = rho >> 4, i = rho & 15; return 8 * (i >> 2) + 4 * n + (i & 3); }

struct Unit { int pm, pn; };

template <int NM, int NN> struct StaticOrder {
    static constexpr int nM = NM, nN = NN, nwg = NM * NN;
    int G, c;
    __host__ __device__ void init(int G_, int c_) { G = G_; c = c_; }
    __host__ __device__ bool next(int i, Unit& u) const {
        const long L = (long)i * G + c; if (L >= nwg) return false;
        int wgid = (int)L; { constexpr int q = nwg / NXCD, r = nwg % NXCD; const int xcd = wgid % NXCD, off = wgid / NXCD; wgid = (xcd < r ? xcd * (q + 1) : r * (q + 1) + (xcd - r) * q) + off; }
        constexpr int nig = WGM * nN; const int gid = wgid / nig, fm = gid * WGM, gsz = (nM - fm) < WGM ? (nM - fm) : WGM;
        u.pm = fm + ((wgid % nig) % gsz); u.pn = (wgid % nig) / gsz; return true;
    }
    __device__ __forceinline__ void a_ready(const Unit&) const {}
    __device__ __forceinline__ void done(const Unit&) const {}
};

__device__ __forceinline__ unsigned cvt_pk_bf16(float lo, float hi) { unsigned r; asm volatile("v_cvt_pk_bf16_f32 %0, %1, %2" : "=v"(r) : "v"(lo), "v"(hi)); return r; }

template <int LDA, int LDB, int NKT> struct GemmRM {
    const bf16_t* A; const bf16_t* Bt;
    static constexpr int nkt = NKT;
    __device__ __forceinline__ unsigned aVoff(int R, int C) const { return (unsigned)(R * LDA + C) * 2u; }
    __device__ __forceinline__ unsigned bVoff(int R, int C) const { return (unsigned)(R * LDB + C) * 2u; }
    __device__ __forceinline__ unsigned aK() const { return 128u; }
    __device__ __forceinline__ unsigned bK() const { return 128u; }
    __device__ __forceinline__ unsigned aH() const { return (unsigned)HALF * LDA * 2u; }
    __device__ __forceinline__ unsigned bH() const { return (unsigned)HALF * LDB * 2u; }
    __device__ __forceinline__ unsigned aOff(const Unit& u) const { return (unsigned)u.pm * (256u * LDA * 2u); }
    __device__ __forceinline__ unsigned bOff(const Unit& u) const { return (unsigned)u.pn * (256u * LDB * 2u); }
};
template <int LDA, int LDB, int NKT, int SCALE_W, int SKM_ = 0, int SKN_ = 0, int PROBE_ = 0  > struct GemmF8 {
    const unsigned char* A; const unsigned char* Bt;
    static constexpr int nkt = NKT; static constexpr bool F8 = true; static constexpr int SW = SCALE_W; static constexpr int SKM = SKM_, SKN = SKN_, PROBE = PROBE_;
    __device__ __forceinline__ unsigned aVoff(int R, int C) const { return (unsigned)(R * LDA + 2 * C); }
    __device__ __forceinline__ unsigned bVoff(int R, int C) const { return (unsigned)(R * LDB + 2 * C); }
    __device__ __forceinline__ unsigned aK() const { return 128u; }
    __device__ __forceinline__ unsigned bK() const { return 128u; }
    __device__ __forceinline__ unsigned aH() const { return (unsigned)HALF * LDA; }
    __device__ __forceinline__ unsigned bH() const { return (unsigned)HALF * LDB; }
    __device__ __forceinline__ unsigned aOff(const Unit& u) const { return (unsigned)u.pm * (256u * LDA); }
    __device__ __forceinline__ unsigned bOff(const Unit& u) const { return (unsigned)u.pn * (256u * LDB); }
};
template <class GP, class = void> struct gp_is_f8 { static constexpr bool value = false; static constexpr int sw = 127; };
template <class GP> struct gp_is_f8<GP, decltype((void)GP::F8)> { static constexpr bool value = GP::F8; static constexpr int sw = GP::SW; };
template <class GP, class = void> struct gp_probe { static constexpr int value = 0; };
template <class GP> struct gp_probe<GP, decltype((void)GP::PROBE)> { static constexpr int value = GP::PROBE; };
template <class GP, class = void> struct gp_skew { static constexpr bool value = false; static constexpr int SKM = 0, SKN = 0; };
template <class GP> struct gp_skew<GP, decltype((void)GP::SKM)> { static constexpr bool value = (GP::SKM != 0 || GP::SKN != 0); static constexpr int SKM = GP::SKM, SKN = GP::SKN; };
typedef int i32x8 __attribute__((ext_vector_type(8)));
typedef int i32x4 __attribute__((ext_vector_type(4)));
__device__ __forceinline__ i32x8 cat32(bf16x8 lo, bf16x8 hi) { const i32x4 a = __builtin_bit_cast(i32x4, lo), b = __builtin_bit_cast(i32x4, hi); return __builtin_shufflevector(a, b, 0, 1, 2, 3, 4, 5, 6, 7); }
template <int LDA, int LDB, int NKT, int BROWS> struct GemmSsm {
    const bf16_t* A; const bf16_t* Bt;
    static constexpr int nkt = NKT;
    __device__ __forceinline__ unsigned aVoff(int R, int C) const { return (unsigned)(R * LDA + C) * 2u; }
    __device__ __forceinline__ unsigned bVoff(int R, int C) const { return (unsigned)(R * LDB + C) * 2u; }
    __device__ __forceinline__ unsigned aK() const { return 128u; }
    __device__ __forceinline__ unsigned bK() const { return 128u; }
    __device__ __forceinline__ unsigned aH() const { return (unsigned)HALF * LDA * 2u; }
    __device__ __forceinline__ unsigned bH() const { return (unsigned)HALF * LDB * 2u; }
    __device__ __forceinline__ unsigned aOff(const Unit& u) const { return (unsigned)u.pm * (256u * LDA * 2u); }
    __device__ __forceinline__ unsigned bOff(const Unit& u) const { return ((unsigned)(u.pm >> 2) * BROWS + (unsigned)u.pn * 256u) * (LDB * 2u); }
};
struct GemmGlu {
    const bf16_t* A; const bf16_t* Bt;
    static constexpr int nkt = 8;
    __device__ __forceinline__ unsigned aVoff(int R, int C) const { return (unsigned)((C >> 4) * (NCHK * KT) + (R >> 5) * KT + (R & 31) * 16 + (C & 15)) * 2u; }
    __device__ __forceinline__ unsigned bVoff(int R, int C) const { return (unsigned)(R * 512 + C) * 2u; }
    __device__ __forceinline__ unsigned aK() const { return 4u * NCHK * KT * 2u; }
    __device__ __forceinline__ unsigned bK() const { return 128u; }
    __device__ __forceinline__ unsigned aH() const { return 4u * KT * 2u; }
    __device__ __forceinline__ unsigned bH() const { return (unsigned)HALF * 512u * 2u; }
    __device__ __forceinline__ unsigned aOff(const Unit& u) const { return (unsigned)u.pm * (8u * KT * 2u); }
    __device__ __forceinline__ unsigned bOff(const Unit& u) const { return (unsigned)u.pn * (256u * 512u * 2u); }
};

template <class GP, class Epi, class Sched, bool ALIGN_EPI = false, bool SP2 = false>
__device__ __forceinline__ void gemm_phase(PG8_LAS unsigned char* lds_w, const GP g, const Sched& S, const Epi& E) {
    const unsigned ldsq = (unsigned)__builtin_amdgcn_readfirstlane((int)(unsigned)(size_t)lds_w);
    PG8_LAS unsigned char* const lds = (PG8_LAS unsigned char*)(size_t)(ldsq & 0xFFFFFFu);
    const int wid0 = (int)(ldsq >> 24), wid = (gp_probe<GP>::value == 3) ? (((wid0 & 1) << 2) | (wid0 >> 1)) : wid0, lane = (int)__builtin_amdgcn_mbcnt_hi(~0u, __builtin_amdgcn_mbcnt_lo(~0u, 0u)), tid = wid * 64 + lane, wr = wid >> 2, wc = wid & 3, fr = lane & 15, fq = lane >> 4;
    const int nt = g.nkt;
    unsigned voffA[2], voffB[2];
#pragma unroll
    for (int i = 0; i < 2; ++i) { int R, C; stage_rc(tid * 16 + i * 8192, R, C); const int Rb = Epi::PERM ? ((R & ~31) + perm32(R & 31)) : R;
        voffA[i] = g.aVoff(R, C); voffB[i] = g.bVoff(Rb, C); }
    const unsigned kstepA = g.aK(), kstepB = g.bK(), hstepA = g.aH(), hstepB = g.bH();
    const char* const baseA = (const char*)g.A; const char* const baseB = (const char*)g.Bt;
    const unsigned ldsw = (unsigned)wid * 1024u;
    const int aoff = lds_byte(wr * 64 + fr, fq * 8), boff = lds_byte(wc * 32 + fr, fq * 8);
#define PG8_SA(b, h) (((b) * 2 + (h)) * HTB)
#define PG8_SB(b, h) ((4 + (b) * 2 + (h)) * HTB)
#define PG8_STAGE_(bufoff, base, goff, voff) do { if constexpr (gp_probe<GP>::value != 2) _Pragma("unroll") for (int _i = 0; _i < 2; ++_i) \
        __builtin_amdgcn_global_load_lds((const unsigned*)((base) + (unsigned)((goff) + (voff)[_i])), (PG8_LAS unsigned*)(lds + (bufoff) + ldsw + _i * 8192), 16, 0, 0); } while (0)
#define PG8_STAGE(bufoff, goff, voff) PG8_STAGE_(bufoff, PG8_BASE_##voff, goff, voff)
#define PG8_BASE_voffA baseA
#define PG8_BASE_voffB baseB
#define PG8_LDA(dst, b, h) do { _Pragma("unroll") for (int m = 0; m < 4; ++m) { \
        if constexpr (gp_is_f8<GP>::value) dst##8[m] = cat32(*(const PG8_LAS bf16x8*)(lds + PG8_SA(b, h) + aoff + m * 2048), *(const PG8_LAS bf16x8*)(lds + PG8_SA(b, h) + aoff + m * 2048 + 1024)); \
        else { _Pragma("unroll") for (int k = 0; k < 2; ++k) dst[m][k] = *(const PG8_LAS bf16x8*)(lds + PG8_SA(b, h) + aoff + m * 2048 + k * 1024); } } } while (0)
#define PG8_LDB(dst, b, h) do { _Pragma("unroll") for (int n = 0; n < 2; ++n) { \
        if constexpr (gp_is_f8<GP>::value) dst##8[n] = cat32(*(const PG8_LAS bf16x8*)(lds + PG8_SB(b, h) + boff + n * 2048), *(const PG8_LAS bf16x8*)(lds + PG8_SB(b, h) + boff + n * 2048 + 1024)); \
        else { _Pragma("unroll") for (int k = 0; k < 2; ++k) dst[n][k] = *(const PG8_LAS bf16x8*)(lds + PG8_SB(b, h) + boff + n * 2048 + k * 1024); } } } while (0)
#define PG8_MMA(ai, bj, At, Bt) do { __builtin_amdgcn_s_setprio(1); _Pragma("unroll") for (int m = 0; m < 4; ++m) _Pragma("unroll") for (int n = 0; n < 2; ++n) { \
        if constexpr (gp_probe<GP>::value == 1) { asm volatile("" :: "v"(Bt##8[n]), "v"(At##8[m])); } else \
        if constexpr (gp_is_f8<GP>::value) acc[ai][bj][m][n] = __builtin_amdgcn_mfma_scale_f32_16x16x128_f8f6f4(Bt##8[n], At##8[m], acc[ai][bj][m][n], 0, 0, 0, gp_is_f8<GP>::sw, 0, gp_is_f8<GP>::sw); \
        else { _Pragma("unroll") for (int k = 0; k < 2; ++k) acc[ai][bj][m][n] = __builtin_amdgcn_mfma_f32_16x16x32_bf16(Bt[n][k], At[m][k], acc[ai][bj][m][n], 0, 0, 0); } } __builtin_amdgcn_s_setprio(0); } while (0)
#define PG8_WAIT_V(n) asm volatile("s_waitcnt vmcnt(" #n ")" ::: "memory")
#define PG8_WAIT_L(n) asm volatile("s_waitcnt lgkmcnt(" #n ")" ::: "memory")
#define PG8_BAR __builtin_amdgcn_s_barrier()
#define PG8_SCHED __builtin_amdgcn_sched_barrier(0)
    Unit cur, nxt; int ui = 0;
    if (!S.next(0, cur)) return;
    f32x4 acc[2][2][4][2];
#pragma unroll
    for (int a = 0; a < 2; ++a)
#pragma unroll
        for (int b = 0; b < 2; ++b)
#pragma unroll
            for (int m = 0; m < 4; ++m)
#pragma unroll
                for (int n = 0; n < 2; ++n) acc[a][b][m][n] = (f32x4){0.f, 0.f, 0.f, 0.f};
    bf16x8 At[4][2], B0[2][2], B1[2][2];
    i32x8 At8[4], B08[2], B18[2];
    unsigned cA = g.aOff(cur), cB = g.bOff(cur);
    constexpr bool SKEW = gp_skew<GP>::value;
    auto kof = [&](const Unit& u) -> int { if constexpr (SKEW) return (int)((unsigned)(gp_skew<GP>::SKM * u.pm + gp_skew<GP>::SKN * u.pn) % (unsigned)GP::nkt); else return 0; };
    auto kx = [&](int t, int off) -> unsigned { if constexpr (SKEW) { int k = t + off; if (k >= nt) k -= nt; return (unsigned)k; } else return (unsigned)t; };
    int offc = kof(cur);
    S.a_ready(cur);
    { const unsigned p0A = cA + kx(0, offc) * kstepA, p0B = cB + kx(0, offc) * kstepB, p1A = cA + kx(1, offc) * kstepA, p1B = cB + kx(1, offc) * kstepB;
    if constexpr (SP2) {
        PG8_STAGE(PG8_SB(0, 0), p0B, voffB); PG8_STAGE(PG8_SB(0, 1), p0B + hstepB, voffB); PG8_STAGE(PG8_SA(0, 0), p0A, voffA); PG8_STAGE(PG8_SA(0, 1), p0A + hstepA, voffA);
        if (wr == 1) PG8_BAR;
        PG8_WAIT_V(2); PG8_BAR;
        PG8_STAGE(PG8_SB(1, 0), p1B, voffB); PG8_STAGE(PG8_SA(1, 0), p1A, voffA); PG8_STAGE(PG8_SB(1, 1), p1B + hstepB, voffB);
        PG8_WAIT_V(6); PG8_BAR;
    } else {
        PG8_STAGE(PG8_SB(0, 0), p0B, voffB); PG8_STAGE(PG8_SA(0, 0), p0A, voffA); PG8_STAGE(PG8_SB(0, 1), p0B + hstepB, voffB); PG8_STAGE(PG8_SA(0, 1), p0A + hstepA, voffA);
        if (wr == 1) PG8_BAR;
        PG8_WAIT_V(4); PG8_BAR;
        PG8_STAGE(PG8_SB(1, 0), p1B, voffB); PG8_STAGE(PG8_SA(1, 0), p1A, voffA); PG8_STAGE(PG8_SB(1, 1), p1B + hstepB, voffB);
        PG8_WAIT_V(6); PG8_BAR;
    } }
    for (;;) {
        const bool has_next = S.next(ui + 1, nxt);
        const unsigned nA = has_next ? g.aOff(nxt) : cA, nB = has_next ? g.bOff(nxt) : cB;
        const int offn = has_next ? kof(nxt) : offc;
#pragma unroll 1
        for (int t = 0; t < nt; t += 2) {
            const bool last = (t == nt - 2);
            const unsigned a1 = cA + kx(t + 1, offc) * kstepA;
            const unsigned k2 = last ? kx(0, offn) : kx(t + 2, offc), k3 = last ? kx(1, offn) : kx(t + 3, offc);
            const unsigned a2 = (last ? nA : cA) + k2 * kstepA, b2 = (last ? nB : cB) + k2 * kstepB;
            const unsigned a3 = SKEW ? (last ? nA : cA) + k3 * kstepA : a2 + kstepA, b3 = SKEW ? (last ? nB : cB) + k3 * kstepB : b2 + kstepB;
            if (last && has_next) S.a_ready(nxt);
            if constexpr (SP2) {
            PG8_LDB(B0, 0, 0); PG8_LDB(B1, 0, 1); PG8_SCHED; PG8_LDA(At, 0, 0); PG8_STAGE(PG8_SA(1, 1), a1 + hstepA, voffA);
            PG8_WAIT_V(8); PG8_WAIT_L(0); PG8_BAR; PG8_MMA(0, 0, At, B0); PG8_MMA(0, 1, At, B1); PG8_BAR; PG8_SCHED;
            PG8_LDA(At, 0, 1); PG8_STAGE(PG8_SB(0, 0), b2, voffB); PG8_STAGE(PG8_SB(0, 1), b2 + hstepB, voffB); PG8_STAGE(PG8_SA(0, 0), a2, voffA);
            PG8_WAIT_V(8); PG8_WAIT_L(0); PG8_BAR; PG8_MMA(1, 0, At, B0); PG8_MMA(1, 1, At, B1); PG8_BAR; PG8_SCHED;
            PG8_LDB(B0, 1, 0); PG8_LDB(B1, 1, 1); PG8_SCHED; PG8_LDA(At, 1, 0); PG8_STAGE(PG8_SA(0, 1), a2 + hstepA, voffA);
            PG8_WAIT_V(8); PG8_WAIT_L(0); PG8_BAR; PG8_MMA(0, 0, At, B0); PG8_MMA(0, 1, At, B1); PG8_BAR; PG8_SCHED;
            PG8_LDA(At, 1, 1); PG8_STAGE(PG8_SB(1, 0), b3, voffB); PG8_STAGE(PG8_SB(1, 1), b3 + hstepB, voffB); PG8_STAGE(PG8_SA(1, 0), a3, voffA);
            PG8_WAIT_V(8); PG8_WAIT_L(0); PG8_BAR; PG8_MMA(1, 0, At, B0); PG8_MMA(1, 1, At, B1); PG8_BAR; PG8_SCHED;
            } else {
            PG8_LDB(B0, 0, 0); PG8_SCHED; PG8_LDA(At, 0, 0); PG8_STAGE(PG8_SA(1, 1), a1 + hstepA, voffA);
            PG8_WAIT_L(8); PG8_BAR; PG8_WAIT_L(0); PG8_MMA(0, 0, At, B0); PG8_BAR; PG8_SCHED;
            PG8_LDB(B1, 0, 1); PG8_STAGE(PG8_SB(0, 0), b2, voffB);
            PG8_BAR; PG8_WAIT_L(0); PG8_MMA(0, 1, At, B1); PG8_BAR;
            PG8_LDA(At, 0, 1); PG8_STAGE(PG8_SA(0, 0), a2, voffA);
            PG8_BAR; PG8_WAIT_L(0); PG8_MMA(1, 0, At, B0); PG8_BAR; PG8_SCHED;
            PG8_STAGE(PG8_SB(0, 1), b2 + hstepB, voffB);
            PG8_WAIT_V(6); PG8_BAR; PG8_MMA(1, 1, At, B1); PG8_BAR;
            PG8_LDB(B0, 1, 0); PG8_SCHED; PG8_LDA(At, 1, 0); PG8_STAGE(PG8_SA(0, 1), a2 + hstepA, voffA);
            PG8_WAIT_L(8); PG8_BAR; PG8_WAIT_L(0); PG8_MMA(0, 0, At, B0); PG8_BAR; PG8_SCHED;
            PG8_LDB(B1, 1, 1); PG8_STAGE(PG8_SB(1, 0), b3, voffB);
            PG8_BAR; PG8_WAIT_L(0); PG8_MMA(0, 1, At, B1); PG8_BAR;
            PG8_LDA(At, 1, 1); PG8_STAGE(PG8_SA(1, 0), a3, voffA);
            PG8_BAR; PG8_WAIT_L(0); PG8_MMA(1, 0, At, B0); PG8_BAR; PG8_SCHED;
            PG8_STAGE(PG8_SB(1, 1), b3 + hstepB, voffB);
            PG8_WAIT_V(6); PG8_BAR; PG8_MMA(1, 1, At, B1); PG8_BAR;
            }
        }
        if constexpr (ALIGN_EPI) { if (wr == 0) PG8_BAR; }
        E(acc, cur, wr, wc, fr, fq); S.done(cur);
        if (!has_next) break;
#pragma unroll
        for (int a = 0; a < 2; ++a)
#pragma unroll
            for (int b = 0; b < 2; ++b)
#pragma unroll
                for (int m = 0; m < 4; ++m)
#pragma unroll
                    for (int n = 0; n < 2; ++n) acc[a][b][m][n] = (f32x4){0.f, 0.f, 0.f, 0.f};
        cur = nxt; cA = nA; cB = nB; offc = offn; ++ui;
        if constexpr (ALIGN_EPI) { if (wr == 1) PG8_BAR; }
    }
    PG8_WAIT_V(0);
    if constexpr (!ALIGN_EPI) { if (wr == 0) PG8_BAR; }
    PG8_BAR;
#undef PG8_SA
#undef PG8_SB
#undef PG8_STAGE
#undef PG8_STAGE_
#undef PG8_BASE_voffA
#undef PG8_BASE_voffB
#undef PG8_LDA
#undef PG8_LDB
#undef PG8_MMA
#undef PG8_WAIT_V
#undef PG8_WAIT_L
#undef PG8_BAR
#undef PG8_SCHED
}
}

constexpr size_t MiB = 1u << 20;
constexpr size_t WS_CTL = 0, CTL_ZERO_BYTES = 1 * MiB;
constexpr size_t WS_MOD = 1 * MiB;
constexpr size_t WS_ROPE = 2 * MiB;
constexpr size_t WS_AL = 4 * MiB;
constexpr size_t WS_W13 = 5 * MiB;
constexpr size_t WS_W2 = 49 * MiB;
constexpr size_t WS_XB = 72 * MiB;
constexpr size_t WS_WIN = 137 * MiB;
constexpr size_t WS_WOUT = 149 * MiB;
constexpr size_t WS_GLU = 157 * MiB;
constexpr size_t WS_BTV = 159 * MiB;
constexpr size_t WS_BW = 239 * MiB;
constexpr size_t WS_H = 256 * MiB;
constexpr size_t WS_R = 320 * MiB;
constexpr size_t R_Q = WS_R, R_KB = WS_R + 32 * MiB, R_VB = WS_R + 36 * MiB, R_QI = WS_R + 40 * MiB, R_KI = WS_R + 56 * MiB, R_WI = WS_R + 60 * MiB;
constexpr size_t R_UG = WS_R + 61 * MiB;
constexpr size_t R_SINC = WS_R + 101 * MiB;
constexpr size_t R_YG = WS_R + 117 * MiB;
constexpr size_t R_Y2 = WS_R + 149 * MiB;
constexpr size_t R_SEL = WS_R + 181 * MiB;
constexpr size_t WS_END = 517 * MiB;
constexpr int CW_BAR = 4096;

constexpr int RING_BYTES = 131072, LDSCTL_OFF = RING_BYTES, MISC_OFF = LDSCTL_OFF + 320, LDS_BYTES = 163840;

#define GAS __attribute__((address_space(1)))
#define LAS __attribute__((address_space(3)))
typedef unsigned short bf16;
typedef unsigned v4u __attribute__((ext_vector_type(4)));
typedef float f32x4 __attribute__((ext_vector_type(4)));
typedef GAS unsigned gu32;
#define RLX_AGENT __ATOMIC_RELAXED, __HIP_MEMORY_SCOPE_AGENT
#define LDS_WAIT() asm volatile("s_waitcnt lgkmcnt(0)" ::: "memory")
__device__ __forceinline__ unsigned f2bf(float f) { unsigned u = __builtin_bit_cast(unsigned, f); return (u + 0x7fffu + ((u >> 16) & 1u)) >> 16; }
__device__ __forceinline__ unsigned pk2(float lo, float hi) { unsigned r; asm("v_cvt_pk_bf16_f32 %0, %1, %2" : "=v"(r) : "v"(lo), "v"(hi)); return r; }
__device__ __forceinline__ unsigned pk8(float a, float b, float c, float d) {
    a = __builtin_amdgcn_fmed3f(a, -448.f, 448.f); b = __builtin_amdgcn_fmed3f(b, -448.f, 448.f); c = __builtin_amdgcn_fmed3f(c, -448.f, 448.f); d = __builtin_amdgcn_fmed3f(d, -448.f, 448.f);
    int v = __builtin_amdgcn_cvt_pk_fp8_f32(a, b, 0, false); v = __builtin_amdgcn_cvt_pk_fp8_f32(c, d, v, true); return (unsigned)v; }
__device__ __forceinline__ float bf2f(unsigned short b) { return __builtin_bit_cast(float, (unsigned)b << 16); }
__device__ __forceinline__ float bflo(unsigned w) { return __builtin_bit_cast(float, w << 16); }
__device__ __forceinline__ float bfhi(unsigned w) { return __builtin_bit_cast(float, w & 0xffff0000u); }

#define XB_TMO      128
#define XB_XCNT(j)  (256  + 64 * (j))
#define XB_XSUB(j)  (1280 + 64 * (j))
#define XB_XGEN(j)  (2304 + 64 * (j))
#define XB_TOP      3328
#define XB_TOPGEN   3392
#define XCD_BAR_WORDS 3456
#define XB_SPIN_CAP (1u << 18)
__device__ __forceinline__ unsigned xb_ld(unsigned* p)              { return __hip_atomic_load(p, __ATOMIC_RELAXED, __HIP_MEMORY_SCOPE_AGENT); }
__device__ __forceinline__ unsigned xb_add(unsigned* p, unsigned v) { return __hip_atomic_fetch_add(p, v, __ATOMIC_RELAXED, __HIP_MEMORY_SCOPE_AGENT); }
__device__ __forceinline__ unsigned xb_xcc_id() { return (unsigned)__builtin_amdgcn_s_getreg((3 << 11) | 20) & 0xFu; }
#define XB_SPIN(cond, bar) do { unsigned _sp = 0; while (cond) { __builtin_amdgcn_s_sleep(1); \
    if ((++_sp & 255u) == 0u) { if (xb_ld(&(bar)[XB_TMO])) break; if (_sp > XB_SPIN_CAP) { atomicAdd(&(bar)[XB_TMO], 1u); break; } } } } while (0)
struct XcdBarrier { unsigned* bar; unsigned x; volatile LAS unsigned* st; };
__device__ __forceinline__ XcdBarrier xcd_barrier_post(unsigned* bar, volatile LAS unsigned* st) {
    XcdBarrier b; b.bar = bar; b.x = xb_xcc_id(); b.st = st;
    if (threadIdx.x == 0) (void)xb_add(&bar[XB_XCNT(b.x)], 1u);
    return b;
}
__device__ __forceinline__ void xcd_barrier_complete(unsigned* bar, unsigned x, unsigned& nloc, unsigned& nx) {
    const unsigned G = gridDim.x * gridDim.y * gridDim.z;
    unsigned sum, cnt, mine, sp = 0u;
    for (;;) {
        sum = 0u; cnt = 0u; mine = 0u;
#pragma unroll
        for (unsigned j = 0; j < 16; ++j) { const unsigned c = xb_ld(&bar[XB_XCNT(j)]); sum += c; cnt += (c > 0u) ? 1u : 0u; mine = (j == x) ? c : mine; }
        if (sum == G) break;
        __builtin_amdgcn_s_sleep(1);
        if ((++sp & 255u) == 0u) { if (xb_ld(&bar[XB_TMO])) break; if (sp > XB_SPIN_CAP) { atomicAdd(&bar[XB_TMO], 1u); break; } }
    }
    nloc = mine > 0u ? mine : 1u; nx = cnt > 0u ? cnt : 1u;
}
__device__ __forceinline__ void xcd_barrier(const XcdBarrier& b, const bool t0) {
    asm volatile("s_waitcnt vmcnt(0)" ::: "memory");
    __syncthreads();
    if (t0) {
        unsigned* bar = b.bar;
        __builtin_amdgcn_s_waitcnt(0);
        unsigned nloc = b.st[0], nx = b.st[1];
        if (nloc == 0u) { xcd_barrier_complete(bar, b.x, nloc, nx); b.st[0] = nloc; b.st[1] = nx; }
        const unsigned old = xb_add(&bar[XB_XSUB(b.x)], 1u);
        const unsigned gen = old / nloc;
        if (old + 1u == (gen + 1u) * nloc) {
            __builtin_amdgcn_fence(__ATOMIC_RELEASE, "agent");
            asm volatile("s_waitcnt vmcnt(0)" ::: "memory");
            const unsigned og = xb_add(&bar[XB_TOP], 1u);
            const unsigned tg = og / nx;
            if (og + 1u == (tg + 1u) * nx) xb_add(&bar[XB_TOPGEN], 1u);
            else XB_SPIN(xb_ld(&bar[XB_TOPGEN]) == tg, bar);
            __builtin_amdgcn_fence(__ATOMIC_ACQUIRE, "agent");
            xb_add(&bar[XB_XGEN(b.x)], 1u);
            asm volatile("s_waitcnt vmcnt(0)" ::: "memory");
        } else {
            XB_SPIN(xb_ld(&bar[XB_XGEN(b.x)]) == gen, bar);
            __builtin_amdgcn_fence(__ATOMIC_ACQUIRE, "agent");
            asm volatile("s_waitcnt vmcnt(0)" ::: "memory");
        }
    }
    __syncthreads();
}

struct Args { const void* in[27]; float* out; unsigned char* ws; int ph_lo, ph_hi, pad0, pad1; };
typedef const __attribute__((address_space(4))) Args CArgs;
__device__ __forceinline__ const CArgs* karg(const CArgs* p) { const unsigned long long v = (unsigned long long)p; const unsigned lo = __builtin_amdgcn_readfirstlane((unsigned)v), hi = __builtin_amdgcn_readfirstlane((unsigned)(v >> 32)); return (const CArgs*)(((unsigned long long)hi << 32) | lo); }
struct Frame {
    LAS unsigned char* lds; unsigned char* ws;
    int tid, lane, wave, vcu, G;
};
__device__ __forceinline__ float wave_sum(float v) {
#define WS_DPP(x, ctrl, rm) __builtin_bit_cast(float, __builtin_amdgcn_update_dpp(0, __builtin_bit_cast(int, (x)), ctrl, rm, 0xF, false))
    v += WS_DPP(v, 0x111, 0xF); v += WS_DPP(v, 0x112, 0xF); v += WS_DPP(v, 0x114, 0xF); v += WS_DPP(v, 0x118, 0xF);
    v += WS_DPP(v, 0x142, 0xA); v += WS_DPP(v, 0x143, 0xC);
#undef WS_DPP
    return __builtin_bit_cast(float, __builtin_amdgcn_readlane(__builtin_bit_cast(int, v), 63));
}
__device__ __forceinline__ float wave_max(float v) {
#pragma unroll
    for (int o = 1; o < 64; o <<= 1) v = fmaxf(v, __shfl_xor(v, o));
    return v;
}
__device__ __forceinline__ float sigmoidf_(float x) { return __builtin_amdgcn_rcpf(1.0f + __expf(-x)); }
__device__ __forceinline__ float gelu_tanh(float x) { const float u = 0.7978845608028654f * (x + 0.044715f * x * x * x); return x * sigmoidf_(2.0f * u); }

using pg8::Unit; using pg8::cvt_pk_bf16;
struct EpiSwiGLU {
    static constexpr bool PERM = true;
    unsigned char* O;
    __device__ __forceinline__ void operator()(const f32x4 (&acc)[2][2][4][2], const Unit& u, int wr, int wc, int fr, int fq) const {
        { int ln; asm volatile("v_mbcnt_lo_u32_b32 %0, -1, 0\n\tv_mbcnt_hi_u32_b32 %0, -1, %0" : "=v"(ln)); fr = ln & 15; fq = ln >> 4; }
        const int row0 = u.pm * 256 + wr * 64 + fr, col0 = u.pn * 128 + wc * 32 + 8 * fq;
#pragma unroll
        for (int ai = 0; ai < 2; ++ai)
#pragma unroll
            for (int m = 0; m < 4; ++m) {
                unsigned char* p = O + (size_t)(row0 + ai * 128 + m * 16) * DFF + col0;
                float o[8];
#pragma unroll
                for (int n = 0; n < 2; ++n)
#pragma unroll
                    for (int e = 0; e < 4; ++e) { const float a = acc[ai][0][m][n][e], b = acc[ai][1][m][n][e]; o[4 * n + e] = (a + a) * sigmoidf_(a) * b; }
                *(unsigned long long*)p = (unsigned long long)pk8(o[0], o[1], o[2], o[3]) | ((unsigned long long)pk8(o[4], o[5], o[6], o[7]) << 32);
            }
    }
};
struct EpiResid {
    static constexpr bool PERM = true;
    const bf16* xin; bf16* xout; const float* gate; float coef;
    __device__ __forceinline__ void operator()(const f32x4 (&acc)[2][2][4][2], const Unit& u, int wr, int wc, int fr, int fq) const {
        { int ln; asm volatile("v_mbcnt_lo_u32_b32 %0, -1, 0\n\tv_mbcnt_hi_u32_b32 %0, -1, %0" : "=v"(ln)); fr = ln & 15; fq = ln >> 4; }
        const unsigned row0 = (unsigned)(u.pm * 256 + wr * 64 + fr), col0 = (unsigned)(u.pn * 256 + wc * 32 + 8 * fq);
        const float* gp = gate + (size_t)((u.pm * 256) >> 13) * (NMOD * DM) + col0;
        f32x4 gv[2][2];
#pragma unroll
        for (int bj = 0; bj < 2; ++bj)
#pragma unroll
            for (int n = 0; n < 2; ++n) gv[bj][n] = *(const f32x4*)(gp + bj * 128 + n * 4) * coef;
#pragma unroll
        for (int ai = 0; ai < 2; ++ai)
#pragma unroll
            for (int m = 0; m < 4; ++m) { const unsigned off = (row0 + ai * 128 + m * 16) * (unsigned)DM + col0;
#pragma unroll
                for (int bj = 0; bj < 2; ++bj) { const v4u q = *(const v4u*)(xin + off + bj * 128);
                    const f32x4 a0 = gv[bj][0] * acc[ai][bj][m][0], a1 = gv[bj][1] * acc[ai][bj][m][1];
                    v4u o; o.x = pk2(bflo(q.x) + a0.x, bfhi(q.x) + a0.y); o.y = pk2(bflo(q.y) + a0.z, bfhi(q.y) + a0.w); o.z = pk2(bflo(q.z) + a1.x, bfhi(q.z) + a1.y); o.w = pk2(bflo(q.w) + a1.z, bfhi(q.w) + a1.w);
                    *(v4u*)(xout + off + bj * 128) = o; } }
    }
};
struct EpiWin {
    static constexpr bool PERM = true;
    unsigned char* ws;
    __device__ __forceinline__ void operator()(const f32x4 (&acc)[2][2][4][2], const Unit& u, int wr, int wc, int fr, int fq) const {
        const int row0 = u.pm * 256 + wr * 64 + fr;
#pragma unroll 1
        for (int bj = 0; bj < 2; ++bj) {
            const int C0 = u.pn * 256 + bj * 128 + wc * 32, G64 = C0 >> 6, w0 = (C0 & 63) + 8 * fq;
            const bool do_rope = ((C0 & 63) == 0) && (G64 <= 8 || (G64 >= 10 && G64 <= 14));
            size_t boff; int S1, S2, loff = w0; float scl = 1.0f;
            if (G64 < 8) { boff = R_Q + (size_t)G64 * 128; S2 = ATTN_W; S1 = 32 * ATTN_W; scl = ATT_SCALE * 1.4426950408889634f; }
            else if (G64 == 8) { boff = R_KB; S2 = 64; S1 = 32 * 64; }
            else if (G64 == 9) { boff = R_VB; S2 = 64; S1 = 32 * 64; }
            else if (G64 < 14) { boff = R_QI + (size_t)(G64 - 10) * 4096; S2 = 8; S1 = 32 * 256; loff = (w0 >> 3) * 256; }
            else if (G64 == 14) { boff = R_KI; S2 = 8; S1 = 32 * 64; loff = (w0 >> 3) * 256; }
            else if (G64 == 15) { boff = R_WI; S2 = 8; S1 = 32 * 8; scl = IDX_SCALE; loff = 0; }
            else { boff = R_UG + (size_t)((C0 - 1024) >> 4) * ((size_t)NCHK * KSS * 2); S2 = 16; S1 = KSS; loff = (fq >> 1) * (NCHK * KSS) + 8 * (fq & 1); }
            bf16* const dst = (bf16*)(ws + boff) + loff;
            const float* const rope = (const float*)(ws + WS_ROPE);
            const float sg = (fq == 0) ? -1.f : 1.f;
#pragma unroll
            for (int ai = 0; ai < 2; ++ai)
#pragma unroll
                for (int m = 0; m < 4; ++m) {
                    const int row = row0 + ai * 128 + m * 16;
                    float v[8];
#pragma unroll
                    for (int n = 0; n < 2; ++n)
#pragma unroll
                        for (int e = 0; e < 4; ++e) v[4 * n + e] = (bj == 0) ? acc[ai][0][m][n][e] : acc[ai][1][m][n][e];
                    if (do_rope) {
                        const f32x4 c0 = *(const f32x4*)(rope + (size_t)row * 16), c1 = *(const f32x4*)(rope + (size_t)row * 16 + 4);
                        const f32x4 s0 = *(const f32x4*)(rope + (size_t)row * 16 + 8), s1 = *(const f32x4*)(rope + (size_t)row * 16 + 12);
                        const float cs[8] = {c0[0], c0[1], c0[2], c0[3], c1[0], c1[1], c1[2], c1[3]}, sn[8] = {s0[0], s0[1], s0[2], s0[3], s1[0], s1[1], s1[2], s1[3]};
#pragma unroll
                        for (int i = 0; i < 8; ++i) { const float pr = __shfl_xor(v[i], 16); const float r = v[i] * cs[i] + sg * pr * sn[i]; v[i] = (fq < 2) ? r : v[i]; }
                    }
#pragma unroll
                    for (int i = 0; i < 8; ++i) v[i] *= scl;
                    bf16* const p = dst + (size_t)((row >> 5) * S1 + (row & 31) * S2);
                    if (G64 == 15) { if (w0 == 0) *(f32x4*)p = (f32x4){v[0], v[1], v[2], v[3]}; }
                    else { v4u w; w.x = cvt_pk_bf16(v[0], v[1]); w.y = cvt_pk_bf16(v[2], v[3]); w.z = cvt_pk_bf16(v[4], v[5]); w.w = cvt_pk_bf16(v[6], v[7]); *(v4u*)p = w; }
                }
        }
    }
};
struct EpiSsmState {
    static constexpr bool PERM = false;
    float* S;
    __device__ __forceinline__ void operator()(const f32x4 (&acc)[2][2][4][2], const Unit& u, int wr, int wc, int fr, int fq) const {
        const int row0 = u.pm * 256 + wr * 64 + fr, col0 = wc * 32 + 4 * fq;
#pragma unroll
        for (int ai = 0; ai < 2; ++ai)
#pragma unroll
            for (int m = 0; m < 4; ++m)
#pragma unroll
                for (int n = 0; n < 2; ++n) *(f32x4*)(S + (size_t)(row0 + ai * 128 + m * 16) * 128 + col0 + n * 16) = acc[ai][0][m][n];
    }
};
struct EpiSsmOut {
    static constexpr bool PERM = true;
    bf16* Y;
    __device__ __forceinline__ void operator()(const f32x4 (&acc)[2][2][4][2], const Unit& u, int wr, int wc, int fr, int fq) const {
        const int row0 = u.pm * 256 + wr * 64 + fr, col0 = u.pn * 256 + wc * 32 + 8 * fq;
#pragma unroll
        for (int ai = 0; ai < 2; ++ai)
#pragma unroll
            for (int m = 0; m < 4; ++m)
#pragma unroll
                for (int bj = 0; bj < 2; ++bj) {
                    float o[8];
#pragma unroll
                    for (int n = 0; n < 2; ++n)
#pragma unroll
                        for (int e = 0; e < 4; ++e) o[4 * n + e] = gelu_tanh(acc[ai][bj][m][n][e]);
                    v4u w; w.x = cvt_pk_bf16(o[0], o[1]); w.y = cvt_pk_bf16(o[2], o[3]); w.z = cvt_pk_bf16(o[4], o[5]); w.w = cvt_pk_bf16(o[6], o[7]);
                    *(v4u*)(Y + (size_t)(row0 + ai * 128 + m * 16) * KT + col0 + bj * 128) = w;
                }
    }
};
struct EpiGlu {
    static constexpr bool PERM = true;
    const bf16* YG; bf16* Y2; const float* gb;
    __device__ __forceinline__ void operator()(const f32x4 (&acc)[2][2][4][2], const Unit& u, int wr, int wc, int fr, int fq) const {
        const int row0 = u.pm * 256 + wr * 64 + fr, col0 = u.pn * 256 + wc * 32 + 8 * fq;
#pragma unroll
        for (int bj = 0; bj < 2; ++bj) {
            const int col = col0 + bj * 128, gg = col >> 4, cc = col & 15;
            const f32x4 b0 = *(const f32x4*)(gb + col), b1 = *(const f32x4*)(gb + col + 4);
            const float bb[8] = {b0[0], b0[1], b0[2], b0[3], b1[0], b1[1], b1[2], b1[3]};
#pragma unroll
            for (int ai = 0; ai < 2; ++ai)
#pragma unroll
                for (int m = 0; m < 4; ++m) {
                    const int row = row0 + ai * 128 + m * 16;
                    const v4u yv = *(const v4u*)(YG + ((size_t)(gg * NCHK + (row >> 5))) * KT + (row & 31) * 16 + cc);
                    const float y[8] = {bflo(yv.x), bfhi(yv.x), bflo(yv.y), bfhi(yv.y), bflo(yv.z), bfhi(yv.z), bflo(yv.w), bfhi(yv.w)};
                    float o[8];
#pragma unroll
                    for (int n = 0; n < 2; ++n)
#pragma unroll
                        for (int e = 0; e < 4; ++e) o[4 * n + e] = y[4 * n + e] * sigmoidf_(acc[ai][bj][m][n][e] + bb[4 * n + e]);
                    v4u w; w.x = cvt_pk_bf16(o[0], o[1]); w.y = cvt_pk_bf16(o[2], o[3]); w.z = cvt_pk_bf16(o[4], o[5]); w.w = cvt_pk_bf16(o[6], o[7]);
                    *(v4u*)(Y2 + (size_t)row * SSM_W + col) = w;
                }
        }
    }
};

__device__ __forceinline__ void transpose_tile(const float* colp, int srcN, int k0, bf16* WT, int Kd, int n0, LAS float* scr, int lane) {
    float tv[32];
#pragma unroll
    for (int i = 0; i < 32; ++i) { const int kk = 2 * i + (lane >> 5); tv[i] = colp ? colp[(size_t)(k0 + kk) * srcN] : 0.f; }
#pragma unroll
    for (int i = 0; i < 32; ++i) { const int kk = 2 * i + (lane >> 5); scr[kk * 33 + (lane & 31)] = tv[i]; }
    LDS_WAIT(); asm volatile("" ::: "memory");
    const int c = lane & 7;
#pragma unroll
    for (int j = 0; j < 4; ++j) { const int n = (lane >> 3) + 8 * j; const LAS float* s = scr + (8 * c) * 33 + n;
        v4u o; o.x = pk2(s[0 * 33], s[1 * 33]); o.y = pk2(s[2 * 33], s[3 * 33]); o.z = pk2(s[4 * 33], s[5 * 33]); o.w = pk2(s[6 * 33], s[7 * 33]);
        *(v4u*)(WT + (size_t)(n0 + n) * Kd + k0 + 8 * c) = o; }
    LDS_WAIT(); asm volatile("" ::: "memory");
}
__device__ __forceinline__ void transpose_tile_f8(const float* colp, int srcN, int k0, unsigned char* WT, int Kd, int n0, LAS float* scr, int lane) {
    float tv[32];
#pragma unroll
    for (int i = 0; i < 32; ++i) { const int kk = 2 * i + (lane >> 5); tv[i] = colp ? colp[(size_t)(k0 + kk) * srcN] : 0.f; }
#pragma unroll
    for (int i = 0; i < 32; ++i) { const int kk = 2 * i + (lane >> 5); scr[kk * 33 + (lane & 31)] = tv[i]; }
    LDS_WAIT(); asm volatile("" ::: "memory");
#pragma unroll
    for (int j = 0; j < 2; ++j) { const int p = lane + 64 * j, n = p >> 2, kc = p & 3; const LAS float* sp = scr + (16 * kc) * 33 + n;
        v4u o;
        o.x = pk8(sp[0 * 33] * 32.f, sp[1 * 33] * 32.f, sp[2 * 33] * 32.f, sp[3 * 33] * 32.f); o.y = pk8(sp[4 * 33] * 32.f, sp[5 * 33] * 32.f, sp[6 * 33] * 32.f, sp[7 * 33] * 32.f);
        o.z = pk8(sp[8 * 33] * 32.f, sp[9 * 33] * 32.f, sp[10 * 33] * 32.f, sp[11 * 33] * 32.f); o.w = pk8(sp[12 * 33] * 32.f, sp[13 * 33] * 32.f, sp[14 * 33] * 32.f, sp[15 * 33] * 32.f);
        *(v4u*)(WT + (size_t)(n0 + n) * Kd + k0 + 16 * kc) = o; }
    LDS_WAIT(); asm volatile("" ::: "memory");
}
constexpr int IT_W13 = 16 * 176, IT_W2 = 44 * 32, IT_WIN = 16 * 48, IT_WOUT = 16 * 32, IT_GLU = 8 * 16;
constexpr int IT_LAYER = 2 * IT_W13 + 2 * IT_W2 + IT_WIN + IT_WOUT + IT_GLU, IT_ALL = DEPTH * IT_LAYER;
__device__ __forceinline__ void wt_item(const CArgs* ap, unsigned char* ws, int item, LAS float* scr, int lane) {
    const int l = item / IT_LAYER; int r = item % IT_LAYER; const int nl = lane & 31;
    if (r < 2 * IT_W13) { const int f = r / IT_W13; r -= f * IT_W13; const int kb = r / 176, nb = r % 176, np = 32 * nb + nl;
        const float* w = (const float*)ap->in[((np >> 7) & 1) ? (f ? 10 : 7) : (f ? 9 : 6)] + (size_t)l * DM * DFF + 128 * (np >> 8) + (np & 127);
        transpose_tile_f8(w, DFF, 64 * kb, ws + WS_W13 + (size_t)(l * 2 + f) * NFF1 * DM, DM, 32 * nb, scr, lane); return; }
    r -= 2 * IT_W13;
    if (r < 2 * IT_W2) { const int f = r / IT_W2; r -= f * IT_W2; const int kb = r / 32, nb = r % 32;
        const float* w = (const float*)ap->in[f ? 11 : 8] + (size_t)l * DFF * DM + 32 * nb + nl;
        transpose_tile_f8(w, DM, 64 * kb, ws + WS_W2 + (size_t)(l * 2 + f) * DM * DFF, DFF, 32 * nb, scr, lane); return; }
    r -= 2 * IT_W2;
    if (r < IT_WIN) { const int kb = r / 48, nb = r % 48, np = 32 * nb + nl;
        const int col = (np < 964) ? np : (np < 1024 ? -1 : np - 60);
        const float* w = (col >= 0) ? (const float*)ap->in[12] + (size_t)l * DM * INC + col : nullptr;
        transpose_tile(w, INC, 64 * kb, (bf16*)(ws + WS_WIN) + (size_t)l * NWIN * DM, DM, 32 * nb, scr, lane); return; }
    r -= IT_WIN;
    if (r < IT_WOUT) { const int kb = r / 32, nb = r % 32;
        const float* w = (const float*)ap->in[13] + (size_t)l * DM * DM + 32 * nb + nl;
        transpose_tile(w, DM, 64 * kb, (bf16*)(ws + WS_WOUT) + (size_t)l * DM * DM, DM, 32 * nb, scr, lane); return; }
    r -= IT_WOUT;
    { const int kb = r / 16, nb = r % 16;
        const float* w = (const float*)ap->in[24] + (size_t)l * SSM_W * SSM_W + 32 * nb + nl;
        transpose_tile(w, SSM_W, 64 * kb, (bf16*)(ws + WS_GLU) + (size_t)l * SSM_W * SSM_W, SSM_W, 32 * nb, scr, lane); }
}
__device__ __forceinline__ void mod_item(const CArgs* ap, Frame& F, int item, const LAS float* sc  , LAS float* red  ) {
    const int l = item / 144, n0 = (item % 144) * 64;
    const float* W = (const float*)ap->in[3] + ((size_t)l * DM + F.wave * 128) * (NMOD * DM) + n0 + F.lane;
    asm volatile("" : "+v"(W));
    float acc0 = 0.f, acc1 = 0.f, acc2 = 0.f, acc3 = 0.f;
#pragma unroll 1
    for (int k = 0; k < 128; k += 32) {
        float w[32];
#pragma unroll
        for (int j = 0; j < 32; ++j) { w[j] = *(const GAS float*)W; W += NMOD * DM; }
#pragma unroll
        for (int j = 0; j < 32; ++j) { const int kk = (F.tid >> 6) * 128 + k + j; acc0 += sc[kk] * w[j]; acc1 += sc[1024 + kk] * w[j]; acc2 += sc[2048 + kk] * w[j]; acc3 += sc[3072 + kk] * w[j]; }
    }
    red[(F.wave * 4 + 0) * 64 + F.lane] = acc0; red[(F.wave * 4 + 1) * 64 + F.lane] = acc1; red[(F.wave * 4 + 2) * 64 + F.lane] = acc2; red[(F.wave * 4 + 3) * 64 + F.lane] = acc3;
    __syncthreads();
    if (F.tid < 256) { const int b = F.tid >> 6, ln = F.tid & 63; float s = ((const float*)ap->in[4])[(size_t)l * NMOD * DM + n0 + ln];
#pragma unroll
        for (int w = 0; w < 8; ++w) s += red[(w * 4 + b) * 64 + ln];
        ((float*)(F.ws + WS_MOD))[((size_t)l * NB + b) * (NMOD * DM) + n0 + ln] = s; }
    __syncthreads();
}
__device__ __forceinline__ void ssm_pre_item(const CArgs* ap, Frame& F, int item) {
    const int l = item >> 5, g = item & 31; int tid = F.tid; asm volatile("" : "+v"(tid)); __builtin_assume(tid >= 0 && tid < 512);
    LAS float* Ere = (LAS float*)F.lds;
    LAS float* Eim = Ere + 33 * 64;
    LAS float* Bre = Eim + 33 * 64;
    LAS float* Bim = Bre + 1024;
    LAS float* Cre = Bim + 1024;
    LAS float* Cim = Cre + 1024;
    LAS float* Kk = Cim + 1024;
    LAS float* Dd = Kk + 8192;
    asm volatile("" : "+s"(ap));
    const float* a_re = (const float*)ap->in[16] + (size_t)(l * SG + g) * SP; const float* a_im = (const float*)ap->in[17] + (size_t)(l * SG + g) * SP;
    asm volatile("" : "+v"(a_re), "+v"(a_im));
    const float dt = __expf(((const float*)ap->in[18])[l * SG + g]);
    const double INV2PI = 0.15915494309189533576888;
    for (int idx = tid; idx < 33 * 64; idx += 512) { const int k = idx >> 6, p = idx & 63;
        const float mag = __expf(a_re[p] * dt * (float)k);
        const double rev = (double)a_im[p] * (double)dt * (double)k * INV2PI; const float fr = (float)(rev - __builtin_rint(rev));
        Ere[idx] = mag * __builtin_amdgcn_cosf(fr); Eim[idx] = mag * __builtin_amdgcn_sinf(fr); }
    asm volatile("" : "+s"(ap));
    for (int idx = tid; idx < 1024; idx += 512) { Cre[idx] = ((const float*)ap->in[21])[(size_t)(l * SG + g) * 1024 + idx]; Cim[idx] = ((const float*)ap->in[22])[(size_t)(l * SG + g) * 1024 + idx]; }
    if (tid < 16) Dd[tid] = ((const float*)ap->in[23])[(l * SG + g) * GC + tid];
    __syncthreads();
    asm volatile("" : "+s"(ap));
    for (int idx = tid; idx < 1024; idx += 512) { const int p = idx >> 4;
        const double ar = a_re[p], ai = a_im[p], zr = ar * dt, zi = ai * dt; double qr, qi;
        if (zr * zr + zi * zi < 0.25) {
            double tr = 1.0, ti = 0.0, sr = 1.0, si = 0.0;
#pragma unroll 1
            for (int n = 2; n <= 14; ++n) { const double nr = (tr * zr - ti * zi) / n, ni = (tr * zi + ti * zr) / n; tr = nr; ti = ni; sr += tr; si += ti; }
            qr = sr * dt; qi = si * dt;
        } else { const double nr = (double)Ere[64 + p] - 1.0, ni = (double)Eim[64 + p], den = ar * ar + ai * ai; qr = (nr * ar + ni * ai) / den; qi = (ni * ar - nr * ai) / den; }
        const double br = ((const float*)ap->in[19])[(size_t)(l * SG + g) * 1024 + idx], bi = ((const float*)ap->in[20])[(size_t)(l * SG + g) * 1024 + idx];
        Bre[idx] = (float)(qr * br - qi * bi); Bim[idx] = (float)(qr * bi + qi * br); }
    __syncthreads();
    for (int idx = tid; idx < 8192; idx += 512) { const int cp = idx & 15, c = (idx >> 4) & 15, tau = idx >> 8; float s = 0.f;
        for (int p = 0; p < 64; ++p) { const float cr = Cre[c * 64 + p], ci = Cim[c * 64 + p], er = Ere[tau * 64 + p], ei = Eim[tau * 64 + p];
            const float xr = cr * er - ci * ei, xi = cr * ei + ci * er; s += xr * Bre[p * 16 + cp] - xi * Bim[p * 16 + cp]; }
        Kk[idx] = s; }
    __syncthreads();
    bf16* TV = (bf16*)(F.ws + WS_BTV) + ((size_t)(l * SG + g) * KT) * KSS;
    for (int idx = tid; idx < 512 * 80; idx += 512) { const int n = idx / 80, k8 = idx % 80, i = n >> 4, c = n & 15; float v[8];
        if (k8 < 64) { const int ip = k8 >> 1, c0 = (k8 & 1) * 8;
#pragma unroll
            for (int e = 0; e < 8; ++e) { float x = 0.f; if (ip <= i) { x = Kk[((i - ip) * 16 + c) * 16 + c0 + e]; if (ip == i && c == c0 + e) x += Dd[c]; } v[e] = x; }
        } else { const int p0 = (k8 - 64) * 8;
#pragma unroll
            for (int e = 0; e < 8; ++e) { const int pp = p0 + e, p = pp & 63; const float cr = Cre[c * 64 + p], ci = Cim[c * 64 + p], er = Ere[(i + 1) * 64 + p], ei = Eim[(i + 1) * 64 + p];
                v[e] = (pp < 64) ? (cr * er - ci * ei) : -(cr * ei + ci * er); } }
        v4u o; o.x = pk2(v[0], v[1]); o.y = pk2(v[2], v[3]); o.z = pk2(v[4], v[5]); o.w = pk2(v[6], v[7]);
        *(v4u*)(TV + (size_t)n * KSS + k8 * 8) = o; }
    bf16* WW = (bf16*)(F.ws + WS_BW) + ((size_t)(l * SG + g) * 128) * KT;
    for (int idx = tid; idx < 128 * 64; idx += 512) { const int n = idx >> 6, k8 = idx & 63, p = n & 63, ip = k8 >> 1, c0 = (k8 & 1) * 8; float v[8];
        const float er = Ere[(31 - ip) * 64 + p], ei = Eim[(31 - ip) * 64 + p];
#pragma unroll
        for (int e = 0; e < 8; ++e) { const float br = Bre[p * 16 + c0 + e], bi = Bim[p * 16 + c0 + e]; v[e] = (n < 64) ? (er * br - ei * bi) : (er * bi + ei * br); }
        v4u o; o.x = pk2(v[0], v[1]); o.y = pk2(v[2], v[3]); o.z = pk2(v[4], v[5]); o.w = pk2(v[6], v[7]);
        *(v4u*)(WW + (size_t)n * KT + k8 * 8) = o; }
    if (tid < 64) { float* al = (float*)(F.ws + WS_AL) + ((size_t)(l * SG + g) * SP + tid) * 2; al[0] = Ere[32 * 64 + tid]; al[1] = Eim[32 * 64 + tid]; }
    __syncthreads();
}
__device__ __forceinline__ void pro_ssm(const CArgs* ap, Frame& F) {
    for (int it = F.vcu; it < DEPTH * SG; it += F.G) ssm_pre_item(ap, F, it);
    if (F.vcu == F.G - 1) { bf16* pad = (bf16*)(F.ws + WS_BW) + (size_t)DEPTH * SG * 128 * KT; for (int i = F.tid; i < 128 * KT / 8; i += 512) ((v4u*)pad)[i] = (v4u){0u, 0u, 0u, 0u}; }
}
__device__ __forceinline__ void pro_mod(const CArgs* ap, Frame& F) {
    LAS float* sc = (LAS float*)F.lds; LAS float* red = sc + 4096;
    for (int i = F.tid; i < NB * DM; i += 512) { const float x = ((const float*)ap->in[1])[i]; sc[i] = x * sigmoidf_(x); }
    __syncthreads();
    if (F.G == 256) { for (int it = F.vcu; it < 512; it += 256) mod_item(ap, F, it, sc, red); if (F.vcu >= 192) mod_item(ap, F, 512 + F.vcu - 192, sc, red); }
    else
    for (int it = F.vcu; it < DEPTH * 144; it += F.G) mod_item(ap, F, it, sc, red);
    __syncthreads();
}
__device__ __forceinline__ void pro_wt(const CArgs* ap, Frame& F) {
    LAS float* scr = (LAS float*)(F.lds + F.wave * 16384); const int gw = F.vcu * 8 + F.wave, NGW = F.G * 8;
    if (F.G == 256) {
        for (int i = 0; i < 16; ++i) wt_item(ap, F.ws, gw + 2048 * i, scr, F.lane);
        if (F.vcu >= 128) for (int it = 32768 + (F.vcu - 128) * 8 + F.wave; it < IT_ALL; it += 1024) wt_item(ap, F.ws, it, scr, F.lane);
    } else
    for (int it = gw; it < IT_ALL; it += NGW) wt_item(ap, F.ws, it, scr, F.lane);
}
__device__ __forceinline__ void pro_rope(const CArgs* ap, Frame& F) {
    const float invf[8] = {1.0f, 0.193922758102417f, 0.03760603070259094f, 0.00729266507551074f, 0.001414213445968926f, 0.00027424818836152554f, 5.318296462064609e-05f, 1.0313385246263351e-05f};
    const double INV2PI = 0.15915494309189533576888;
    float* rp = (float*)(F.ws + WS_ROPE); const int* pos = (const int*)ap->in[2];
    for (int idx = F.vcu * 512 + F.tid; idx < MTOK * 8; idx += F.G * 512) { const int r = idx >> 3, i = idx & 7; float f = invf[0];
#pragma unroll
        for (int j = 1; j < 8; ++j) f = (i == j) ? invf[j] : f;
        const float ang = (float)pos[r] * f; const double rev = (double)ang * INV2PI; const float fr = (float)(rev - __builtin_rint(rev));
        rp[(size_t)r * 16 + i] = __builtin_amdgcn_cosf(fr); rp[(size_t)r * 16 + 8 + i] = __builtin_amdgcn_sinf(fr); }
}

template <bool XBF> __device__ __forceinline__ int norm_col(int lane, int q) { return XBF ? 8 * lane + 512 * (q >> 1) + 4 * (q & 1) : 4 * lane + 256 * q; }
template <bool XBF> __device__ __forceinline__ void norm_load(const void* x, int r, int lane, f32x4 (&v)[4]) {
    if constexpr (XBF) { const v4u* xr = (const v4u*)((const bf16*)x + (size_t)r * DM) + lane;
#pragma unroll
        for (int j = 0; j < 2; ++j) { const v4u q = xr[64 * j]; v[2 * j] = (f32x4){bflo(q.x), bfhi(q.x), bflo(q.y), bfhi(q.y)}; v[2 * j + 1] = (f32x4){bflo(q.z), bfhi(q.z), bflo(q.w), bfhi(q.w)}; }
    } else { const f32x4* xr = (const f32x4*)((const float*)x + (size_t)r * DM) + lane;
#pragma unroll
        for (int j = 0; j < 4; ++j) v[j] = xr[64 * j]; }
}
template <bool F8OUT, bool XBF> __device__ __forceinline__ void norm_mod_phase(Frame& F, const void* x, const float* g, const float* modl  , int ksh, bf16* H, bf16* XB) {
    const int gw = F.vcu * 8 + F.wave, NGW = F.G * 8, rpw = (MTOK + NGW - 1) / NGW;
    int r0 = gw * rpw, r1 = r0 + rpw; if (r1 > MTOK) r1 = MTOK;
    f32x4 gs[4], sh[4]; int curb = -1;
    for (int r = r0; r < r1; ++r) {
        const int b = r >> 13;
        if (b != curb) { curb = b; const float* sp = modl + (size_t)b * (NMOD * DM) + (size_t)ksh * DM;
#pragma unroll
            for (int j = 0; j < 4; ++j) { const int c = norm_col<XBF>(F.lane, j); const f32x4 gg = *(const f32x4*)(g + c), sc = *(const f32x4*)(sp + DM + c); gs[j] = gg * (sc + 1.0f); sh[j] = *(const f32x4*)(sp + c); } }
        f32x4 v[4]; float s = 0.f;
        norm_load<XBF>(x, r, F.lane, v);
#pragma unroll
        for (int j = 0; j < 4; ++j) s += (v[j].x * v[j].x + v[j].y * v[j].y) + (v[j].z * v[j].z + v[j].w * v[j].w);
        const float rs = __builtin_amdgcn_rsqf(wave_sum(s) * (1.f / DM) + EPS);
        if constexpr (!XBF) { unsigned long long* o8 = (unsigned long long*)(XB + (size_t)r * DM) + F.lane;
#pragma unroll
            for (int j = 0; j < 4; ++j) o8[64 * j] = (unsigned long long)pk2(v[j].x, v[j].y) | ((unsigned long long)pk2(v[j].z, v[j].w) << 32); }
        f32x4 y[4];
#pragma unroll
        for (int j = 0; j < 4; ++j) y[j] = v[j] * rs * gs[j] + sh[j];
        if constexpr (F8OUT) {
            if constexpr (XBF) { unsigned long long* o8 = (unsigned long long*)((unsigned char*)H + (size_t)r * DM) + F.lane;
#pragma unroll
                for (int j = 0; j < 2; ++j) { const f32x4 a = y[2 * j] * 2.0f, c = y[2 * j + 1] * 2.0f; o8[64 * j] = (unsigned long long)pk8(a.x, a.y, a.z, a.w) | ((unsigned long long)pk8(c.x, c.y, c.z, c.w) << 32); }
            } else { unsigned* o4 = (unsigned*)((unsigned char*)H + (size_t)r * DM) + F.lane;
#pragma unroll
                for (int j = 0; j < 4; ++j) { const f32x4 a = y[j] * 2.0f; o4[64 * j] = pk8(a.x, a.y, a.z, a.w); } }
        } else {
            static_assert(XBF || F8OUT, "the f32 input only feeds the first FFN norm");
            v4u* o16 = (v4u*)(H + (size_t)r * DM) + F.lane;
#pragma unroll
            for (int j = 0; j < 2; ++j) { v4u o; o.x = pk2(y[2 * j].x, y[2 * j].y); o.y = pk2(y[2 * j].z, y[2 * j].w); o.z = pk2(y[2 * j + 1].x, y[2 * j + 1].y); o.w = pk2(y[2 * j + 1].z, y[2 * j + 1].w); o16[64 * j] = o; }
        }
    }
}
__device__ __forceinline__ void final_norm_phase(Frame& F, const bf16* x, const float* g, float* out) {
    const int gw = F.vcu * 8 + F.wave, NGW = F.G * 8;
    f32x4 gs[4];
#pragma unroll
    for (int j = 0; j < 4; ++j) gs[j] = *(const f32x4*)(g + norm_col<true>(F.lane, j));
    for (int r = gw; r < MTOK; r += NGW) {
        f32x4 v[4]; float s = 0.f;
        norm_load<true>(x, r, F.lane, v);
#pragma unroll
        for (int j = 0; j < 4; ++j) s += (v[j].x * v[j].x + v[j].y * v[j].y) + (v[j].z * v[j].z + v[j].w * v[j].w);
        const float rs = __builtin_amdgcn_rsqf(wave_sum(s) * (1.f / DM) + EPS);
#pragma unroll
        for (int j = 0; j < 4; ++j) *(f32x4*)(out + (size_t)r * DM + norm_col<true>(F.lane, j)) = v[j] * rs * gs[j];
    }
}
__device__ __forceinline__ void ssm_norm_phase(Frame& F, const bf16* Y2, const float* gain, bf16* MIX) {
    const int gw = F.vcu * 8 + F.wave, NGW = F.G * 8;
    const f32x4 g0 = *(const f32x4*)(gain + 8 * F.lane), g1 = *(const f32x4*)(gain + 8 * F.lane + 4);
    for (int r = gw; r < MTOK; r += NGW) {
        const v4u yv = *((const v4u*)(Y2 + (size_t)r * SSM_W) + F.lane);
        float y[8] = {bflo(yv.x), bfhi(yv.x), bflo(yv.y), bfhi(yv.y), bflo(yv.z), bfhi(yv.z), bflo(yv.w), bfhi(yv.w)};
        float s = 0.f;
#pragma unroll
        for (int e = 0; e < 8; ++e) s += y[e] * y[e];
        const float rs = __builtin_amdgcn_rsqf(wave_sum(s) * (1.f / SSM_W) + EPS);
        v4u w; w.x = pk2(y[0] * rs * g0[0], y[1] * rs * g0[1]); w.y = pk2(y[2] * rs * g0[2], y[3] * rs * g0[3]); w.z = pk2(y[4] * rs * g1[0], y[5] * rs * g1[1]); w.w = pk2(y[6] * rs * g1[2], y[7] * rs * g1[3]);
        *((v4u*)(MIX + (size_t)r * DM + ATTN_W) + F.lane) = w;
    }
}
__device__ __forceinline__ void ssm_scan_phase(Frame& F, const float* AL  , const float* SINC, bf16* UG) {
    if (F.wave != 0) return;
    for (int it = F.vcu; it < NB * SG; it += F.G) {
        const int b = it >> 5, g = it & 31, p = F.lane;
        const float ar = AL[(g * SP + p) * 2], ai = AL[(g * SP + p) * 2 + 1];
        const size_t row0 = (size_t)g * NCHK + (size_t)b * CHB;
        const float* sp = SINC + row0 * 128 + p; bf16* hp = UG + row0 * KSS + KT + p;
        float hr = 0.f, hi = 0.f;
        float sr[16], si[16];
#pragma unroll
        for (int j = 0; j < 16; ++j) { sr[j] = sp[(size_t)j * 128]; si[j] = sp[(size_t)j * 128 + 64]; }
#pragma unroll 1
        for (int j0 = 0; j0 < CHB; j0 += 16) {
            float nr_[16], ni_[16];
            if (j0 + 16 < CHB) {
#pragma unroll
                for (int j = 0; j < 16; ++j) { nr_[j] = sp[(size_t)(j0 + 16 + j) * 128]; ni_[j] = sp[(size_t)(j0 + 16 + j) * 128 + 64]; } }
#pragma unroll
            for (int j = 0; j < 16; ++j) {
                hp[(size_t)(j0 + j) * KSS] = (bf16)f2bf(hr); hp[(size_t)(j0 + j) * KSS + 64] = (bf16)f2bf(hi);
                const float nr = ar * hr - ai * hi + sr[j], ni = ar * hi + ai * hr + si[j]; hr = nr; hi = ni;
            }
            if (j0 + 16 < CHB) {
#pragma unroll
                for (int j = 0; j < 16; ++j) { sr[j] = nr_[j]; si[j] = ni_[j]; } }
        }
    }
}

__device__ __forceinline__ unsigned comp_key(float sc, int s) {
    sc = sc + 0.0f; unsigned u = __builtin_bit_cast(unsigned, sc); u = (u & 0x80000000u) ? ~u : (u | 0x80000000u);
    return (u & 0xFFFFE000u) | (unsigned)(8191 - s);
}
#if !ATTN_FAST
__device__ __forceinline__ void attn_simple_phase(Frame& F, const bf16* Q, const bf16* KB, const bf16* VB, const bf16* QI, const bf16* KI, const float* WI, const float* again, bf16* MIX) {
    LAS unsigned* comp = (LAS unsigned*)F.lds;
    LAS float* lg = (LAS float*)(F.lds + 32768);
    LAS float* qs = lg + 2048;
    LAS float* qis = qs + 512;
    LAS float* wis = qis + 256;
    LAS unsigned* hist = (LAS unsigned*)(wis + 8);
    LAS unsigned* sel = hist + 256;
    LAS unsigned* misc = sel + 256;
    LAS float* red = (LAS float*)(misc + 16);
    const int tid = F.tid;
    asm volatile("" : "+v"(Q), "+v"(KB), "+v"(VB), "+v"(QI), "+v"(KI), "+v"(WI), "+v"(again), "+v"(MIX));
#pragma unroll 1
    for (int r = F.vcu; r < MTOK; r += F.G) {
        const int b = r >> 13, t = r & 8191, n = ((t >> 6) + 1) << 6;
        qs[tid] = bf2f(Q[(size_t)r * ATTN_W + tid]);
        if (tid < 256) qis[tid] = bf2f(QI[(size_t)r * 256 + tid]);
        if (tid < 4) wis[tid] = WI[(size_t)r * 4 + tid];
        __syncthreads();
#pragma unroll 1
        for (int s0 = 0; s0 < n; s0 += 512) {
            const int s = s0 + tid; if (s >= n) continue;
            const v4u* kp = (const v4u*)(KI + (size_t)(b * SEQ + s) * 64);
            float a0 = 0.f, a1 = 0.f, a2 = 0.f, a3 = 0.f;
#pragma unroll 1
            for (int j = 0; j < 8; ++j) { const v4u kv = kp[j]; const float kf[8] = {bflo(kv.x), bfhi(kv.x), bflo(kv.y), bfhi(kv.y), bflo(kv.z), bfhi(kv.z), bflo(kv.w), bfhi(kv.w)};
#pragma unroll
                for (int e = 0; e < 8; ++e) { const int d = 8 * j + e; a0 += qis[d] * kf[e]; a1 += qis[64 + d] * kf[e]; a2 += qis[128 + d] * kf[e]; a3 += qis[192 + d] * kf[e]; } }
            const float sc = wis[0] * fmaxf(a0, 0.f) + wis[1] * fmaxf(a1, 0.f) + wis[2] * fmaxf(a2, 0.f) + wis[3] * fmaxf(a3, 0.f);
            comp[s] = comp_key(sc, s);
        }
        __syncthreads();
        int nsel;
        if (n > TOPK) {
            unsigned prefix = 0u, kneed = TOPK;
#pragma unroll 1
            for (int round = 0; round < 4; ++round) {
                const int shift = 24 - 8 * round;
                if (tid < 256) hist[tid] = 0u;
                __syncthreads();
#pragma unroll 1
                for (int s0 = 0; s0 < n; s0 += 512) { const int s = s0 + tid; const unsigned c = (s < n) ? comp[s] : 0u; const bool match = (s < n) && ((round == 0) || ((c >> (shift + 8)) == prefix));
                    if (match) __hip_atomic_fetch_add(&hist[(c >> shift) & 255u], 1u, __ATOMIC_RELAXED, __HIP_MEMORY_SCOPE_WORKGROUP); }
                __syncthreads();
                if (tid < 64) {
                    const unsigned h0 = hist[4 * tid], h1 = hist[4 * tid + 1], h2 = hist[4 * tid + 2], h3 = hist[4 * tid + 3], tot = h0 + h1 + h2 + h3;
                    unsigned v = tot;
#pragma unroll
                    for (int o = 1; o < 64; o <<= 1) { const unsigned up = __shfl_down(v, o); if (tid + o < 64) v += up; }
                    const unsigned above = v - tot, c3 = above + h3, c2 = c3 + h2, c1 = c2 + h1, c0 = c1 + h0;
                    const bool f3 = (c3 >= kneed) & (above < kneed), f2 = (c2 >= kneed) & (c3 < kneed), f1 = (c1 >= kneed) & (c2 < kneed), f0 = (c0 >= kneed) & (c1 < kneed);
                    const unsigned dsel = 4u * tid + (f3 ? 3u : f2 ? 2u : f1 ? 1u : 0u), below = f3 ? above : f2 ? c3 : f1 ? c2 : c1;
                    if (f3 | f2 | f1 | f0) { misc[0] = dsel; misc[1] = kneed - below; }
                }
                __syncthreads();
                prefix = (prefix << 8) | misc[0]; kneed = misc[1];
            }
            unsigned base = 0u;
#pragma unroll 1
            for (int s0 = 0; s0 < n; s0 += 512) {
                const int s = s0 + tid; const bool f = (s < n) && (comp[s] >= prefix);
                const unsigned long long bal = __ballot(f);
                if (F.lane == 0) misc[8 + F.wave] = (unsigned)__popcll(bal);
                __syncthreads();
                unsigned off = base, tot = 0u;
#pragma unroll
                for (int w = 0; w < 8; ++w) { const unsigned c = misc[8 + w]; if (w < F.wave) off += c; tot += c; }
                if (f) { const unsigned pos = off + (unsigned)__popcll(bal & ((1ull << F.lane) - 1ull)); if (pos < TOPK) sel[pos] = (unsigned)s; }
                base += tot;
                __syncthreads();
            }
            nsel = TOPK;
        } else { if (tid < n) sel[tid] = (unsigned)tid; nsel = n; }
        __syncthreads();
        {
            const int k = tid & 255, hh = tid >> 8; float a0 = 0.f, a1 = 0.f, a2 = 0.f, a3 = 0.f;
            if (k < nsel) { const v4u* kp = (const v4u*)(KB + (size_t)(b * SEQ + (int)sel[k]) * 64); const LAS float* qh = qs + hh * 256;
#pragma unroll 1
                for (int j = 0; j < 8; ++j) { const v4u kv = kp[j]; const float kf[8] = {bflo(kv.x), bfhi(kv.x), bflo(kv.y), bfhi(kv.y), bflo(kv.z), bfhi(kv.z), bflo(kv.w), bfhi(kv.w)};
#pragma unroll
                    for (int e = 0; e < 8; ++e) { const int d = 8 * j + e; a0 += qh[d] * kf[e]; a1 += qh[64 + d] * kf[e]; a2 += qh[128 + d] * kf[e]; a3 += qh[192 + d] * kf[e]; } } }
            const float ninf = -__builtin_inff(); const bool ok = k < nsel;
            lg[(4 * hh + 0) * 256 + k] = ok ? a0 : ninf; lg[(4 * hh + 1) * 256 + k] = ok ? a1 : ninf; lg[(4 * hh + 2) * 256 + k] = ok ? a2 : ninf; lg[(4 * hh + 3) * 256 + k] = ok ? a3 : ninf;
        }
        __syncthreads();
        {
            LAS float* lh = lg + F.wave * 256; float v0 = lh[F.lane], v1 = lh[F.lane + 64], v2 = lh[F.lane + 128], v3 = lh[F.lane + 192];
            const float mx = wave_max(fmaxf(fmaxf(v0, v1), fmaxf(v2, v3)));
            v0 = __builtin_amdgcn_exp2f(v0 - mx); v1 = __builtin_amdgcn_exp2f(v1 - mx); v2 = __builtin_amdgcn_exp2f(v2 - mx); v3 = __builtin_amdgcn_exp2f(v3 - mx);
            const float inv = 1.0f / wave_sum((v0 + v1) + (v2 + v3));
            lh[F.lane] = v0 * inv; lh[F.lane + 64] = v1 * inv; lh[F.lane + 128] = v2 * inv; lh[F.lane + 192] = v3 * inv;
        }
        __syncthreads();
        {
            const LAS float* ph = lg + F.wave * 256; const bf16* vb = VB + (size_t)b * SEQ * 64 + F.lane; float o = 0.f;
#pragma unroll 2
            for (int k = 0; k < nsel; k += 4) { const float x0 = bf2f(vb[(size_t)sel[k] * 64]), x1 = bf2f(vb[(size_t)sel[k + 1] * 64]), x2 = bf2f(vb[(size_t)sel[k + 2] * 64]), x3 = bf2f(vb[(size_t)sel[k + 3] * 64]);
                o += ph[k] * x0 + ph[k + 1] * x1 + ph[k + 2] * x2 + ph[k + 3] * x3; }
            const float ss = wave_sum(o * o);
            if (F.lane == 0) red[F.wave] = ss;
            __syncthreads();
            float tot = 0.f;
#pragma unroll
            for (int w = 0; w < 8; ++w) tot += red[w];
            const float rs = __builtin_amdgcn_rsqf(tot * (1.f / ATTN_W) + EPS);
            MIX[(size_t)r * DM + tid] = (bf16)f2bf(o * rs * again[tid]);
        }
        __syncthreads();
    }
}
#endif

typedef short bf16x8v __attribute__((ext_vector_type(8)));
typedef short v4i16_t __attribute__((ext_vector_type(4)));
typedef float f32x16 __attribute__((ext_vector_type(16)));
constexpr int AQ = 32, ACAP = 1024, ATRIG = 768;
constexpr int A_CNT = LDSCTL_OFF + 1024, A_THR = A_CNT + 128, A_HIST = LDSCTL_OFF + 2048, A_SEL = LDSCTL_OFF + 10240;
constexpr int A_OK = A_THR + 128;
constexpr int A_DUMP = A_SEL;
constexpr int V_RS = 144;
static_assert(A_SEL + AQ * 256 * 2 <= LDS_BYTES, "attention LDS map");
constexpr float QK_SCALE = 0.125f * 1.4426950408889634f;

__device__ __forceinline__ unsigned ord_of(unsigned c) { const unsigned m = (unsigned)((int)c >> 31); return c ^ ((m & 0x7FFFE000u) | 0x80000000u); }
#define DPPU(old, x, ctrl, rm) ((unsigned)__builtin_amdgcn_update_dpp((int)(old), (int)(x), ctrl, rm, 0xF, false))
__device__ __forceinline__ unsigned wave_scan_add(unsigned x) {
    x += DPPU(0u, x, 0x111, 0xF); x += DPPU(0u, x, 0x112, 0xF); x += DPPU(0u, x, 0x114, 0xF); x += DPPU(0u, x, 0x118, 0xF);
    x += DPPU(0u, x, 0x142, 0xA); x += DPPU(0u, x, 0x143, 0xC); return x; }
__device__ __forceinline__ unsigned wave_red_max(unsigned x) {
    x = max(x, DPPU(0u, x, 0x111, 0xF)); x = max(x, DPPU(0u, x, 0x112, 0xF)); x = max(x, DPPU(0u, x, 0x114, 0xF)); x = max(x, DPPU(0u, x, 0x118, 0xF));
    x = max(x, DPPU(0u, x, 0x142, 0xA)); x = max(x, DPPU(0u, x, 0x143, 0xC)); return (unsigned)__builtin_amdgcn_readlane((int)x, 63); }
__device__ __forceinline__ unsigned wave_red_min(unsigned x) {
    x = min(x, DPPU(~0u, x, 0x111, 0xF)); x = min(x, DPPU(~0u, x, 0x112, 0xF)); x = min(x, DPPU(~0u, x, 0x114, 0xF)); x = min(x, DPPU(~0u, x, 0x118, 0xF));
    x = min(x, DPPU(~0u, x, 0x142, 0xA)); x = min(x, DPPU(~0u, x, 0x143, 0xC)); return (unsigned)__builtin_amdgcn_readlane((int)x, 63); }
__device__ __forceinline__ unsigned lane_count_ge(const unsigned (&o)[16], const unsigned mid) {
    unsigned c0 = 0u, c1 = 0u, c2 = 0u, c3 = 0u;
#pragma unroll
    for (int j = 0; j < 16; j += 4) { unsigned long long m0, m1, m2, m3, d0, d1, d2, d3;
        asm volatile("v_cmp_le_u32 %4, %12, %13\n\tv_cmp_le_u32 %5, %12, %14\n\tv_cmp_le_u32 %6, %12, %15\n\tv_cmp_le_u32 %7, %12, %16\n\t"
                     "v_addc_co_u32 %0, %8, 0, %0, %4\n\tv_addc_co_u32 %1, %9, 0, %1, %5\n\tv_addc_co_u32 %2, %10, 0, %2, %6\n\tv_addc_co_u32 %3, %11, 0, %3, %7"
                     : "+v"(c0), "+v"(c1), "+v"(c2), "+v"(c3), "=&s"(m0), "=&s"(m1), "=&s"(m2), "=&s"(m3), "=&s"(d0), "=&s"(d1), "=&s"(d2), "=&s"(d3)
                     : "s"(mid), "v"(o[j]), "v"(o[j + 1]), "v"(o[j + 2]), "v"(o[j + 3])); }
    return (c0 + c1) + (c2 + c3);
}
template <int MODE, unsigned KTH_> __device__ __forceinline__ void wave_select(LAS unsigned* cand, LAS unsigned* cntp, LAS float* thrp, LAS unsigned* H, unsigned short* selq, const int lane, const int qx, const unsigned kth_rt = KTH_, const unsigned kmax_rt = 384u) {
    const unsigned KTH = (MODE == 0) ? kth_rt : KTH_, KMAX = (MODE == 0) ? kmax_rt : (MODE == 1) ? KTH_ : KTH_ + 16u;
    const int m = __builtin_amdgcn_readfirstlane((int)*cntp);
    unsigned e[16], o[16]; unsigned mx = 0u, mn = ~0u;
#pragma unroll
    for (int j = 0; j < 4; ++j) { const int i0 = 4 * (lane + 64 * j); v4u q = (v4u){0u, 0u, 0u, 0u}; if (256 * j < m) q = *(LAS v4u*)(cand + i0);
#pragma unroll
        for (int k = 0; k < 4; ++k) { const bool v = ((i0 + k) ^ qx) < m; e[4 * j + k] = q[k]; const unsigned ok = ord_of(q[k]); o[4 * j + k] = v ? ok : 0u; mx = max(mx, v ? ok : 0u); mn = min(mn, v ? ok : ~0u); } }
    mx = wave_red_max(mx); mn = wave_red_min(mn);
    unsigned lo = mn, hi = mx + 1u, T = mn;
    bool done = false;
    if (MODE == 1 && (unsigned)m > KMAX) {
        unsigned slo = mn >> 13, shi = (mx >> 13) + 1u, clo = (unsigned)m, chi = 0u;
#pragma unroll 1
        while (shi - slo > 1u) {
            const unsigned smid = slo + ((shi - slo) >> 1), mid = smid << 13;
            unsigned cl = 0u;
            cl = lane_count_ge(o, mid);
            const unsigned c = (unsigned)__builtin_amdgcn_readlane((int)wave_scan_add(cl), 63);
            if (c >= KTH) { slo = smid; clo = c; } else { shi = smid; chi = c; }
        }
        lo = slo << 13; hi = shi << 13;
        if (clo == KTH) { T = lo; done = true; }
        else if (KTH - chi <= 4u) {
            unsigned Tc = hi;
#pragma unroll 1
            for (unsigned i = chi; i < KTH; ++i) { unsigned bm = 0u;
#pragma unroll
                for (int j = 0; j < 16; ++j) { const unsigned v = (o[j] >= lo && o[j] < Tc) ? o[j] : 0u; bm = max(bm, v); }
                Tc = wave_red_max(bm); }
            T = Tc; done = true;
        }
    }
    if (!done && (unsigned)m > KMAX) {
#pragma unroll 1
        for (int it = 0; it < 40; ++it) {
            const unsigned mid = lo + ((hi - lo) >> 1);
            unsigned cl = 0u;
            cl = lane_count_ge(o, mid);
            const unsigned c = (unsigned)__builtin_amdgcn_readlane((int)wave_scan_add(cl), 63);
            if (c > KMAX) lo = mid; else if (c < KTH) hi = mid; else { T = mid; break; }
            if (hi - lo <= 1u) { T = lo; break; }
        }
    }
    if (MODE == 2) {
        if (lane == 0) { *cntp = 0u; const unsigned cb = (T & 0x80000000u) ? (T & 0x7FFFE000u) : ((T ^ 0xFFFFE000u) | 0x1FFFu); *thrp = __builtin_bit_cast(float, cb); }
    } else if (MODE == 0) {
        unsigned base = 0u;
#pragma unroll
        for (int j = 0; j < 16; ++j) { const bool f = (o[j] != 0u) && (o[j] >= T); const unsigned long long bal = __ballot(f);
            const unsigned pos = base + (unsigned)__builtin_amdgcn_mbcnt_hi((unsigned)(bal >> 32), __builtin_amdgcn_mbcnt_lo((unsigned)bal, 0u));
            if (f) cand[pos ^ (unsigned)qx] = e[j]; base += (unsigned)__popcll(bal); }
        if (lane == 0) { *cntp = base; const unsigned cb = (T & 0x80000000u) ? (T & 0x7FFFE000u) : ((T ^ 0xFFFFE000u) | 0x1FFFu); *thrp = __builtin_bit_cast(float, cb); }
    } else {
        LAS unsigned* BM = H;
        *(LAS v4u*)(BM + 4 * lane) = (v4u){0u, 0u, 0u, 0u};
#pragma unroll
        for (int j = 0; j < 16; ++j) { const bool f = (o[j] != 0u) && (o[j] >= T); const unsigned key = 8191u - (e[j] & 0x1FFFu);
            if (f) __hip_atomic_fetch_or(&BM[key >> 5], 1u << (key & 31u), __ATOMIC_RELAXED, __HIP_MEMORY_SCOPE_WAVEFRONT); }
        const v4u w4 = *(LAS v4u*)(BM + 4 * lane);
        const unsigned tot = __popc(w4.x) + __popc(w4.y) + __popc(w4.z) + __popc(w4.w);
        unsigned pos = wave_scan_add(tot) - tot;
        LAS unsigned short* st = (LAS unsigned short*)H;
#pragma unroll 1
        for (int k = 0; k < 4; ++k) { unsigned ww = (k == 0) ? w4.x : (k == 1) ? w4.y : (k == 2) ? w4.z : w4.w;
            while (ww) { const unsigned bit = (unsigned)__builtin_ctz(ww); ww &= ww - 1u; if (pos < TOPK) st[pos] = (unsigned short)(128u * lane + 32u * k + bit); ++pos; } }
        *((unsigned long long*)selq + lane) = *((LAS unsigned long long*)st + lane);
    }
}

__device__ __forceinline__ void lds_barrier() { asm volatile("s_waitcnt lgkmcnt(0)\n\ts_barrier" ::: "memory"); }
__device__ __forceinline__ int attn_unit_of(const Frame& F, int ui) {
    if (F.G == 256) { const int b = F.vcu >> 6, j = F.vcu & 63; const int qt = (ui == 0) ? j : (ui == 1) ? 127 - j : (ui == 2) ? 128 + j : 255 - j; return 4 * qt + b; }
    const int u = F.vcu + ui * F.G; return u < 1024 ? u : -1;
}
__device__ __forceinline__ void idx_tile(const bf16x8v (&Ak)[4], const bf16x8v (&Bq)[4][4], const float (&lo)[4], const float (&hi)[4], const int t, const int h2, const float thr_r,
                                         LAS unsigned* cntq, LAS unsigned* myc, LAS unsigned* dump, const unsigned qx) {
    float sc[16];
#pragma unroll
    for (int hd = 0; hd < 4; ++hd) { f32x16 acc;
#pragma unroll
        for (int i = 0; i < 16; ++i) acc[i] = 0.f;
#pragma unroll
        for (int kk = 0; kk < 4; ++kk) acc = __builtin_amdgcn_mfma_f32_32x32x16_bf16(Ak[kk], Bq[hd][kk], acc, 0, 0, 0);
#pragma unroll
        for (int i = 0; i < 16; ++i) { const float mclamp = __builtin_amdgcn_fmed3f(acc[i], lo[hd], hi[hd]); sc[i] = (hd == 0) ? mclamp : sc[i] + mclamp; } }
    const unsigned Bt = (unsigned)(8191 - 32 * t) ^ (unsigned)(4 * h2);
    unsigned c[16]; unsigned pm = 0u;
#pragma unroll
    for (int i = 0; i < 16; ++i) { const unsigned rowc = (unsigned)((i & 3) + 8 * (i >> 2));
        c[i] = (__builtin_bit_cast(unsigned, sc[i]) & 0xFFFFE000u) | (Bt ^ rowc);
        asm volatile("v_cmp_le_f32 vcc, %1, %2\n\tv_addc_co_u32 %0, vcc, %0, %0, vcc" : "+v"(pm) : "v"(thr_r), "v"(c[i]) : "vcc"); }
    if (pm) {
        unsigned slot = __hip_atomic_fetch_add(cntq, (unsigned)__popc(pm), __ATOMIC_RELAXED, __HIP_MEMORY_SCOPE_WORKGROUP);
#pragma unroll
        for (int i = 0; i < 16; ++i) { const unsigned p = (pm >> (15 - i)) & 1u; LAS unsigned* dstp = (p && slot < (unsigned)ACAP) ? (myc + (slot ^ qx)) : dump; *dstp = c[i]; slot += p; }
    }
}
template <int MODE> __device__ __forceinline__ void attn_index_phase(Frame& F, const int ui, const bf16* QI, const bf16* KI, const float* WI, unsigned short* SEL, const int safe = 0) {
    const int tid = F.tid, lane = F.lane, wave = F.wave;
    LAS unsigned* const cand = (LAS unsigned*)F.lds;
    LAS unsigned* const cnt = (LAS unsigned*)(F.lds + A_CNT);
    LAS float* const thr = (LAS float*)(F.lds + A_THR);
    LAS unsigned* const H = (LAS unsigned*)(F.lds + A_HIST) + wave * 256;
    const int r32 = lane & 31, h2 = lane >> 5;
    {
        const int u = attn_unit_of(F, ui); if (u < 0) return;
        const int b = u & 3, qt = u >> 2, t0 = qt * AQ, q0 = b * SEQ + t0, n = ((t0 >> 6) + 1) << 6;
        unsigned short* const sel = SEL + (size_t)q0 * 256;
        if (n <= TOPK) { if (MODE == 1 && tid == 0) *(LAS unsigned*)(F.lds + A_OK) = 1u; return; }
        if constexpr (MODE == 0) {
        if (tid < AQ) { cnt[tid] = 0u; thr[tid] = -__builtin_inff(); }
        __syncthreads();
        {
            bf16x8v Bq[4][4]; float lo[4], hi[4];
            { const f32x4 wv = *(const f32x4*)(WI + (size_t)(q0 + r32) * 4);
#pragma unroll
              for (int hd = 0; hd < 4; ++hd) { const float w = wv[hd]; lo[hd] = (w >= 0.f) ? 0.f : -__builtin_inff(); hi[hd] = (w >= 0.f) ? __builtin_inff() : 0.f;
#pragma unroll
                  for (int kk = 0; kk < 4; ++kk) { const v4u qv = *(const v4u*)(QI + (size_t)q0 * 256 + (size_t)(((hd * 8 + 2 * kk + h2) * 32 + r32) * 8));
                      v4u o; o.x = pk2(bflo(qv.x) * w, bfhi(qv.x) * w); o.y = pk2(bflo(qv.y) * w, bfhi(qv.y) * w); o.z = pk2(bflo(qv.z) * w, bfhi(qv.z) * w); o.w = pk2(bflo(qv.w) * w, bfhi(qv.w) * w);
                      Bq[hd][kk] = __builtin_bit_cast(bf16x8v, o); } } }
            const int ntile = n >> 5, nround = (ntile + 7) >> 3;
            const bf16* kib = KI + (size_t)b * SEQ * 64 + (size_t)((h2 * 32 + r32) * 8);
            float thr_r = -__builtin_inff();
            bool first = true; unsigned kspec = (unsigned)(SPEC_NUM * 1024) / (unsigned)n; kspec = (safe || kspec > (unsigned)TOPK) ? (unsigned)TOPK : (kspec < 32u ? 32u : kspec);
            LAS unsigned* const myc = cand + r32 * ACAP;
            LAS unsigned* const dump = (LAS unsigned*)(F.lds + A_DUMP) + tid;
            bf16x8v Ak[4];
            { const int t = wave; if (t < ntile) {
#pragma unroll
                for (int kk = 0; kk < 4; ++kk) Ak[kk] = *(const bf16x8v*)(kib + (size_t)t * 32 * 64 + 512 * kk); } }
            bf16x8v An[4];
#pragma unroll
            for (int kk = 0; kk < 4; ++kk) An[kk] = Ak[kk];
#pragma unroll 1
            for (int rd = 0; rd < nround; ++rd) {
                const int t = 8 * rd + wave;
                if (t < ntile) {
#pragma unroll
                    for (int kk = 0; kk < 4; ++kk) Ak[kk] = An[kk];
                    const int tn = t + 8;
                    if (tn < ntile) {
#pragma unroll
                        for (int kk = 0; kk < 4; ++kk) An[kk] = *(const bf16x8v*)(kib + (size_t)tn * 32 * 64 + 512 * kk); }
                    idx_tile(Ak, Bq, lo, hi, t, h2, thr_r, cnt + r32, myc, dump, (unsigned)r32);
                    if (PROBE_DUP == 11) idx_tile(Ak, Bq, lo, hi, t, h2, __builtin_inff(), cnt + r32, myc, dump, (unsigned)r32);
                }
                lds_barrier();
                if (PROBE_DUP == 10) { lds_barrier(); lds_barrier(); }
                const unsigned cq = (lane < AQ) ? cnt[lane] : 0u;
                const unsigned need = (unsigned)__ballot(cq > (unsigned)ATRIG), comp = (unsigned)__ballot(cq > 448u);
                lds_barrier();
                if (DEBUG_STAT == 9 && need && tid == 0) atomicAdd((unsigned*)(F.ws + WS_CTL) + 32768 + 8, 1u);
                if (need) {
                    const unsigned kth = first ? kspec : (unsigned)TOPK, kmax = kth + (kth >> 1);
#pragma unroll 1
                    for (int q = wave; q < AQ; q += 8) if ((comp >> q) & 1u) { if (DEBUG_STAT == 8 && lane == 0) atomicAdd((unsigned*)(F.ws + WS_CTL) + 32768 + 7, 1u); wave_select<0, TOPK>(cand + q * ACAP, cnt + q, thr + q, H, sel + q * 256, lane, q, kth, kmax); }
                    lds_barrier();
                    first = false;
                }
                thr_r = thr[r32];
            }
        }
        } else {
            { const unsigned cq = (lane < AQ) ? cnt[lane] : (unsigned)TOPK; const bool bad = __ballot(cq < (unsigned)TOPK) != 0ull;
              if (tid == 0) *(LAS unsigned*)(F.lds + A_OK) = bad ? 0u : 1u;
              if (bad) return; }
#pragma unroll 1
            for (int q = wave; q < AQ; q += 8) wave_select<1, TOPK>(cand + q * ACAP, cnt + q, thr + q, H, sel + q * 256, lane, q);
            __syncthreads();
        }
    }
}
__device__ __forceinline__ void attn_gather_phase(Frame& F, const bf16* Q, const bf16* KB, const bf16* VB, const unsigned short* SEL, const float* again, bf16* MIX) {
    const int lane = F.lane, wave = F.wave;
    const int hd = lane & 15, kq = lane >> 4;
    LAS unsigned char* const vb = F.lds + wave * (64 * V_RS);
    LAS unsigned short* const sq = (LAS unsigned short*)(F.lds + 8 * 64 * V_RS) + wave * 256;
    LAS unsigned char* const kb = vb;
#pragma unroll 1
    for (int ui = 0; ui < 4; ++ui) {
        const int u = attn_unit_of(F, ui); if (u < 0) break;
        const int b = u & 3, qt = u >> 2, t0 = qt * AQ, q0 = b * SEQ + t0, n = ((t0 >> 6) + 1) << 6;
        const int nsel = n < TOPK ? n : TOPK, nchunk = nsel >> 6;
        const bf16* const kbat = KB + (size_t)b * SEQ * 64; const bf16* const vbat = VB + (size_t)b * SEQ * 64;
#pragma unroll 1
        for (int qq = wave; qq < AQ; qq += 8) {
            const int r = q0 + qq;
            if (n > TOPK) { const unsigned long long iv = *((const unsigned long long*)(SEL + (size_t)r * 256) + lane); *((LAS unsigned long long*)sq + lane) = iv; }
            else { const unsigned i0 = 4u * lane; *((LAS unsigned long long*)sq + lane) = (unsigned long long)(i0 | ((i0 + 1u) << 16)) | ((unsigned long long)((i0 + 2u) | ((i0 + 3u) << 16)) << 32); }
            asm volatile("s_waitcnt lgkmcnt(0)" ::: "memory");
            bf16x8v bq0, bq1;
            { v4u z = (v4u){0u, 0u, 0u, 0u}; const v4u a0 = (hd < 8) ? *(const v4u*)(Q + (size_t)r * ATTN_W + hd * 64 + 8 * kq) : z, a1 = (hd < 8) ? *(const v4u*)(Q + (size_t)r * ATTN_W + hd * 64 + 32 + 8 * kq) : z;
              bq0 = __builtin_bit_cast(bf16x8v, a0); bq1 = __builtin_bit_cast(bf16x8v, a1); }
            f32x4 lg[16];
#pragma unroll
            for (int hb2 = 0; hb2 < 2; ++hb2) {
                v4u kk[2][8];
#pragma unroll
                for (int c2 = 0; c2 < 2; ++c2) { const int c = 2 * hb2 + c2; if (c < nchunk) {
#pragma unroll
                    for (int jj = 0; jj < 8; ++jj) { const unsigned off = (unsigned)sq[64 * c + (lane >> 3) + 8 * jj] * 128u + 16u * (lane & 7); kk[c2][jj] = *(const v4u*)((const char*)kbat + off); } } }
#pragma unroll
                for (int c2 = 0; c2 < 2; ++c2) { const int c = 2 * hb2 + c2;
                    if (c < nchunk) {
#pragma unroll
                        for (int jj = 0; jj < 8; ++jj) *(LAS v4u*)(kb + ((lane >> 3) + 8 * jj) * V_RS + (lane & 7) * 16) = kk[c2][jj];
                        asm volatile("s_waitcnt lgkmcnt(0)" ::: "memory");
#pragma unroll
                        for (int g = 0; g < 4; ++g) { const bf16x8v k0 = *(const LAS bf16x8v*)(kb + (16 * g + hd) * V_RS + 16 * kq), k1 = *(const LAS bf16x8v*)(kb + (16 * g + hd) * V_RS + 64 + 16 * kq);
                            f32x4 a = (f32x4){0.f, 0.f, 0.f, 0.f}; a = __builtin_amdgcn_mfma_f32_16x16x32_bf16(k0, bq0, a, 0, 0, 0); a = __builtin_amdgcn_mfma_f32_16x16x32_bf16(k1, bq1, a, 0, 0, 0); lg[4 * c + g] = a; }
                        asm volatile("s_waitcnt lgkmcnt(0)" ::: "memory");
                    } else {
                        const float ni = -__builtin_inff();
#pragma unroll
                        for (int g = 0; g < 4; ++g) lg[4 * c + g] = (f32x4){ni, ni, ni, ni};
                    }
                }
            }
            float mxv = -__builtin_inff();
#pragma unroll
            for (int g = 0; g < 16; ++g) mxv = fmaxf(fmaxf(fmaxf(lg[g][0], lg[g][1]), fmaxf(lg[g][2], lg[g][3])), mxv);
            mxv = fmaxf(mxv, __shfl_xor(mxv, 16)); mxv = fmaxf(mxv, __shfl_xor(mxv, 32));
            float sum = 0.f; bf16x8v pb[8];
#pragma unroll
            for (int ks = 0; ks < 8; ++ks) { float p[8];
#pragma unroll
                for (int e = 0; e < 4; ++e) { p[e] = __builtin_amdgcn_exp2f(lg[2 * ks][e] - mxv); p[4 + e] = __builtin_amdgcn_exp2f(lg[2 * ks + 1][e] - mxv); }
#pragma unroll
                for (int e = 0; e < 8; ++e) sum += p[e];
                v4u o; o.x = pk2(p[0], p[1]); o.y = pk2(p[2], p[3]); o.z = pk2(p[4], p[5]); o.w = pk2(p[6], p[7]); pb[ks] = __builtin_bit_cast(bf16x8v, o); }
            sum += __shfl_xor(sum, 16); sum += __shfl_xor(sum, 32);
            asm volatile("" ::: "memory");
            f32x4 O[4];
#pragma unroll
            for (int mt = 0; mt < 4; ++mt) O[mt] = (f32x4){0.f, 0.f, 0.f, 0.f};
#pragma unroll
            for (int hb2 = 0; hb2 < 2; ++hb2) {
                v4u vv[2][8];
#pragma unroll
                for (int c2 = 0; c2 < 2; ++c2) { const int c = 2 * hb2 + c2; if (c < nchunk) {
#pragma unroll
                    for (int j = 0; j < 8; ++j) { const unsigned off = (unsigned)sq[64 * c + (lane >> 3) + 8 * j] * 128u + 16u * (lane & 7); vv[c2][j] = *(const v4u*)((const char*)vbat + off); } } }
#pragma unroll
                for (int c2 = 0; c2 < 2; ++c2) { const int c = 2 * hb2 + c2;
                    if (c < nchunk) {
#pragma unroll
                        for (int j = 0; j < 8; ++j) *(LAS v4u*)(vb + ((lane >> 3) + 8 * j) * V_RS + (lane & 7) * 16) = vv[c2][j];
                        asm volatile("s_waitcnt lgkmcnt(0)" ::: "memory");
#pragma unroll
                        for (int ksl = 0; ksl < 2; ++ksl) {
                            const int rowa = 32 * ksl + 4 * kq + (hd >> 2);
#pragma unroll
                            for (int mt = 0; mt < 4; ++mt) {
                                const v4i16_t alo = __builtin_amdgcn_ds_read_tr16_b64_v4i16((LAS v4i16_t*)(vb + rowa * V_RS + (16 * mt + 4 * (hd & 3)) * 2));
                                const v4i16_t ahi = __builtin_amdgcn_ds_read_tr16_b64_v4i16((LAS v4i16_t*)(vb + (rowa + 16) * V_RS + (16 * mt + 4 * (hd & 3)) * 2));
                                bf16x8v A; A[0] = alo[0]; A[1] = alo[1]; A[2] = alo[2]; A[3] = alo[3]; A[4] = ahi[0]; A[5] = ahi[1]; A[6] = ahi[2]; A[7] = ahi[3];
                                O[mt] = __builtin_amdgcn_mfma_f32_16x16x32_bf16(A, pb[2 * c + ksl], O[mt], 0, 0, 0);
                            }
                        }
                        asm volatile("s_waitcnt lgkmcnt(0)" ::: "memory");
                    }
                }
            }
            const float inv = 1.0f / sum; float ss = 0.f;
#pragma unroll
            for (int mt = 0; mt < 4; ++mt) { O[mt] = O[mt] * inv; ss += (O[mt][0] * O[mt][0] + O[mt][1] * O[mt][1]) + (O[mt][2] * O[mt][2] + O[mt][3] * O[mt][3]); }
            ss = wave_sum((hd < 8) ? ss : 0.f);
            const float rs = __builtin_amdgcn_rsqf(ss * (1.f / ATTN_W) + EPS);
            if (hd < 8) {
#pragma unroll
                for (int mt = 0; mt < 4; ++mt) { const int col = hd * 64 + 16 * mt + 4 * kq; const f32x4 gn = *(const f32x4*)(again + col); const f32x4 y = O[mt] * rs * gn;
                    *(unsigned long long*)(MIX + (size_t)r * DM + col) = (unsigned long long)pk2(y[0], y[1]) | ((unsigned long long)pk2(y[2], y[3]) << 32); }
            }
        }
    }
}

constexpr int PH_PER_LAYER = 15, N_PHASES = 2 + DEPTH * PH_PER_LAYER;
#define NOINL __attribute__((noinline, not_tail_called))
typedef LAS unsigned char* ldsp_t;
__device__ __forceinline__ Frame make_frame(ldsp_t lds, const CArgs* A) {
    const unsigned ldsw = (unsigned)(size_t)lds;
    Frame F; F.lds = (ldsp_t)(size_t)(ldsw & 0xFFFFFFu); F.ws = A->ws; F.wave = __builtin_amdgcn_readfirstlane((int)(ldsw >> 24)); F.lane = (int)__builtin_amdgcn_mbcnt_hi(~0u, __builtin_amdgcn_mbcnt_lo(~0u, 0u)); F.tid = (int)(ldsw >> 24) * 64 + F.lane;
    __builtin_assume(F.lane >= 0 && F.lane < 64); __builtin_assume(F.wave >= 0 && F.wave < 8); __builtin_assume(F.tid >= 0 && F.tid < 512);
    F.G = gridDim.x; { const int bx = blockIdx.x; F.vcu = (F.G % 8 == 0) ? (bx % 8) * (F.G / 8) + bx / 8 : bx; }
    return F;
}
__device__ NOINL void ph_grid_bar(const CArgs* A0, ldsp_t lds_w) { const CArgs* A = karg(A0); const unsigned ldsw = (unsigned)__builtin_amdgcn_readfirstlane((int)(unsigned)(size_t)lds_w); const ldsp_t lds = (ldsp_t)(size_t)(ldsw & 0xFFFFFFu);
    const bool t0 = (ldsw >> 24) == 0u && __builtin_amdgcn_mbcnt_hi(~0u, __builtin_amdgcn_mbcnt_lo(~0u, 0u)) == 0u; XcdBarrier b; b.bar = (unsigned*)(A->ws + WS_CTL) + CW_BAR; b.x = xb_xcc_id(); b.st = (volatile LAS unsigned*)(lds + MISC_OFF) + 8; xcd_barrier(b, t0); }
__device__ NOINL void ph_pro_ssm(const CArgs* A0, ldsp_t lds) { const CArgs* A = karg(A0); Frame F = make_frame(lds, A); pro_ssm(A, F); }
__device__ NOINL void ph_pro_mod(const CArgs* A0, ldsp_t lds) { const CArgs* A = karg(A0); Frame F = make_frame(lds, A); pro_mod(A, F); }
__device__ NOINL void ph_pro_wt(const CArgs* A0, ldsp_t lds) { const CArgs* A = karg(A0); Frame F = make_frame(lds, A); pro_wt(A, F); }
__device__ NOINL void ph_pro_rope(const CArgs* A0, ldsp_t lds) { const CArgs* A = karg(A0); Frame F = make_frame(lds, A); pro_rope(A, F); }
__device__ NOINL void ph_norm(const CArgs* A0, ldsp_t lds, int l, int which, int first) { l = __builtin_amdgcn_readfirstlane(l); which = __builtin_amdgcn_readfirstlane(which); first = __builtin_amdgcn_readfirstlane(first); const CArgs* A = karg(A0); Frame F = make_frame(lds, A); unsigned char* ws = A->ws;
    const float* g = (const float*)A->in[5] + (size_t)(l * 3 + which) * DM; const float* modl = (const float*)(ws + WS_MOD) + (size_t)l * NB * NMOD * DM; bf16* XB = (bf16*)(ws + WS_XB);
    if (first) norm_mod_phase<true, false>(F, A->in[0], g, modl, 3 * which, (bf16*)(ws + WS_H), XB);
    else if (which == 1) norm_mod_phase<false, true>(F, XB, g, modl, 3 * which, (bf16*)(ws + WS_H), XB);
    else norm_mod_phase<true, true>(F, XB, g, modl, 3 * which, (bf16*)(ws + WS_H), XB); }
__device__ NOINL void ph_ffn_up(const CArgs* A0, ldsp_t lds, int l, int f) { l = __builtin_amdgcn_readfirstlane(l); f = __builtin_amdgcn_readfirstlane(f); const CArgs* A = karg(A0); unsigned char* ws = A->ws;
    typedef pg8::GemmF8<DM, DM, DM / 128, 124> GP; typedef pg8::StaticOrder<MTOK / 256, NFF1 / 256> SO; GP g{ws + WS_H, ws + WS_W13 + (size_t)(l * 2 + f) * NFF1 * DM}; SO S; S.init(gridDim.x, (int)blockIdx.x);
    EpiSwiGLU E{ws + WS_R}; pg8::gemm_phase<GP, EpiSwiGLU, SO, FFN_ALIGN, FFN_SP2>(lds, g, S, E); }
#if PROBE_DUP >= 13 && PROBE_DUP <= 16
__device__ NOINL void ph_ffn_up_p(const CArgs* A0, ldsp_t lds, int l, int f) { l = __builtin_amdgcn_readfirstlane(l); f = __builtin_amdgcn_readfirstlane(f); const CArgs* A = karg(A0); unsigned char* ws = A->ws;
    typedef pg8::GemmF8<DM, DM, DM / 128, 124, 0, 0, PROBE_DUP - 13> GP; typedef pg8::StaticOrder<MTOK / 256, NFF1 / 256> SO; GP g{ws + WS_H, ws + WS_W13 + (size_t)(l * 2 + f) * NFF1 * DM}; SO S; S.init(gridDim.x, (int)blockIdx.x);
    EpiSwiGLU E{ws + WS_R + 96 * MiB}; pg8::gemm_phase<GP, EpiSwiGLU, SO, FFN_ALIGN, FFN_SP2>(lds, g, S, E); }
#endif
__device__ NOINL void ph_ffn_down(const CArgs* A0, ldsp_t lds, int l, int f, int first) { l = __builtin_amdgcn_readfirstlane(l); f = __builtin_amdgcn_readfirstlane(f); first = __builtin_amdgcn_readfirstlane(first); const CArgs* A = karg(A0); unsigned char* ws = A->ws;
    typedef pg8::GemmF8<DFF, DFF, DFF / 128, 124> GP; typedef pg8::StaticOrder<MTOK / 256, DM / 256> SO; GP g{ws + WS_R, ws + WS_W2 + (size_t)(l * 2 + f) * DM * DFF}; SO S; S.init(gridDim.x, (int)blockIdx.x);
    EpiResid E{(const bf16*)(ws + WS_XB), (bf16*)(ws + WS_XB), (const float*)(ws + WS_MOD) + (size_t)l * NB * NMOD * DM + (2 + 6 * f) * DM, 0.5f}; pg8::gemm_phase<GP, EpiResid, SO, true, true>(lds, g, S, E); }
__device__ NOINL void ph_win(const CArgs* A0, ldsp_t lds, int l) { const CArgs* A = karg(A0); unsigned char* ws = A->ws;
    typedef pg8::GemmRM<DM, DM, DM / 64> GP; typedef pg8::StaticOrder<MTOK / 256, NWIN / 256> SO; GP g{(const bf16*)(ws + WS_H), (const bf16*)(ws + WS_WIN) + (size_t)l * NWIN * DM}; SO S; S.init(gridDim.x, (int)blockIdx.x);
    EpiWin E{ws}; pg8::gemm_phase<GP, EpiWin, SO, true, true>(lds, g, S, E); }
#if ATTN_FAST
__device__ NOINL void ph_attn_a(const CArgs* A0, ldsp_t lds, int ui, int safe) { ui = __builtin_amdgcn_readfirstlane(ui); safe = __builtin_amdgcn_readfirstlane(safe); const CArgs* A = karg(A0); Frame F = make_frame(lds, A); unsigned char* ws = A->ws;
    attn_index_phase<0>(F, ui, (const bf16*)(ws + R_QI), (const bf16*)(ws + R_KI), (const float*)(ws + R_WI), (unsigned short*)(ws + R_SEL), safe); }
__device__ NOINL void ph_attn_b(const CArgs* A0, ldsp_t lds, int ui) { ui = __builtin_amdgcn_readfirstlane(ui); const CArgs* A = karg(A0); Frame F = make_frame(lds, A); unsigned char* ws = A->ws;
    attn_index_phase<1>(F, ui, (const bf16*)(ws + R_QI), (const bf16*)(ws + R_KI), (const float*)(ws + R_WI), (unsigned short*)(ws + R_SEL));
    asm volatile("s_waitcnt vmcnt(0)" ::: "memory"); __syncthreads(); }
#else
__device__ NOINL void ph_attn(const CArgs* A0, ldsp_t lds, int l) { l = __builtin_amdgcn_readfirstlane(l); const CArgs* A = karg(A0); Frame F = make_frame(lds, A); unsigned char* ws = A->ws;
    attn_simple_phase(F, (const bf16*)(ws + R_Q), (const bf16*)(ws + R_KB), (const bf16*)(ws + R_VB), (const bf16*)(ws + R_QI), (const bf16*)(ws + R_KI), (const float*)(ws + R_WI), (const float*)A->in[14] + (size_t)l * ATTN_W, (bf16*)(ws + WS_H)); }
#endif
__device__ NOINL void ph_attn2(const CArgs* A0, ldsp_t lds, int l) { l = __builtin_amdgcn_readfirstlane(l); const CArgs* A = karg(A0); Frame F = make_frame(lds, A); unsigned char* ws = A->ws;
    attn_gather_phase(F, (const bf16*)(ws + R_Q), (const bf16*)(ws + R_KB), (const bf16*)(ws + R_VB), (const unsigned short*)(ws + R_SEL), (const float*)A->in[14] + (size_t)l * ATTN_W, (bf16*)(ws + WS_H)); }
__device__ NOINL void ph_ssm_state(const CArgs* A0, ldsp_t lds, int l) { l = __builtin_amdgcn_readfirstlane(l); const CArgs* A = karg(A0); unsigned char* ws = A->ws;
    typedef pg8::GemmSsm<KSS, KT, KT / 64, 128> GP; typedef pg8::StaticOrder<SG * NCHK / 256, 1> SO; GP g{(const bf16*)(ws + R_UG), (const bf16*)(ws + WS_BW) + (size_t)l * SG * 128 * KT}; SO S; S.init(gridDim.x, (int)blockIdx.x);
    EpiSsmState E{(float*)(ws + R_SINC)}; pg8::gemm_phase<GP, EpiSsmState, SO, true, true>(lds, g, S, E); }
__device__ NOINL void ph_ssm_scan(const CArgs* A0, ldsp_t lds, int l) { l = __builtin_amdgcn_readfirstlane(l); const CArgs* A = karg(A0); Frame F = make_frame(lds, A); unsigned char* ws = A->ws;
    ssm_scan_phase(F, (const float*)(ws + WS_AL) + (size_t)l * SG * SP * 2, (const float*)(ws + R_SINC), (bf16*)(ws + R_UG)); }
__device__ NOINL void ph_ssm_out(const CArgs* A0, ldsp_t lds, int l) { l = __builtin_amdgcn_readfirstlane(l); const CArgs* A = karg(A0); unsigned char* ws = A->ws;
    typedef pg8::GemmSsm<KSS, KSS, KSS / 64, KT> GP; typedef pg8::StaticOrder<SG * NCHK / 256, KT / 256> SO; GP g{(const bf16*)(ws + R_UG), (const bf16*)(ws + WS_BTV) + (size_t)l * SG * KT * KSS}; SO S; S.init(gridDim.x, (int)blockIdx.x);
    EpiSsmOut E{(bf16*)(ws + R_YG)}; pg8::gemm_phase<GP, EpiSsmOut, SO, true, true>(lds, g, S, E); }
__device__ NOINL void ph_glu(const CArgs* A0, ldsp_t lds, int l) { l = __builtin_amdgcn_readfirstlane(l); const CArgs* A = karg(A0); unsigned char* ws = A->ws;
    pg8::GemmGlu g{(const bf16*)(ws + R_YG), (const bf16*)(ws + WS_GLU) + (size_t)l * SSM_W * SSM_W}; typedef pg8::StaticOrder<MTOK / 256, SSM_W / 256> SO; SO S; S.init(gridDim.x, (int)blockIdx.x);
    EpiGlu E{(const bf16*)(ws + R_YG), (bf16*)(ws + R_Y2), (const float*)A->in[25] + (size_t)l * SSM_W}; pg8::gemm_phase<pg8::GemmGlu, EpiGlu, SO, true, true>(lds, g, S, E); }
__device__ NOINL void ph_ssm_norm(const CArgs* A0, ldsp_t lds, int l) { l = __builtin_amdgcn_readfirstlane(l); const CArgs* A = karg(A0); Frame F = make_frame(lds, A); unsigned char* ws = A->ws;
    ssm_norm_phase(F, (const bf16*)(ws + R_Y2), (const float*)A->in[15] + (size_t)l * SSM_W, (bf16*)(ws + WS_H)); }
__device__ NOINL void ph_wout(const CArgs* A0, ldsp_t lds, int l) { l = __builtin_amdgcn_readfirstlane(l); const CArgs* A = karg(A0); unsigned char* ws = A->ws;
    typedef pg8::GemmRM<DM, DM, DM / 64> GP; typedef pg8::StaticOrder<MTOK / 256, DM / 256> SO; GP g{(const bf16*)(ws + WS_H), (const bf16*)(ws + WS_WOUT) + (size_t)l * DM * DM}; SO S; S.init(gridDim.x, (int)blockIdx.x);
    EpiResid E{(const bf16*)(ws + WS_XB), (bf16*)(ws + WS_XB), (const float*)(ws + WS_MOD) + (size_t)l * NB * NMOD * DM + 5 * DM, 1.0f}; pg8::gemm_phase<GP, EpiResid, SO, true, true>(lds, g, S, E); }
__device__ NOINL void ph_final(const CArgs* A0, ldsp_t lds) { const CArgs* A = karg(A0); Frame F = make_frame(lds, A); final_norm_phase(F, (const bf16*)(F.ws + WS_XB), (const float*)A->in[26], A->out);
#if DEBUG_STAT
    { const unsigned* ctr = (const unsigned*)(F.ws + WS_CTL) + 32768; const float den = (DEBUG_STAT == 8) ? 131072.0f : (DEBUG_STAT == 9) ? 4096.0f : 1.0f;
      const float k = 1.0f + (float)ctr[DEBUG_STAT - 1] / den;
      asm volatile("s_waitcnt vmcnt(0)" ::: "memory"); __syncthreads();
      const int gw = F.vcu * 8 + F.wave, NGW = F.G * 8;
      for (int r = gw; r < MTOK; r += NGW) { f32x4* o = (f32x4*)(A->out + (size_t)r * DM) + F.lane; for (int j = 0; j < 4; ++j) o[64 * j] = o[64 * j] * k; } }
#endif
}

__global__ void __launch_bounds__(512, 2) fwd(Args args) {
    extern __shared__ __attribute__((aligned(16))) unsigned char lds_raw[];
    const ldsp_t lds = (ldsp_t)lds_raw;
    const CArgs* const KA = (const CArgs*)__builtin_amdgcn_kernarg_segment_ptr();
    for (int u = threadIdx.x; u < (LDS_BYTES - LDSCTL_OFF) / 4; u += 512) ((LAS unsigned*)(lds + LDSCTL_OFF))[u] = 0u;
    __syncthreads();
    const int lo = args.ph_lo, hi = args.ph_hi;
    if (hi - lo > 1) (void)xcd_barrier_post((unsigned*)(args.ws + WS_CTL) + CW_BAR, (volatile LAS unsigned*)(lds + MISC_OFF) + 8);
    const ldsp_t lw = (ldsp_t)(size_t)((unsigned)(size_t)lds | ((unsigned)__builtin_amdgcn_readfirstlane((int)threadIdx.x >> 6) << 24));
#define IN(k) (lo <= (k) && (k) < hi)
#define SEAM(k) do { if (IN(k) && IN((k) + 1)) ph_grid_bar(KA, lw); } while (0)
    if (IN(0)) { for (int rep = 0; rep < (PROBE_DUP == 7 ? 2 : 1); ++rep) { ph_pro_ssm(KA, lw); ph_pro_mod(KA, lw); ph_pro_wt(KA, lw); ph_pro_rope(KA, lw); __syncthreads(); } }
    SEAM(0);
    for (int sl = 0; sl < 3 * DEPTH; ++sl) {
        const int l = sl / 3, ty = sl - 3 * l, f = ty >> 1;
        if (ty != 1) {
            const int pf = 1 + l * PH_PER_LAYER + (f ? 12 : 0);
            if (IN(pf)) { ph_norm(KA, lw, l, 2 * f, sl == 0); if (PROBE_DUP == 6) ph_norm(KA, lw, l, 2 * f, sl == 0); }
            SEAM(pf);
            if (IN(pf + 1)) { ph_ffn_up(KA, lw, l, f); if (PROBE_DUP == 3) ph_ffn_up(KA, lw, l, f);
#if PROBE_DUP >= 13 && PROBE_DUP <= 16
                ph_ffn_up_p(KA, lw, l, f);
#endif
            }
            SEAM(pf + 1);
            if (IN(pf + 2)) ph_ffn_down(KA, lw, l, f, sl == 0);
            SEAM(pf + 2);
        } else {
            const int p0 = 1 + l * PH_PER_LAYER;
            if (IN(p0 + 3)) { ph_norm(KA, lw, l, 1, 0); if (PROBE_DUP == 6) ph_norm(KA, lw, l, 1, 0); }
            SEAM(p0 + 3);
            if (IN(p0 + 4)) { ph_win(KA, lw, l); if (PROBE_DUP == 4) ph_win(KA, lw, l); }
            SEAM(p0 + 4);
#if ATTN_FAST
            if (IN(p0 + 5)) { for (int rep = 0; rep < (PROBE_DUP == 1 ? 2 : 1); ++rep) for (int ui = 0; ui < 4; ++ui) {
                                  ph_attn_a(KA, lw, ui, 0); if (PROBE_DUP == 12) ph_attn_a(KA, lw, ui, 0);
                                  ph_attn_b(KA, lw, ui);
                                  __syncthreads(); const unsigned okv = (unsigned)__builtin_amdgcn_readfirstlane((int)*(volatile LAS unsigned*)(lds + A_OK)); __syncthreads();
                                  if (!okv) { ph_attn_a(KA, lw, ui, 1); ph_attn_b(KA, lw, ui); }
                                  if (PROBE_DUP == 9) ph_attn_b(KA, lw, ui); }
                              for (int rep = 0; rep < (PROBE_DUP == 2 ? 2 : 1); ++rep) ph_attn2(KA, lw, l); }
#else
            if (IN(p0 + 5)) ph_attn(KA, lw, l);
#endif
            if (PROBE_DUP == 5) SEAM(p0 + 5); else __syncthreads();
            for (int rep = 0; rep < (PROBE_DUP == 5 ? 2 : 1); ++rep) {
            if (IN(p0 + 6)) ph_ssm_state(KA, lw, l);
            SEAM(p0 + 6);
            if (IN(p0 + 7)) ph_ssm_scan(KA, lw, l);
            SEAM(p0 + 7);
            if (IN(p0 + 8)) ph_ssm_out(KA, lw, l);
            SEAM(p0 + 8);
            if (IN(p0 + 9)) ph_glu(KA, lw, l);
            SEAM(p0 + 9);
            if (IN(p0 + 10)) ph_ssm_norm(KA, lw, l);
            SEAM(p0 + 10);
            }
            if (IN(p0 + 11)) ph_wout(KA, lw, l);
            SEAM(p0 + 11);
        }
    }
    if (IN(N_PHASES - 1)) ph_final(KA, lw);
#undef IN
#undef SEAM
}

extern "C" void kernel_launch(void* const* d_in, const int* in_sizes, int n_in, void* d_out, int out_size, void* d_ws, size_t ws_size, hipStream_t stream) {
    static int grid = 0;
    if (grid == 0) {
        if (n_in != 27 || in_sizes[0] != MTOK * DM || out_size != MTOK * DM || ws_size < WS_END) { fprintf(stderr, "kernel_launch: unexpected shapes (n_in %d, in0 %d, out %d, ws %zu < %zu)\n", n_in, n_in > 0 ? in_sizes[0] : -1, out_size, ws_size, (size_t)WS_END); grid = -1; return; }
        int dev = 0, cus = 0;
        if (hipGetDevice(&dev) != hipSuccess || hipDeviceGetAttribute(&cus, hipDeviceAttributeMultiprocessorCount, dev) != hipSuccess) { grid = -1; return; }
        if (hipFuncSetAttribute((const void*)fwd, hipFuncAttributeMaxDynamicSharedMemorySize, LDS_BYTES) != hipSuccess) { fprintf(stderr, "kernel_launch: hipFuncSetAttribute failed\n"); grid = -1; return; }
        int per_cu = 0;
        if (hipOccupancyMaxActiveBlocksPerMultiprocessor(&per_cu, (const void*)fwd, 512, LDS_BYTES) != hipSuccess || per_cu < 1) fprintf(stderr, "kernel_launch: occupancy query reports %d\n", per_cu);
        (void)hipGetLastError();
        grid = cus;
    }
    if (grid < 0) return;
    (void)hipMemsetAsync((char*)d_ws + WS_CTL, 0, CTL_ZERO_BYTES, stream);
    Args a{};
    for (int i = 0; i < 27; ++i) a.in[i] = d_in[i];
    a.out = (float*)d_out; a.ws = (unsigned char*)d_ws;
#if MK_ONE_LAUNCH
    a.ph_lo = 0; a.ph_hi = N_PHASES;
    hipLaunchKernelGGL(fwd, dim3(grid), dim3(512), LDS_BYTES, stream, a);
#else
    for (int p = 0; p < N_PHASES; ++p) { a.ph_lo = p; a.ph_hi = p + 1; hipLaunchKernelGGL(fwd, dim3(grid), dim3(512), LDS_BYTES, stream, a); }
#endif
}
```

```cpp
#include <hip/hip_runtime.h>
#include <cstdio>
#include <cstdint>

#ifndef ATTN_FAST
#define ATTN_FAST 1
#endif
#ifndef PROBE_DUP
#define PROBE_DUP 0
#endif
#ifndef ATTN_SAMPLE
#define ATTN_SAMPLE 0
#endif
#ifndef SPEC_NUM
#define SPEC_NUM 704
#endif
#ifndef PROBE_FALLBACK
#define PROBE_FALLBACK 0
#endif
#ifndef DEBUG_STAT
#define DEBUG_STAT 0
#endif
#ifndef FFN_ALIGN
#define FFN_ALIGN true
#endif
#ifndef FFN_SP2
#define FFN_SP2 true
#endif
#ifndef MK_ONE_LAUNCH
#define MK_ONE_LAUNCH 1
#endif

constexpr int NB = 4, SEQ = 8192, DM = 1024, DEPTH = 4, MTOK = NB * SEQ;
constexpr int DFF = 2816, NFF1 = 2 * DFF;
constexpr int ATTN_W = 512, NH = 8, HD = 64, IDXH = 4, TOPK = 256;
constexpr int SSM_W = 512, SG = 32, GC = 16, SP = 64;
constexpr int LCH = 32, NCHK = MTOK / LCH, CHB = SEQ / LCH, KT = LCH * GC, KSS = KT + 2 * SP;
constexpr int INC = 1476, NWIN = 1536, NMOD = 9;
constexpr float EPS = 1e-6f, ATT_SCALE = 0.125f, IDX_SCALE = 0.0625f;

namespace pg8 {
#define PG8_LAS __attribute__((address_space(3)))
typedef unsigned short bf16_t;
typedef short bf16x8 __attribute__((ext_vector_type(8)));
typedef float f32x4 __attribute__((ext_vector_type(4)));
typedef unsigned u32x4 __attribute__((ext_vector_type(4)));
constexpr int BM = 256, BK = 64, HALF = 128, HTB = HALF * BK * 2, STAGE_BYTES = 8 * HTB, NXCD = 8, WGM = 8;

__host__ __device__ __forceinline__ int lds_byte(int r, int c) { const int st = (r >> 4) * 2 + (c >> 5), rr = r & 15, cc = c & 31, ob = rr * 64 + cc * 2; return st * 1024 + (ob ^ (((ob >> 9) & 1) << 5)); }
__host__ __device__ __forceinline__ void stage_rc(int b, int& R, int& C) { const int st = b / 1024, sb = b % 1024, swz = sb ^ (((sb >> 9) & 1) << 5); R = (st >> 1) * 16 + swz / 64; C = (st & 1) * 32 + (swz % 64) / 2; }
__host__ __device__ __forceinline__ int perm32(int rho) { const int n = rho >> 4, i = rho & 15; return 8 * (i >> 2) + 4 * n + (i & 3); }

struct Unit { int pm, pn; };

template <int NM, int NN> struct StaticOrder {
    static constexpr int nM = NM, nN = NN, nwg = NM * NN;
    int G, c;
    __host__ __device__ void init(int G_, int c_) { G = G_; c = c_; }
    __host__ __device__ bool next(int i, Unit& u) const {
        const long L = (long)i * G + c; if (L >= nwg) return false;
        int wgid = (int)L; { constexpr int q = nwg / NXCD, r = nwg % NXCD; const int xcd = wgid % NXCD, off = wgid / NXCD; wgid = (xcd < r ? xcd * (q + 1) : r * (q + 1) + (xcd - r) * q) + off; }
        constexpr int nig = WGM * nN; const int gid = wgid / nig, fm = gid * WGM, gsz = (nM - fm) < WGM ? (nM - fm) : WGM;
        u.pm = fm + ((wgid % nig) % gsz); u.pn = (wgid % nig) / gsz; return true;
    }
    __device__ __forceinline__ void a_ready(const Unit&) const {}
    __device__ __forceinline__ void done(const Unit&) const {}
};

__device__ __forceinline__ unsigned cvt_pk_bf16(float lo, float hi) { unsigned r; asm volatile("v_cvt_pk_bf16_f32 %0, %1, %2" : "=v"(r) : "v"(lo), "v"(hi)); return r; }

template <int LDA, int LDB, int NKT> struct GemmRM {
    const bf16_t* A; const bf16_t* Bt;
    static constexpr int nkt = NKT;
    __device__ __forceinline__ unsigned aVoff(int R, int C) const { return (unsigned)(R * LDA + C) * 2u; }
    __device__ __forceinline__ unsigned bVoff(int R, int C) const { return (unsigned)(R * LDB + C) * 2u; }
    __device__ __forceinline__ unsigned aK() const { return 128u; }
    __device__ __forceinline__ unsigned bK() const { return 128u; }
    __device__ __forceinline__ unsigned aH() const { return (unsigned)HALF * LDA * 2u; }
    __device__ __forceinline__ unsigned bH() const { return (unsigned)HALF * LDB * 2u; }
    __device__ __forceinline__ unsigned aOff(const Unit& u) const { return (unsigned)u.pm * (256u * LDA * 2u); }
    __device__ __forceinline__ unsigned bOff(const Unit& u) const { return (unsigned)u.pn * (256u * LDB * 2u); }
};
template <int LDA, int LDB, int NKT, int SCALE_W, int SKM_ = 0, int SKN_ = 0, int PROBE_ = 0  > struct GemmF8 {
    const unsigned char* A; const unsigned char* Bt;
    static constexpr int nkt = NKT; static constexpr bool F8 = true; static constexpr int SW = SCALE_W; static constexpr int SKM = SKM_, SKN = SKN_, PROBE = PROBE_;
    __device__ __forceinline__ unsigned aVoff(int R, int C) const { return (unsigned)(R * LDA + 2 * C); }
    __device__ __forceinline__ unsigned bVoff(int R, int C) const { return (unsigned)(R * LDB + 2 * C); }
    __device__ __forceinline__ unsigned aK() const { return 128u; }
    __device__ __forceinline__ unsigned bK() const { return 128u; }
    __device__ __forceinline__ unsigned aH() const { return (unsigned)HALF * LDA; }
    __device__ __forceinline__ unsigned bH() const { return (unsigned)HALF * LDB; }
    __device__ __forceinline__ unsigned aOff(const Unit& u) const { return (unsigned)u.pm * (256u * LDA); }
    __device__ __forceinline__ unsigned bOff(const Unit& u) const { return (unsigned)u.pn * (256u * LDB); }
};
template <class GP, class = void> struct gp_is_f8 { static constexpr bool value = false; static constexpr int sw = 127; };
template <class GP> struct gp_is_f8<GP, decltype((void)GP::F8)> { static constexpr bool value = GP::F8; static constexpr int sw = GP::SW; };
template <class GP, class = void> struct gp_probe { static constexpr int value = 0; };
template <class GP> struct gp_probe<GP, decltype((void)GP::PROBE)> { static constexpr int value = GP::PROBE; };
template <class GP, class = void> struct gp_skew { static constexpr bool value = false; static constexpr int SKM = 0, SKN = 0; };
template <class GP> struct gp_skew<GP, decltype((void)GP::SKM)> { static constexpr bool value = (GP::SKM != 0 || GP::SKN != 0); static constexpr int SKM = GP::SKM, SKN = GP::SKN; };
typedef int i32x8 __attribute__((ext_vector_type(8)));
typedef int i32x4 __attribute__((ext_vector_type(4)));
__device__ __forceinline__ i32x8 cat32(bf16x8 lo, bf16x8 hi) { const i32x4 a = __builtin_bit_cast(i32x4, lo), b = __builtin_bit_cast(i32x4, hi); return __builtin_shufflevector(a, b, 0, 1, 2, 3, 4, 5, 6, 7); }
template <int LDA, int LDB, int NKT, int BROWS> struct GemmSsm {
    const bf16_t* A; const bf16_t* Bt;
    static constexpr int nkt = NKT;
    __device__ __forceinline__ unsigned aVoff(int R, int C) const { return (unsigned)(R * LDA + C) * 2u; }
    __device__ __forceinline__ unsigned bVoff(int R, int C) const { return (unsigned)(R * LDB + C) * 2u; }
    __device__ __forceinline__ unsigned aK() const { return 128u; }
    __device__ __forceinline__ unsigned bK() const { return 128u; }
    __device__ __forceinline__ unsigned aH() const { return (unsigned)HALF * LDA * 2u; }
    __device__ __forceinline__ unsigned bH() const { return (unsigned)HALF * LDB * 2u; }
    __device__ __forceinline__ unsigned aOff(const Unit& u) const { return (unsigned)u.pm * (256u * LDA * 2u); }
    __device__ __forceinline__ unsigned bOff(const Unit& u) const { return ((unsigned)(u.pm >> 2) * BROWS + (unsigned)u.pn * 256u) * (LDB * 2u); }
};
struct GemmGlu {
    const bf16_t* A; const bf16_t* Bt;
    static constexpr int nkt = 8;
    __device__ __forceinline__ unsigned aVoff(int R, int C) const { return (unsigned)((C >> 4) * (NCHK * KT) + (R >> 5) * KT + (R & 31) * 16 + (C & 15)) * 2u; }
    __device__ __forceinline__ unsigned bVoff(int R, int C) const { return (unsigned)(R * 512 + C) * 2u; }
    __device__ __forceinline__ unsigned aK() const { return 4u * NCHK * KT * 2u; }
    __device__ __forceinline__ unsigned bK() const { return 128u; }
    __device__ __forceinline__ unsigned aH() const { return 4u * KT * 2u; }
    __device__ __forceinline__ unsigned bH() const { return (unsigned)HALF * 512u * 2u; }
    __device__ __forceinline__ unsigned aOff(const Unit& u) const { return (unsigned)u.pm * (8u * KT * 2u); }
    __device__ __forceinline__ unsigned bOff(const Unit& u) const { return (unsigned)u.pn * (256u * 512u * 2u); }
};

template <class GP, class Epi, class Sched, bool ALIGN_EPI = false, bool SP2 = false>
__device__ __forceinline__ void gemm_phase(PG8_LAS unsigned char* lds_w, const GP g, const Sched& S, const Epi& E) {
    const unsigned ldsq = (unsigned)__builtin_amdgcn_readfirstlane((int)(unsigned)(size_t)lds_w);
    PG8_LAS unsigned char* const lds = (PG8_LAS unsigned char*)(size_t)(ldsq & 0xFFFFFFu);
    const int wid0 = (int)(ldsq >> 24), wid = (gp_probe<GP>::value == 3) ? (((wid0 & 1) << 2) | (wid0 >> 1)) : wid0, lane = (int)__builtin_amdgcn_mbcnt_hi(~0u, __builtin_amdgcn_mbcnt_lo(~0u, 0u)), tid = wid * 64 + lane, wr = wid >> 2, wc = wid & 3, fr = lane & 15, fq = lane >> 4;
    const int nt = g.nkt;
    unsigned voffA[2], voffB[2];
#pragma unroll
    for (int i = 0; i < 2; ++i) { int R, C; stage_rc(tid * 16 + i * 8192, R, C); const int Rb = Epi::PERM ? ((R & ~31) + perm32(R & 31)) : R;
        voffA[i] = g.aVoff(R, C); voffB[i] = g.bVoff(Rb, C); }
    const unsigned kstepA = g.aK(), kstepB = g.bK(), hstepA = g.aH(), hstepB = g.bH();
    const char* const baseA = (const char*)g.A; const char* const baseB = (const char*)g.Bt;
    const unsigned ldsw = (unsigned)wid * 1024u;
    const int aoff = lds_byte(wr * 64 + fr, fq * 8), boff = lds_byte(wc * 32 + fr, fq * 8);
#define PG8_SA(b, h) (((b) * 2 + (h)) * HTB)
#define PG8_SB(b, h) ((4 + (b) * 2 + (h)) * HTB)
#define PG8_STAGE_(bufoff, base, goff, voff) do { if constexpr (gp_probe<GP>::value != 2) _Pragma("unroll") for (int _i = 0; _i < 2; ++_i) \
        __builtin_amdgcn_global_load_lds((const unsigned*)((base) + (unsigned)((goff) + (voff)[_i])), (PG8_LAS unsigned*)(lds + (bufoff) + ldsw + _i * 8192), 16, 0, 0); } while (0)
#define PG8_STAGE(bufoff, goff, voff) PG8_STAGE_(bufoff, PG8_BASE_##voff, goff, voff)
#define PG8_BASE_voffA baseA
#define PG8_BASE_voffB baseB
#define PG8_LDA(dst, b, h) do { _Pragma("unroll") for (int m = 0; m < 4; ++m) { \
        if constexpr (gp_is_f8<GP>::value) dst##8[m] = cat32(*(const PG8_LAS bf16x8*)(lds + PG8_SA(b, h) + aoff + m * 2048), *(const PG8_LAS bf16x8*)(lds + PG8_SA(b, h) + aoff + m * 2048 + 1024)); \
        else { _Pragma("unroll") for (int k = 0; k < 2; ++k) dst[m][k] = *(const PG8_LAS bf16x8*)(lds + PG8_SA(b, h) + aoff + m * 2048 + k * 1024); } } } while (0)
#define PG8_LDB(dst, b, h) do { _Pragma("unroll") for (int n = 0; n < 2; ++n) { \
        if constexpr (gp_is_f8<GP>::value) dst##8[n] = cat32(*(const PG8_LAS bf16x8*)(lds + PG8_SB(b, h) + boff + n * 2048), *(const PG8_LAS bf16x8*)(lds + PG8_SB(b, h) + boff + n * 2048 + 1024)); \
        else { _Pragma("unroll") for (int k = 0; k < 2; ++k) dst[n][k] = *(const PG8_LAS bf16x8*)(lds + PG8_SB(b, h) + boff + n * 2048 + k * 1024); } } } while (0)
#define PG8_MMA(ai, bj, At, Bt) do { __builtin_amdgcn_s_setprio(1); _Pragma("unroll") for (int m = 0; m < 4; ++m) _Pragma("unroll") for (int n = 0; n < 2; ++n) { \
        if constexpr (gp_probe<GP>::value == 1) { asm volatile("" :: "v"(Bt##8[n]), "v"(At##8[m])); } else \
        if constexpr (gp_is_f8<GP>::value) acc[ai][bj][m][n] = __builtin_amdgcn_mfma_scale_f32_16x16x128_f8f6f4(Bt##8[n], At##8[m], acc[ai][bj][m][n], 0, 0, 0, gp_is_f8<GP>::sw, 0, gp_is_f8<GP>::sw); \
        else { _Pragma("unroll") for (int k = 0; k < 2; ++k) acc[ai][bj][m][n] = __builtin_amdgcn_mfma_f32_16x16x32_bf16(Bt[n][k], At[m][k], acc[ai][bj][m][n], 0, 0, 0); } } __builtin_amdgcn_s_setprio(0); } while (0)
#define PG8_WAIT_V(n) asm volatile("s_waitcnt vmcnt(" #n ")" ::: "memory")
#define PG8_WAIT_L(n) asm volatile("s_waitcnt lgkmcnt(" #n ")" ::: "memory")
#define PG8_BAR __builtin_amdgcn_s_barrier()
#define PG8_SCHED __builtin_amdgcn_sched_barrier(0)
    Unit cur, nxt; int ui = 0;
    if (!S.next(0, cur)) return;
    f32x4 acc[2][2][4][2];
#pragma unroll
    for (int a = 0; a < 2; ++a)
#pragma unroll
        for (int b = 0; b < 2; ++b)
#pragma unroll
            for (int m = 0; m < 4; ++m)
#pragma unroll
                for (int n = 0; n < 2; ++n) acc[a][b][m][n] = (f32x4){0.f, 0.f, 0.f, 0.f};
    bf16x8 At[4][2], B0[2][2], B1[2][2];
    i32x8 At8[4], B08[2], B18[2];
    unsigned cA = g.aOff(cur), cB = g.bOff(cur);
    constexpr bool SKEW = gp_skew<GP>::value;
    auto kof = [&](const Unit& u) -> int { if constexpr (SKEW) return (int)((unsigned)(gp_skew<GP>::SKM * u.pm + gp_skew<GP>::SKN * u.pn) % (unsigned)GP::nkt); else return 0; };
    auto kx = [&](int t, int off) -> unsigned { if constexpr (SKEW) { int k = t + off; if (k >= nt) k -= nt; return (unsigned)k; } else return (unsigned)t; };
    int offc = kof(cur);
    S.a_ready(cur);
    { const unsigned p0A = cA + kx(0, offc) * kstepA, p0B = cB + kx(0, offc) * kstepB, p1A = cA + kx(1, offc) * kstepA, p1B = cB + kx(1, offc) * kstepB;
    if constexpr (SP2) {
        PG8_STAGE(PG8_SB(0, 0), p0B, voffB); PG8_STAGE(PG8_SB(0, 1), p0B + hstepB, voffB); PG8_STAGE(PG8_SA(0, 0), p0A, voffA); PG8_STAGE(PG8_SA(0, 1), p0A + hstepA, voffA);
        if (wr == 1) PG8_BAR;
        PG8_WAIT_V(2); PG8_BAR;
        PG8_STAGE(PG8_SB(1, 0), p1B, voffB); PG8_STAGE(PG8_SA(1, 0), p1A, voffA); PG8_STAGE(PG8_SB(1, 1), p1B + hstepB, voffB);
        PG8_WAIT_V(6); PG8_BAR;
    } else {
        PG8_STAGE(PG8_SB(0, 0), p0B, voffB); PG8_STAGE(PG8_SA(0, 0), p0A, voffA); PG8_STAGE(PG8_SB(0, 1), p0B + hstepB, voffB); PG8_STAGE(PG8_SA(0, 1), p0A + hstepA, voffA);
        if (wr == 1) PG8_BAR;
        PG8_WAIT_V(4); PG8_BAR;
        PG8_STAGE(PG8_SB(1, 0), p1B, voffB); PG8_STAGE(PG8_SA(1, 0), p1A, voffA); PG8_STAGE(PG8_SB(1, 1), p1B + hstepB, voffB);
        PG8_WAIT_V(6); PG8_BAR;
    } }
    for (;;) {
        const bool has_next = S.next(ui + 1, nxt);
        const unsigned nA = has_next ? g.aOff(nxt) : cA, nB = has_next ? g.bOff(nxt) : cB;
        const int offn = has_next ? kof(nxt) : offc;
#pragma unroll 1
        for (int t = 0; t < nt; t += 2) {
            const bool last = (t == nt - 2);
            const unsigned a1 = cA + kx(t + 1, offc) * kstepA;
            const unsigned k2 = last ? kx(0, offn) : kx(t + 2, offc), k3 = last ? kx(1, offn) : kx(t + 3, offc);
            const unsigned a2 = (last ? nA : cA) + k2 * kstepA, b2 = (last ? nB : cB) + k2 * kstepB;
            const unsigned a3 = SKEW ? (last ? nA : cA) + k3 * kstepA : a2 + kstepA, b3 = SKEW ? (last ? nB : cB) + k3 * kstepB : b2 + kstepB;
            if (last && has_next) S.a_ready(nxt);
            if constexpr (SP2) {
            PG8_LDB(B0, 0, 0); PG8_LDB(B1, 0, 1); PG8_SCHED; PG8_LDA(At, 0, 0); PG8_STAGE(PG8_SA(1, 1), a1 + hstepA, voffA);
            PG8_WAIT_V(8); PG8_WAIT_L(0); PG8_BAR; PG8_MMA(0, 0, At, B0); PG8_MMA(0, 1, At, B1); PG8_BAR; PG8_SCHED;
            PG8_LDA(At, 0, 1); PG8_STAGE(PG8_SB(0, 0), b2, voffB); PG8_STAGE(PG8_SB(0, 1), b2 + hstepB, voffB); PG8_STAGE(PG8_SA(0, 0), a2, voffA);
            PG8_WAIT_V(8); PG8_WAIT_L(0); PG8_BAR; PG8_MMA(1, 0, At, B0); PG8_MMA(1, 1, At, B1); PG8_BAR; PG8_SCHED;
            PG8_LDB(B0, 1, 0); PG8_LDB(B1, 1, 1); PG8_SCHED; PG8_LDA(At, 1, 0); PG8_STAGE(PG8_SA(0, 1), a2 + hstepA, voffA);
            PG8_WAIT_V(8); PG8_WAIT_L(0); PG8_BAR; PG8_MMA(0, 0, At, B0); PG8_MMA(0, 1, At, B1); PG8_BAR; PG8_SCHED;
            PG8_LDA(At, 1, 1); PG8_STAGE(PG8_SB(1, 0), b3, voffB); PG8_STAGE(PG8_SB(1, 1), b3 + hstepB, voffB); PG8_STAGE(PG8_SA(1, 0), a3, voffA);
            PG8_WAIT_V(8); PG8_WAIT_L(0); PG8_BAR; PG8_MMA(1, 0, At, B0); PG8_MMA(1, 1, At, B1); PG8_BAR; PG8_SCHED;
            } else {
            PG8_LDB(B0, 0, 0); PG8_SCHED; PG8_LDA(At, 0, 0); PG8_STAGE(PG8_SA(1, 1), a1 + hstepA, voffA);
            PG8_WAIT_L(8); PG8_BAR; PG8_WAIT_L(0); PG8_MMA(0, 0, At, B0); PG8_BAR; PG8_SCHED;
            PG8_LDB(B1, 0, 1); PG8_STAGE(PG8_SB(0, 0), b2, voffB);
            PG8_BAR; PG8_WAIT_L(0); PG8_MMA(0, 1, At, B1); PG8_BAR;
            PG8_LDA(At, 0, 1); PG8_STAGE(PG8_SA(0, 0), a2, voffA);
            PG8_BAR; PG8_WAIT_L(0); PG8_MMA(1, 0, At, B0); PG8_BAR; PG8_SCHED;
            PG8_STAGE(PG8_SB(0, 1), b2 + hstepB, voffB);
            PG8_WAIT_V(6); PG8_BAR; PG8_MMA(1, 1, At, B1); PG8_BAR;
            PG8_LDB(B0, 1, 0); PG8_SCHED; PG8_LDA(At, 1, 0); PG8_STAGE(PG8_SA(0, 1), a2 + hstepA, voffA);
            PG8_WAIT_L(8); PG8_BAR; PG8_WAIT_L(0); PG8_MMA(0, 0, At, B0); PG8_BAR; PG8_SCHED;
            PG8_LDB(B1, 1, 1); PG8_STAGE(PG8_SB(1, 0), b3, voffB);
            PG8_BAR; PG8_WAIT_L(0); PG8_MMA(0, 1, At, B1); PG8_BAR;
            PG8_LDA(At, 1, 1); PG8_STAGE(PG8_SA(1, 0), a3, voffA);
            PG8_BAR; PG8_WAIT_L(0); PG8_MMA(1, 0, At, B0); PG8_BAR; PG8_SCHED;
            PG8_STAGE(PG8_SB(1, 1), b3 + hstepB, voffB);
            PG8_WAIT_V(6); PG8_BAR; PG8_MMA(1, 1, At, B1); PG8_BAR;
            }
        }
        if constexpr (ALIGN_EPI) { if (wr == 0) PG8_BAR; }
        E(acc, cur, wr, wc, fr, fq); S.done(cur);
        if (!has_next) break;
#pragma unroll
        for (int a = 0; a < 2; ++a)
#pragma unroll
            for (int b = 0; b < 2; ++b)
#pragma unroll
                for (int m = 0; m < 4; ++m)
#pragma unroll
                    for (int n = 0; n < 2; ++n) acc[a][b][m][n] = (f32x4){0.f, 0.f, 0.f, 0.f};
        cur = nxt; cA = nA; cB = nB; offc = offn; ++ui;
        if constexpr (ALIGN_EPI) { if (wr == 1) PG8_BAR; }
    }
    PG8_WAIT_V(0);
    if constexpr (!ALIGN_EPI) { if (wr == 0) PG8_BAR; }
    PG8_BAR;
#undef PG8_SA
#undef PG8_SB
#undef PG8_STAGE
#undef PG8_STAGE_
#undef PG8_BASE_voffA
#undef PG8_BASE_voffB
#undef PG8_LDA
#undef PG8_LDB
#undef PG8_MMA
#undef PG8_WAIT_V
#undef PG8_WAIT_L
#undef PG8_BAR
#undef PG8_SCHED
}
}

constexpr size_t MiB = 1u << 20;
constexpr size_t WS_CTL = 0, CTL_ZERO_BYTES = 1 * MiB;
constexpr size_t WS_MOD = 1 * MiB;
constexpr size_t WS_ROPE = 2 * MiB;
constexpr size_t WS_AL = 4 * MiB;
constexpr size_t WS_W13 = 5 * MiB;
constexpr size_t WS_W2 = 49 * MiB;
constexpr size_t WS_XB = 72 * MiB;
constexpr size_t WS_WIN = 137 * MiB;
constexpr size_t WS_WOUT = 149 * MiB;
constexpr size_t WS_GLU = 157 * MiB;
constexpr size_t WS_BTV = 159 * MiB;
constexpr size_t WS_BW = 239 * MiB;
constexpr size_t WS_H = 256 * MiB;
constexpr size_t WS_R = 320 * MiB;
constexpr size_t R_Q = WS_R, R_KB = WS_R + 32 * MiB, R_VB = WS_R + 36 * MiB, R_QI = WS_R + 40 * MiB, R_KI = WS_R + 56 * MiB, R_WI = WS_R + 60 * MiB;
constexpr size_t R_UG = WS_R + 61 * MiB;
constexpr size_t R_SINC = WS_R + 101 * MiB;
constexpr size_t R_YG = WS_R + 117 * MiB;
constexpr size_t R_Y2 = WS_R + 149 * MiB;
constexpr size_t R_SEL = WS_R + 181 * MiB;
constexpr size_t WS_END = 517 * MiB;
constexpr int CW_BAR = 4096;

constexpr int RING_BYTES = 131072, LDSCTL_OFF = RING_BYTES, MISC_OFF = LDSCTL_OFF + 320, LDS_BYTES = 163840;

#define GAS __attribute__((address_space(1)))
#define LAS __attribute__((address_space(3)))
typedef unsigned short bf16;
typedef unsigned v4u __attribute__((ext_vector_type(4)));
typedef float f32x4 __attribute__((ext_vector_type(4)));
typedef GAS unsigned gu32;
#define RLX_AGENT __ATOMIC_RELAXED, __HIP_MEMORY_SCOPE_AGENT
#define LDS_WAIT() asm volatile("s_waitcnt lgkmcnt(0)" ::: "memory")
__device__ __forceinline__ unsigned f2bf(float f) { unsigned u = __builtin_bit_cast(unsigned, f); return (u + 0x7fffu + ((u >> 16) & 1u)) >> 16; }
__device__ __forceinline__ unsigned pk2(float lo, float hi) { unsigned r; asm("v_cvt_pk_bf16_f32 %0, %1, %2" : "=v"(r) : "v"(lo), "v"(hi)); return r; }
__device__ __forceinline__ unsigned pk8(float a, float b, float c, float d) {
    a = __builtin_amdgcn_fmed3f(a, -448.f, 448.f); b = __builtin_amdgcn_fmed3f(b, -448.f, 448.f); c = __builtin_amdgcn_fmed3f(c, -448.f, 448.f); d = __builtin_amdgcn_fmed3f(d, -448.f, 448.f);
    int v = __builtin_amdgcn_cvt_pk_fp8_f32(a, b, 0, false); v = __builtin_amdgcn_cvt_pk_fp8_f32(c, d, v, true); return (unsigned)v; }
__device__ __forceinline__ float bf2f(unsigned short b) { return __builtin_bit_cast(float, (unsigned)b << 16); }
__device__ __forceinline__ float bflo(unsigned w) { return __builtin_bit_cast(float, w << 16); }
__device__ __forceinline__ float bfhi(unsigned w) { return __builtin_bit_cast(float, w & 0xffff0000u); }

#define XB_TMO      128
#define XB_XCNT(j)  (256  + 64 * (j))
#define XB_XSUB(j)  (1280 + 64 * (j))
#define XB_XGEN(j)  (2304 + 64 * (j))
#define XB_TOP      3328
#define XB_TOPGEN   3392
#define XCD_BAR_WORDS 3456
#define XB_SPIN_CAP (1u << 18)
__device__ __forceinline__ unsigned xb_ld(unsigned* p)              { return __hip_atomic_load(p, __ATOMIC_RELAXED, __HIP_MEMORY_SCOPE_AGENT); }
__device__ __forceinline__ unsigned xb_add(unsigned* p, unsigned v) { return __hip_atomic_fetch_add(p, v, __ATOMIC_RELAXED, __HIP_MEMORY_SCOPE_AGENT); }
__device__ __forceinline__ unsigned xb_xcc_id() { return (unsigned)__builtin_amdgcn_s_getreg((3 << 11) | 20) & 0xFu; }
#define XB_SPIN(cond, bar) do { unsigned _sp = 0; while (cond) { __builtin_amdgcn_s_sleep(1); \
    if ((++_sp & 255u) == 0u) { if (xb_ld(&(bar)[XB_TMO])) break; if (_sp > XB_SPIN_CAP) { atomicAdd(&(bar)[XB_TMO], 1u); break; } } } } while (0)
struct XcdBarrier { unsigned* bar; unsigned x; volatile LAS unsigned* st; };
__device__ __forceinline__ XcdBarrier xcd_barrier_post(unsigned* bar, volatile LAS unsigned* st) {
    XcdBarrier b; b.bar = bar; b.x = xb_xcc_id(); b.st = st;
    if (threadIdx.x == 0) (void)xb_add(&bar[XB_XCNT(b.x)], 1u);
    return b;
}
__device__ __forceinline__ void xcd_barrier_complete(unsigned* bar, unsigned x, unsigned& nloc, unsigned& nx) {
    const unsigned G = gridDim.x * gridDim.y * gridDim.z;
    unsigned sum, cnt, mine, sp = 0u;
    for (;;) {
        sum = 0u; cnt = 0u; mine = 0u;
#pragma unroll
        for (unsigned j = 0; j < 16; ++j) { const unsigned c = xb_ld(&bar[XB_XCNT(j)]); sum += c; cnt += (c > 0u) ? 1u : 0u; mine = (j == x) ? c : mine; }
        if (sum == G) break;
        __builtin_amdgcn_s_sleep(1);
        if ((++sp & 255u) == 0u) { if (xb_ld(&bar[XB_TMO])) break; if (sp > XB_SPIN_CAP) { atomicAdd(&bar[XB_TMO], 1u); break; } }
    }
    nloc = mine > 0u ? mine : 1u; nx = cnt > 0u ? cnt : 1u;
}
__device__ __forceinline__ void xcd_barrier(const XcdBarrier& b, const bool t0) {
    asm volatile("s_waitcnt vmcnt(0)" ::: "memory");
    __syncthreads();
    if (t0) {
        unsigned* bar = b.bar;
        __builtin_amdgcn_s_waitcnt(0);
        unsigned nloc = b.st[0], nx = b.st[1];
        if (nloc == 0u) { xcd_barrier_complete(bar, b.x, nloc, nx); b.st[0] = nloc; b.st[1] = nx; }
        const unsigned old = xb_add(&bar[XB_XSUB(b.x)], 1u);
        const unsigned gen = old / nloc;
        if (old + 1u == (gen + 1u) * nloc) {
            __builtin_amdgcn_fence(__ATOMIC_RELEASE, "agent");
            asm volatile("s_waitcnt vmcnt(0)" ::: "memory");
            const unsigned og = xb_add(&bar[XB_TOP], 1u);
            const unsigned tg = og / nx;
            if (og + 1u == (tg + 1u) * nx) xb_add(&bar[XB_TOPGEN], 1u);
            else XB_SPIN(xb_ld(&bar[XB_TOPGEN]) == tg, bar);
            __builtin_amdgcn_fence(__ATOMIC_ACQUIRE, "agent");
            xb_add(&bar[XB_XGEN(b.x)], 1u);
            asm volatile("s_waitcnt vmcnt(0)" ::: "memory");
        } else {
            XB_SPIN(xb_ld(&bar[XB_XGEN(b.x)]) == gen, bar);
            __builtin_amdgcn_fence(__ATOMIC_ACQUIRE, "agent");
            asm volatile("s_waitcnt vmcnt(0)" ::: "memory");
        }
    }
    __syncthreads();
}

struct Args { const void* in[27]; float* out; unsigned char* ws; int ph_lo, ph_hi, pad0, pad1; };
typedef const __attribute__((address_space(4))) Args CArgs;
__device__ __forceinline__ const CArgs* karg(const CArgs* p) { const unsigned long long v = (unsigned long long)p; const unsigned lo = __builtin_amdgcn_readfirstlane((unsigned)v), hi = __builtin_amdgcn_readfirstlane((unsigned)(v >> 32)); return (const CArgs*)(((unsigned long long)hi << 32) | lo); }
struct Frame {
    LAS unsigned char* lds; unsigned char* ws;
    int tid, lane, wave, vcu, G;
};
__device__ __forceinline__ float wave_sum(float v) {
#define WS_DPP(x, ctrl, rm) __builtin_bit_cast(float, __builtin_amdgcn_update_dpp(0, __builtin_bit_cast(int, (x)), ctrl, rm, 0xF, false))
    v += WS_DPP(v, 0x111, 0xF); v += WS_DPP(v, 0x112, 0xF); v += WS_DPP(v, 0x114, 0xF); v += WS_DPP(v, 0x118, 0xF);
    v += WS_DPP(v, 0x142, 0xA); v += WS_DPP(v, 0x143, 0xC);
#undef WS_DPP
    return __builtin_bit_cast(float, __builtin_amdgcn_readlane(__builtin_bit_cast(int, v), 63));
}
__device__ __forceinline__ float wave_max(float v) {
#pragma unroll
    for (int o = 1; o < 64; o <<= 1) v = fmaxf(v, __shfl_xor(v, o));
    return v;
}
__device__ __forceinline__ float sigmoidf_(float x) { return __builtin_amdgcn_rcpf(1.0f + __expf(-x)); }
__device__ __forceinline__ float gelu_tanh(float x) { const float u = 0.7978845608028654f * (x + 0.044715f * x * x * x); return x * sigmoidf_(2.0f * u); }

using pg8::Unit; using pg8::cvt_pk_bf16;
struct EpiSwiGLU {
    static constexpr bool PERM = true;
    unsigned char* O;
    __device__ __forceinline__ void operator()(const f32x4 (&acc)[2][2][4][2], const Unit& u, int wr, int wc, int fr, int fq) const {
        { int ln; asm volatile("v_mbcnt_lo_u32_b32 %0, -1, 0\n\tv_mbcnt_hi_u32_b32 %0, -1, %0" : "=v"(ln)); fr = ln & 15; fq = ln >> 4; }
        const int row0 = u.pm * 256 + wr * 64 + fr, col0 = u.pn * 128 + wc * 32 + 8 * fq;
#pragma unroll
        for (int ai = 0; ai < 2; ++ai)
#pragma unroll
            for (int m = 0; m < 4; ++m) {
                unsigned char* p = O + (size_t)(row0 + ai * 128 + m * 16) * DFF + col0;
                float o[8];
#pragma unroll
                for (int n = 0; n < 2; ++n)
#pragma unroll
                    for (int e = 0; e < 4; ++e) { const float a = acc[ai][0][m][n][e], b = acc[ai][1][m][n][e]; o[4 * n + e] = (a + a) * sigmoidf_(a) * b; }
                *(unsigned long long*)p = (unsigned long long)pk8(o[0], o[1], o[2], o[3]) | ((unsigned long long)pk8(o[4], o[5], o[6], o[7]) << 32);
            }
    }
};
struct EpiResid {
    static constexpr bool PERM = true;
    const bf16* xin; bf16* xout; const float* gate; float coef;
    __device__ __forceinline__ void operator()(const f32x4 (&acc)[2][2][4][2], const Unit& u, int wr, int wc, int fr, int fq) const {
        { int ln; asm volatile("v_mbcnt_lo_u32_b32 %0, -1, 0\n\tv_mbcnt_hi_u32_b32 %0, -1, %0" : "=v"(ln)); fr = ln & 15; fq = ln >> 4; }
        const unsigned row0 = (unsigned)(u.pm * 256 + wr * 64 + fr), col0 = (unsigned)(u.pn * 256 + wc * 32 + 8 * fq);
        const float* gp = gate + (size_t)((u.pm * 256) >> 13) * (NMOD * DM) + col0;
        f32x4 gv[2][2];
#pragma unroll
        for (int bj = 0; bj < 2; ++bj)
#pragma unroll
            for (int n = 0; n < 2; ++n) gv[bj][n] = *(const f32x4*)(gp + bj * 128 + n * 4) * coef;
#pragma unroll
        for (int ai = 0; ai < 2; ++ai)
#pragma unroll
            for (int m = 0; m < 4; ++m) { const unsigned off = (row0 + ai * 128 + m * 16) * (unsigned)DM + col0;
#pragma unroll
                for (int bj = 0; bj < 2; ++bj) { const v4u q = *(const v4u*)(xin + off + bj * 128);
                    const f32x4 a0 = gv[bj][0] * acc[ai][bj][m][0], a1 = gv[bj][1] * acc[ai][bj][m][1];
                    v4u o; o.x = pk2(bflo(q.x) + a0.x, bfhi(q.x) + a0.y); o.y = pk2(bflo(q.y) + a0.z, bfhi(q.y) + a0.w); o.z = pk2(bflo(q.z) + a1.x, bfhi(q.z) + a1.y); o.w = pk2(bflo(q.w) + a1.z, bfhi(q.w) + a1.w);
                    *(v4u*)(xout + off + bj * 128) = o; } }
    }
};
struct EpiWin {
    static constexpr bool PERM = true;
    unsigned char* ws;
    __device__ __forceinline__ void operator()(const f32x4 (&acc)[2][2][4][2], const Unit& u, int wr, int wc, int fr, int fq) const {
        const int row0 = u.pm * 256 + wr * 64 + fr;
#pragma unroll 1
        for (int bj = 0; bj < 2; ++bj) {
            const int C0 = u.pn * 256 + bj * 128 + wc * 32, G64 = C0 >> 6, w0 = (C0 & 63) + 8 * fq;
            const bool do_rope = ((C0 & 63) == 0) && (G64 <= 8 || (G64 >= 10 && G64 <= 14));
            size_t boff; int S1, S2, loff = w0; float scl = 1.0f;
            if (G64 < 8) { boff = R_Q + (size_t)G64 * 128; S2 = ATTN_W; S1 = 32 * ATTN_W; scl = ATT_SCALE * 1.4426950408889634f; }
            else if (G64 == 8) { boff = R_KB; S2 = 64; S1 = 32 * 64; }
            else if (G64 == 9) { boff = R_VB; S2 = 64; S1 = 32 * 64; }
            else if (G64 < 14) { boff = R_QI + (size_t)(G64 - 10) * 4096; S2 = 8; S1 = 32 * 256; loff = (w0 >> 3) * 256; }
            else if (G64 == 14) { boff = R_KI; S2 = 8; S1 = 32 * 64; loff = (w0 >> 3) * 256; }
            else if (G64 == 15) { boff = R_WI; S2 = 8; S1 = 32 * 8; scl = IDX_SCALE; loff = 0; }
            else { boff = R_UG + (size_t)((C0 - 1024) >> 4) * ((size_t)NCHK * KSS * 2); S2 = 16; S1 = KSS; loff = (fq >> 1) * (NCHK * KSS) + 8 * (fq & 1); }
            bf16* const dst = (bf16*)(ws + boff) + loff;
            const float* const rope = (const float*)(ws + WS_ROPE);
            const float sg = (fq == 0) ? -1.f : 1.f;
#pragma unroll
            for (int ai = 0; ai < 2; ++ai)
#pragma unroll
                for (int m = 0; m < 4; ++m) {
                    const int row = row0 + ai * 128 + m * 16;
                    float v[8];
#pragma unroll
                    for (int n = 0; n < 2; ++n)
#pragma unroll
                        for (int e = 0; e < 4; ++e) v[4 * n + e] = (bj == 0) ? acc[ai][0][m][n][e] : acc[ai][1][m][n][e];
                    if (do_rope) {
                        const f32x4 c0 = *(const f32x4*)(rope + (size_t)row * 16), c1 = *(const f32x4*)(rope + (size_t)row * 16 + 4);
                        const f32x4 s0 = *(const f32x4*)(rope + (size_t)row * 16 + 8), s1 = *(const f32x4*)(rope + (size_t)row * 16 + 12);
                        const float cs[8] = {c0[0], c0[1], c0[2], c0[3], c1[0], c1[1], c1[2], c1[3]}, sn[8] = {s0[0], s0[1], s0[2], s0[3], s1[0], s1[1], s1[2], s1[3]};
#pragma unroll
                        for (int i = 0; i < 8; ++i) { const float pr = __shfl_xor(v[i], 16); const float r = v[i] * cs[i] + sg * pr * sn[i]; v[i] = (fq < 2) ? r : v[i]; }
                    }
#pragma unroll
                    for (int i = 0; i < 8; ++i) v[i] *= scl;
                    bf16* const p = dst + (size_t)((row >> 5) * S1 + (row & 31) * S2);
                    if (G64 == 15) { if (w0 == 0) *(f32x4*)p = (f32x4){v[0], v[1], v[2], v[3]}; }
                    else { v4u w; w.x = cvt_pk_bf16(v[0], v[1]); w.y = cvt_pk_bf16(v[2], v[3]); w.z = cvt_pk_bf16(v[4], v[5]); w.w = cvt_pk_bf16(v[6], v[7]); *(v4u*)p = w; }
                }
        }
    }
};
struct EpiSsmState {
    static constexpr bool PERM = false;
    float* S;
    __device__ __forceinline__ void operator()(const f32x4 (&acc)[2][2][4][2], const Unit& u, int wr, int wc, int fr, int fq) const {
        const int row0 = u.pm * 256 + wr * 64 + fr, col0 = wc * 32 + 4 * fq;
#pragma unroll
        for (int ai = 0; ai < 2; ++ai)
#pragma unroll
            for (int m = 0; m < 4; ++m)
#pragma unroll
                for (int n = 0; n < 2; ++n) *(f32x4*)(S + (size_t)(row0 + ai * 128 + m * 16) * 128 + col0 + n * 16) = acc[ai][0][m][n];
    }
};
struct EpiSsmOut {
    static constexpr bool PERM = true;
    bf16* Y;
    __device__ __forceinline__ void operator()(const f32x4 (&acc)[2][2][4][2], const Unit& u, int wr, int wc, int fr, int fq) const {
        const int row0 = u.pm * 256 + wr * 64 + fr, col0 = u.pn * 256 + wc * 32 + 8 * fq;
#pragma unroll
        for (int ai = 0; ai < 2; ++ai)
#pragma unroll
            for (int m = 0; m < 4; ++m)
#pragma unroll
                for (int bj = 0; bj < 2; ++bj) {
                    float o[8];
#pragma unroll
                    for (int n = 0; n < 2; ++n)
#pragma unroll
                        for (int e = 0; e < 4; ++e) o[4 * n + e] = gelu_tanh(acc[ai][bj][m][n][e]);
                    v4u w; w.x = cvt_pk_bf16(o[0], o[1]); w.y = cvt_pk_bf16(o[2], o[3]); w.z = cvt_pk_bf16(o[4], o[5]); w.w = cvt_pk_bf16(o[6], o[7]);
                    *(v4u*)(Y + (size_t)(row0 + ai * 128 + m * 16) * KT + col0 + bj * 128) = w;
                }
    }
};
struct EpiGlu {
    static constexpr bool PERM = true;
    const bf16* YG; bf16* Y2; const float* gb;
    __device__ __forceinline__ void operator()(const f32x4 (&acc)[2][2][4][2], const Unit& u, int wr, int wc, int fr, int fq) const {
        const int row0 = u.pm * 256 + wr * 64 + fr, col0 = u.pn * 256 + wc * 32 + 8 * fq;
#pragma unroll
        for (int bj = 0; bj < 2; ++bj) {
            const int col = col0 + bj * 128, gg = col >> 4, cc = col & 15;
            const f32x4 b0 = *(const f32x4*)(gb + col), b1 = *(const f32x4*)(gb + col + 4);
            const float bb[8] = {b0[0], b0[1], b0[2], b0[3], b1[0], b1[1], b1[2], b1[3]};
#pragma unroll
            for (int ai = 0; ai < 2; ++ai)
#pragma unroll
                for (int m = 0; m < 4; ++m) {
                    const int row = row0 + ai * 128 + m * 16;
                    const v4u yv = *(const v4u*)(YG + ((size_t)(gg * NCHK + (row >> 5))) * KT + (row & 31) * 16 + cc);
                    const float y[8] = {bflo(yv.x), bfhi(yv.x), bflo(yv.y), bfhi(yv.y), bflo(yv.z), bfhi(yv.z), bflo(yv.w), bfhi(yv.w)};
                    float o[8];
#pragma unroll
                    for (int n = 0; n < 2; ++n)
#pragma unroll
                        for (int e = 0; e < 4; ++e) o[4 * n + e] = y[4 * n + e] * sigmoidf_(acc[ai][bj][m][n][e] + bb[4 * n + e]);
                    v4u w; w.x = cvt_pk_bf16(o[0], o[1]); w.y = cvt_pk_bf16(o[2], o[3]); w.z = cvt_pk_bf16(o[4], o[5]); w.w = cvt_pk_bf16(o[6], o[7]);
                    *(v4u*)(Y2 + (size_t)row * SSM_W + col) = w;
                }
        }
    }
};

__device__ __forceinline__ void transpose_tile(const float* colp, int srcN, int k0, bf16* WT, int Kd, int n0, LAS float* scr, int lane) {
    float tv[32];
#pragma unroll
    for (int i = 0; i < 32; ++i) { const int kk = 2 * i + (lane >> 5); tv[i] = colp ? colp[(size_t)(k0 + kk) * srcN] : 0.f; }
#pragma unroll
    for (int i = 0; i < 32; ++i) { const int kk = 2 * i + (lane >> 5); scr[kk * 33 + (lane & 31)] = tv[i]; }
    LDS_WAIT(); asm volatile("" ::: "memory");
    const int c = lane & 7;
#pragma unroll
    for (int j = 0; j < 4; ++j) { const int n = (lane >> 3) + 8 * j; const LAS float* s = scr + (8 * c) * 33 + n;
        v4u o; o.x = pk2(s[0 * 33], s[1 * 33]); o.y = pk2(s[2 * 33], s[3 * 33]); o.z = pk2(s[4 * 33], s[5 * 33]); o.w = pk2(s[6 * 33], s[7 * 33]);
        *(v4u*)(WT + (size_t)(n0 + n) * Kd + k0 + 8 * c) = o; }
    LDS_WAIT(); asm volatile("" ::: "memory");
}
__device__ __forceinline__ void transpose_tile_f8(const float* colp, int srcN, int k0, unsigned char* WT, int Kd, int n0, LAS float* scr, int lane) {
    float tv[32];
#pragma unroll
    for (int i = 0; i < 32; ++i) { const int kk = 2 * i + (lane >> 5); tv[i] = colp ? colp[(size_t)(k0 + kk) * srcN] : 0.f; }
#pragma unroll
    for (int i = 0; i < 32; ++i) { const int kk = 2 * i + (lane >> 5); scr[kk * 33 + (lane & 31)] = tv[i]; }
    LDS_WAIT(); asm volatile("" ::: "memory");
#pragma unroll
    for (int j = 0; j < 2; ++j) { const int p = lane + 64 * j, n = p >> 2, kc = p & 3; const LAS float* sp = scr + (16 * kc) * 33 + n;
        v4u o;
        o.x = pk8(sp[0 * 33] * 32.f, sp[1 * 33] * 32.f, sp[2 * 33] * 32.f, sp[3 * 33] * 32.f); o.y = pk8(sp[4 * 33] * 32.f, sp[5 * 33] * 32.f, sp[6 * 33] * 32.f, sp[7 * 33] * 32.f);
        o.z = pk8(sp[8 * 33] * 32.f, sp[9 * 33] * 32.f, sp[10 * 33] * 32.f, sp[11 * 33] * 32.f); o.w = pk8(sp[12 * 33] * 32.f, sp[13 * 33] * 32.f, sp[14 * 33] * 32.f, sp[15 * 33] * 32.f);
        *(v4u*)(WT + (size_t)(n0 + n) * Kd + k0 + 16 * kc) = o; }
    LDS_WAIT(); asm volatile("" ::: "memory");
}
constexpr int IT_W13 = 16 * 176, IT_W2 = 44 * 32, IT_WIN = 16 * 48, IT_WOUT = 16 * 32, IT_GLU = 8 * 16;
constexpr int IT_LAYER = 2 * IT_W13 + 2 * IT_W2 + IT_WIN + IT_WOUT + IT_GLU, IT_ALL = DEPTH * IT_LAYER;
__device__ __forceinline__ void wt_item(const CArgs* ap, unsigned char* ws, int item, LAS float* scr, int lane) {
    const int l = item / IT_LAYER; int r = item % IT_LAYER; const int nl = lane & 31;
    if (r < 2 * IT_W13) { const int f = r / IT_W13; r -= f * IT_W13; const int kb = r / 176, nb = r % 176, np = 32 * nb + nl;
        const float* w = (const float*)ap->in[((np >> 7) & 1) ? (f ? 10 : 7) : (f ? 9 : 6)] + (size_t)l * DM * DFF + 128 * (np >> 8) + (np & 127);
        transpose_tile_f8(w, DFF, 64 * kb, ws + WS_W13 + (size_t)(l * 2 + f) * NFF1 * DM, DM, 32 * nb, scr, lane); return; }
    r -= 2 * IT_W13;
    if (r < 2 * IT_W2) { const int f = r / IT_W2; r -= f * IT_W2; const int kb = r / 32, nb = r % 32;
        const float* w = (const float*)ap->in[f ? 11 : 8] + (size_t)l * DFF * DM + 32 * nb + nl;
        transpose_tile_f8(w, DM, 64 * kb, ws + WS_W2 + (size_t)(l * 2 + f) * DM * DFF, DFF, 32 * nb, scr, lane); return; }
    r -= 2 * IT_W2;
    if (r < IT_WIN) { const int kb = r / 48, nb = r % 48, np = 32 * nb + nl;
        const int col = (np < 964) ? np : (np < 1024 ? -1 : np - 60);
        const float* w = (col >= 0) ? (const float*)ap->in[12] + (size_t)l * DM * INC + col : nullptr;
        transpose_tile(w, INC, 64 * kb, (bf16*)(ws + WS_WIN) + (size_t)l * NWIN * DM, DM, 32 * nb, scr, lane); return; }
    r -= IT_WIN;
    if (r < IT_WOUT) { const int kb = r / 32, nb = r % 32;
        const float* w = (const float*)ap->in[13] + (size_t)l * DM * DM + 32 * nb + nl;
        transpose_tile(w, DM, 64 * kb, (bf16*)(ws + WS_WOUT) + (size_t)l * DM * DM, DM, 32 * nb, scr, lane); return; }
    r -= IT_WOUT;
    { const int kb = r / 16, nb = r % 16;
        const float* w = (const float*)ap->in[24] + (size_t)l * SSM_W * SSM_W + 32 * nb + nl;
        transpose_tile(w, SSM_W, 64 * kb, (bf16*)(ws + WS_GLU) + (size_t)l * SSM_W * SSM_W, SSM_W, 32 * nb, scr, lane); }
}
__device__ __forceinline__ void mod_item(const CArgs* ap, Frame& F, int item, const LAS float* sc  , LAS float* red  ) {
    const int l = item / 144, n0 = (item % 144) * 64;
    const float* W = (const float*)ap->in[3] + ((size_t)l * DM + F.wave * 128) * (NMOD * DM) + n0 + F.lane;
    asm volatile("" : "+v"(W));
    float acc0 = 0.f, acc1 = 0.f, acc2 = 0.f, acc3 = 0.f;
#pragma unroll 1
    for (int k = 0; k < 128; k += 32) {
        float w[32];
#pragma unroll
        for (int j = 0; j < 32; ++j) { w[j] = *(const GAS float*)W; W += NMOD * DM; }
#pragma unroll
        for (int j = 0; j < 32; ++j) { const int kk = (F.tid >> 6) * 128 + k + j; acc0 += sc[kk] * w[j]; acc1 += sc[1024 + kk] * w[j]; acc2 += sc[2048 + kk] * w[j]; acc3 += sc[3072 + kk] * w[j]; }
    }
    red[(F.wave * 4 + 0) * 64 + F.lane] = acc0; red[(F.wave * 4 + 1) * 64 + F.lane] = acc1; red[(F.wave * 4 + 2) * 64 + F.lane] = acc2; red[(F.wave * 4 + 3) * 64 + F.lane] = acc3;
    __syncthreads();
    if (F.tid < 256) { const int b = F.tid >> 6, ln = F.tid & 63; float s = ((const float*)ap->in[4])[(size_t)l * NMOD * DM + n0 + ln];
#pragma unroll
        for (int w = 0; w < 8; ++w) s += red[(w * 4 + b) * 64 + ln];
        ((float*)(F.ws + WS_MOD))[((size_t)l * NB + b) * (NMOD * DM) + n0 + ln] = s; }
    __syncthreads();
}
__device__ __forceinline__ void ssm_pre_item(const CArgs* ap, Frame& F, int item) {
    const int l = item >> 5, g = item & 31; int tid = F.tid; asm volatile("" : "+v"(tid)); __builtin_assume(tid >= 0 && tid < 512);
    LAS float* Ere = (LAS float*)F.lds;
    LAS float* Eim = Ere + 33 * 64;
    LAS float* Bre = Eim + 33 * 64;
    LAS float* Bim = Bre + 1024;
    LAS float* Cre = Bim + 1024;
    LAS float* Cim = Cre + 1024;
    LAS float* Kk = Cim + 1024;
    LAS float* Dd = Kk + 8192;
    asm volatile("" : "+s"(ap));
    const float* a_re = (const float*)ap->in[16] + (size_t)(l * SG + g) * SP; const float* a_im = (const float*)ap->in[17] + (size_t)(l * SG + g) * SP;
    asm volatile("" : "+v"(a_re), "+v"(a_im));
    const float dt = __expf(((const float*)ap->in[18])[l * SG + g]);
    const double INV2PI = 0.15915494309189533576888;
    for (int idx = tid; idx < 33 * 64; idx += 512) { const int k = idx >> 6, p = idx & 63;
        const float mag = __expf(a_re[p] * dt * (float)k);
        const double rev = (double)a_im[p] * (double)dt * (double)k * INV2PI; const float fr = (float)(rev - __builtin_rint(rev));
        Ere[idx] = mag * __builtin_amdgcn_cosf(fr); Eim[idx] = mag * __builtin_amdgcn_sinf(fr); }
    asm volatile("" : "+s"(ap));
    for (int idx = tid; idx < 1024; idx += 512) { Cre[idx] = ((const float*)ap->in[21])[(size_t)(l * SG + g) * 1024 + idx]; Cim[idx] = ((const float*)ap->in[22])[(size_t)(l * SG + g) * 1024 + idx]; }
    if (tid < 16) Dd[tid] = ((const float*)ap->in[23])[(l * SG + g) * GC + tid];
    __syncthreads();
    asm volatile("" : "+s"(ap));
    for (int idx = tid; idx < 1024; idx += 512) { const int p = idx >> 4;
        const double ar = a_re[p], ai = a_im[p], zr = ar * dt, zi = ai * dt; double qr, qi;
        if (zr * zr + zi * zi < 0.25) {
            double tr = 1.0, ti = 0.0, sr = 1.0, si = 0.0;
#pragma unroll 1
            for (int n = 2; n <= 14; ++n) { const double nr = (tr * zr - ti * zi) / n, ni = (tr * zi + ti * zr) / n; tr = nr; ti = ni; sr += tr; si += ti; }
            qr = sr * dt; qi = si * dt;
        } else { const double nr = (double)Ere[64 + p] - 1.0, ni = (double)Eim[64 + p], den = ar * ar + ai * ai; qr = (nr * ar + ni * ai) / den; qi = (ni * ar - nr * ai) / den; }
        const double br = ((const float*)ap->in[19])[(size_t)(l * SG + g) * 1024 + idx], bi = ((const float*)ap->in[20])[(size_t)(l * SG + g) * 1024 + idx];
        Bre[idx] = (float)(qr * br - qi * bi); Bim[idx] = (float)(qr * bi + qi * br); }
    __syncthreads();
    for (int idx = tid; idx < 8192; idx += 512) { const int cp = idx & 15, c = (idx >> 4) & 15, tau = idx >> 8; float s = 0.f;
        for (int p = 0; p < 64; ++p) { const float cr = Cre[c * 64 + p], ci = Cim[c * 64 + p], er = Ere[tau * 64 + p], ei = Eim[tau * 64 + p];
            const float xr = cr * er - ci * ei, xi = cr * ei + ci * er; s += xr * Bre[p * 16 + cp] - xi * Bim[p * 16 + cp]; }
        Kk[idx] = s; }
    __syncthreads();
    bf16* TV = (bf16*)(F.ws + WS_BTV) + ((size_t)(l * SG + g) * KT) * KSS;
    for (int idx = tid; idx < 512 * 80; idx += 512) { const int n = idx / 80, k8 = idx % 80, i = n >> 4, c = n & 15; float v[8];
        if (k8 < 64) { const int ip = k8 >> 1, c0 = (k8 & 1) * 8;
#pragma unroll
            for (int e = 0; e < 8; ++e) { float x = 0.f; if (ip <= i) { x = Kk[((i - ip) * 16 + c) * 16 + c0 + e]; if (ip == i && c == c0 + e) x += Dd[c]; } v[e] = x; }
        } else { const int p0 = (k8 - 64) * 8;
#pragma unroll
            for (int e = 0; e < 8; ++e) { const int pp = p0 + e, p = pp & 63; const float cr = Cre[c * 64 + p], ci = Cim[c * 64 + p], er = Ere[(i + 1) * 64 + p], ei = Eim[(i + 1) * 64 + p];
                v[e] = (pp < 64) ? (cr * er - ci * ei) : -(cr * ei + ci * er); } }
        v4u o; o.x = pk2(v[0], v[1]); o.y = pk2(v[2], v[3]); o.z = pk2(v[4], v[5]); o.w = pk2(v[6], v[7]);
        *(v4u*)(TV + (size_t)n * KSS + k8 * 8) = o; }
    bf16* WW = (bf16*)(F.ws + WS_BW) + ((size_t)(l * SG + g) * 128) * KT;
    for (int idx = tid; idx < 128 * 64; idx += 512) { const int n = idx >> 6, k8 = idx & 63, p = n & 63, ip = k8 >> 1, c0 = (k8 & 1) * 8; float v[8];
        const float er = Ere[(31 - ip) * 64 + p], ei = Eim[(31 - ip) * 64 + p];
#pragma unroll
        for (int e = 0; e < 8; ++e) { const float br = Bre[p * 16 + c0 + e], bi = Bim[p * 16 + c0 + e]; v[e] = (n < 64) ? (er * br - ei * bi) : (er * bi + ei * br); }
        v4u o; o.x = pk2(v[0], v[1]); o.y = pk2(v[2], v[3]); o.z = pk2(v[4], v[5]); o.w = pk2(v[6], v[7]);
        *(v4u*)(WW + (size_t)n * KT + k8 * 8) = o; }
    if (tid < 64) { float* al = (float*)(F.ws + WS_AL) + ((size_t)(l * SG + g) * SP + tid) * 2; al[0] = Ere[32 * 64 + tid]; al[1] = Eim[32 * 64 + tid]; }
    __syncthreads();
}
__device__ __forceinline__ void pro_ssm(const CArgs* ap, Frame& F) {
    for (int it = F.vcu; it < DEPTH * SG; it += F.G) ssm_pre_item(ap, F, it);
    if (F.vcu == F.G - 1) { bf16* pad = (bf16*)(F.ws + WS_BW) + (size_t)DEPTH * SG * 128 * KT; for (int i = F.tid; i < 128 * KT / 8; i += 512) ((v4u*)pad)[i] = (v4u){0u, 0u, 0u, 0u}; }
}
__device__ __forceinline__ void pro_mod(const CArgs* ap, Frame& F) {
    LAS float* sc = (LAS float*)F.lds; LAS float* red = sc + 4096;
    for (int i = F.tid; i < NB * DM; i += 512) { const float x = ((const float*)ap->in[1])[i]; sc[i] = x * sigmoidf_(x); }
    __syncthreads();
    if (F.G == 256) { for (int it = F.vcu; it < 512; it += 256) mod_item(ap, F, it, sc, red); if (F.vcu >= 192) mod_item(ap, F, 512 + F.vcu - 192, sc, red); }
    else
    for (int it = F.vcu; it < DEPTH * 144; it += F.G) mod_item(ap, F, it, sc, red);
    __syncthreads();
}
__device__ __forceinline__ void pro_wt(const CArgs* ap, Frame& F) {
    LAS float* scr = (LAS float*)(F.lds + F.wave * 16384); const int gw = F.vcu * 8 + F.wave, NGW = F.G * 8;
    if (F.G == 256) {
        for (int i = 0; i < 16; ++i) wt_item(ap, F.ws, gw + 2048 * i, scr, F.lane);
        if (F.vcu >= 128) for (int it = 32768 + (F.vcu - 128) * 8 + F.wave; it < IT_ALL; it += 1024) wt_item(ap, F.ws, it, scr, F.lane);
    } else
    for (int it = gw; it < IT_ALL; it += NGW) wt_item(ap, F.ws, it, scr, F.lane);
}
__device__ __forceinline__ void pro_rope(const CArgs* ap, Frame& F) {
    const float invf[8] = {1.0f, 0.193922758102417f, 0.03760603070259094f, 0.00729266507551074f, 0.001414213445968926f, 0.00027424818836152554f, 5.318296462064609e-05f, 1.0313385246263351e-05f};
    const double INV2PI = 0.15915494309189533576888;
    float* rp = (float*)(F.ws + WS_ROPE); const int* pos = (const int*)ap->in[2];
    for (int idx = F.vcu * 512 + F.tid; idx < MTOK * 8; idx += F.G * 512) { const int r = idx >> 3, i = idx & 7; float f = invf[0];
#pragma unroll
        for (int j = 1; j < 8; ++j) f = (i == j) ? invf[j] : f;
        const float ang = (float)pos[r] * f; const double rev = (double)ang * INV2PI; const float fr = (float)(rev - __builtin_rint(rev));
        rp[(size_t)r * 16 + i] = __builtin_amdgcn_cosf(fr); rp[(size_t)r * 16 + 8 + i] = __builtin_amdgcn_sinf(fr); }
}

template <bool XBF> __device__ __forceinline__ int norm_col(int lane, int q) { return XBF ? 8 * lane + 512 * (q >> 1) + 4 * (q & 1) : 4 * lane + 256 * q; }
template <bool XBF> __device__ __forceinline__ void norm_load(const void* x, int r, int lane, f32x4 (&v)[4]) {
    if constexpr (XBF) { const v4u* xr = (const v4u*)((const bf16*)x + (size_t)r * DM) + lane;
#pragma unroll
        for (int j = 0; j < 2; ++j) { const v4u q = xr[64 * j]; v[2 * j] = (f32x4){bflo(q.x), bfhi(q.x), bflo(q.y), bfhi(q.y)}; v[2 * j + 1] = (f32x4){bflo(q.z), bfhi(q.z), bflo(q.w), bfhi(q.w)}; }
    } else { const f32x4* xr = (const f32x4*)((const float*)x + (size_t)r * DM) + lane;
#pragma unroll
        for (int j = 0; j < 4; ++j) v[j] = xr[64 * j]; }
}
template <bool F8OUT, bool XBF> __device__ __forceinline__ void norm_mod_phase(Frame& F, const void* x, const float* g, const float* modl  , int ksh, bf16* H, bf16* XB) {
    const int gw = F.vcu * 8 + F.wave, NGW = F.G * 8, rpw = (MTOK + NGW - 1) / NGW;
    int r0 = gw * rpw, r1 = r0 + rpw; if (r1 > MTOK) r1 = MTOK;
    f32x4 gs[4], sh[4]; int curb = -1;
    for (int r = r0; r < r1; ++r) {
        const int b = r >> 13;
        if (b != curb) { curb = b; const float* sp = modl + (size_t)b * (NMOD * DM) + (size_t)ksh * DM;
#pragma unroll
            for (int j = 0; j < 4; ++j) { const int c = norm_col<XBF>(F.lane, j); const f32x4 gg = *(const f32x4*)(g + c), sc = *(const f32x4*)(sp + DM + c); gs[j] = gg * (sc + 1.0f); sh[j] = *(const f32x4*)(sp + c); } }
        f32x4 v[4]; float s = 0.f;
        norm_load<XBF>(x, r, F.lane, v);
#pragma unroll
        for (int j = 0; j < 4; ++j) s += (v[j].x * v[j].x + v[j].y * v[j].y) + (v[j].z * v[j].z + v[j].w * v[j].w);
        const float rs = __builtin_amdgcn_rsqf(wave_sum(s) * (1.f / DM) + EPS);
        if constexpr (!XBF) { unsigned long long* o8 = (unsigned long long*)(XB + (size_t)r * DM) + F.lane;
#pragma unroll
            for (int j = 0; j < 4; ++j) o8[64 * j] = (unsigned long long)pk2(v[j].x, v[j].y) | ((unsigned long long)pk2(v[j].z, v[j].w) << 32); }
        f32x4 y[4];
#pragma unroll
        for (int j = 0; j < 4; ++j) y[j] = v[j] * rs * gs[j] + sh[j];
        if constexpr (F8OUT) {
            if constexpr (XBF) { unsigned long long* o8 = (unsigned long long*)((unsigned char*)H + (size_t)r * DM) + F.lane;
#pragma unroll
                for (int j = 0; j < 2; ++j) { const f32x4 a = y[2 * j] * 2.0f, c = y[2 * j + 1] * 2.0f; o8[64 * j] = (unsigned long long)pk8(a.x, a.y, a.z, a.w) | ((unsigned long long)pk8(c.x, c.y, c.z, c.w) << 32); }
            } else { unsigned* o4 = (unsigned*)((unsigned char*)H + (size_t)r * DM) + F.lane;
#pragma unroll
                for (int j = 0; j < 4; ++j) { const f32x4 a = y[j] * 2.0f; o4[64 * j] = pk8(a.x, a.y, a.z, a.w); } }
        } else {
            static_assert(XBF || F8OUT, "the f32 input only feeds the first FFN norm");
            v4u* o16 = (v4u*)(H + (size_t)r * DM) + F.lane;
#pragma unroll
            for (int j = 0; j < 2; ++j) { v4u o; o.x = pk2(y[2 * j].x, y[2 * j].y); o.y = pk2(y[2 * j].z, y[2 * j].w); o.z = pk2(y[2 * j + 1].x, y[2 * j + 1].y); o.w = pk2(y[2 * j + 1].z, y[2 * j + 1].w); o16[64 * j] = o; }
        }
    }
}
__device__ __forceinline__ void final_norm_phase(Frame& F, const bf16* x, const float* g, float* out) {
    const int gw = F.vcu * 8 + F.wave, NGW = F.G * 8;
    f32x4 gs[4];
#pragma unroll
    for (int j = 0; j < 4; ++j) gs[j] = *(const f32x4*)(g + norm_col<true>(F.lane, j));
    for (int r = gw; r < MTOK; r += NGW) {
        f32x4 v[4]; float s = 0.f;
        norm_load<true>(x, r, F.lane, v);
#pragma unroll
        for (int j = 0; j < 4; ++j) s += (v[j].x * v[j].x + v[j].y * v[j].y) + (v[j].z * v[j].z + v[j].w * v[j].w);
        const float rs = __builtin_amdgcn_rsqf(wave_sum(s) * (1.f / DM) + EPS);
#pragma unroll
        for (int j = 0; j < 4; ++j) *(f32x4*)(out + (size_t)r * DM + norm_col<true>(F.lane, j)) = v[j] * rs * gs[j];
    }
}
__device__ __forceinline__ void ssm_norm_phase(Frame& F, const bf16* Y2, const float* gain, bf16* MIX) {
    const int gw = F.vcu * 8 + F.wave, NGW = F.G * 8;
    const f32x4 g0 = *(const f32x4*)(gain + 8 * F.lane), g1 = *(const f32x4*)(gain + 8 * F.lane + 4);
    for (int r = gw; r < MTOK; r += NGW) {
        const v4u yv = *((const v4u*)(Y2 + (size_t)r * SSM_W) + F.lane);
        float y[8] = {bflo(yv.x), bfhi(yv.x), bflo(yv.y), bfhi(yv.y), bflo(yv.z), bfhi(yv.z), bflo(yv.w), bfhi(yv.w)};
        float s = 0.f;
#pragma unroll
        for (int e = 0; e < 8; ++e) s += y[e] * y[e];
        const float rs = __builtin_amdgcn_rsqf(wave_sum(s) * (1.f / SSM_W) + EPS);
        v4u w; w.x = pk2(y[0] * rs * g0[0], y[1] * rs * g0[1]); w.y = pk2(y[2] * rs * g0[2], y[3] * rs * g0[3]); w.z = pk2(y[4] * rs * g1[0], y[5] * rs * g1[1]); w.w = pk2(y[6] * rs * g1[2], y[7] * rs * g1[3]);
        *((v4u*)(MIX + (size_t)r * DM + ATTN_W) + F.lane) = w;
    }
}
__device__ __forceinline__ void ssm_scan_phase(Frame& F, const float* AL  , const float* SINC, bf16* UG) {
    if (F.wave != 0) return;
    for (int it = F.vcu; it < NB * SG; it += F.G) {
        const int b = it >> 5, g = it & 31, p = F.lane;
        const float ar = AL[(g * SP + p) * 2], ai = AL[(g * SP + p) * 2 + 1];
        const size_t row0 = (size_t)g * NCHK + (size_t)b * CHB;
        const float* sp = SINC + row0 * 128 + p; bf16* hp = UG + row0 * KSS + KT + p;
        float hr = 0.f, hi = 0.f;
        float sr[16], si[16];
#pragma unroll
        for (int j = 0; j < 16; ++j) { sr[j] = sp[(size_t)j * 128]; si[j] = sp[(size_t)j * 128 + 64]; }
#pragma unroll 1
        for (int j0 = 0; j0 < CHB; j0 += 16) {
            float nr_[16], ni_[16];
            if (j0 + 16 < CHB) {
#pragma unroll
                for (int j = 0; j < 16; ++j) { nr_[j] = sp[(size_t)(j0 + 16 + j) * 128]; ni_[j] = sp[(size_t)(j0 + 16 + j) * 128 + 64]; } }
#pragma unroll
            for (int j = 0; j < 16; ++j) {
                hp[(size_t)(j0 + j) * KSS] = (bf16)f2bf(hr); hp[(size_t)(j0 + j) * KSS + 64] = (bf16)f2bf(hi);
                const float nr = ar * hr - ai * hi + sr[j], ni = ar * hi + ai * hr + si[j]; hr = nr; hi = ni;
            }
            if (j0 + 16 < CHB) {
#pragma unroll
                for (int j = 0; j < 16; ++j) { sr[j] = nr_[j]; si[j] = ni_[j]; } }
        }
    }
}

__device__ __forceinline__ unsigned comp_key(float sc, int s) {
    sc = sc + 0.0f; unsigned u = __builtin_bit_cast(unsigned, sc); u = (u & 0x80000000u) ? ~u : (u | 0x80000000u);
    return (u & 0xFFFFE000u) | (unsigned)(8191 - s);
}
#if !ATTN_FAST
__device__ __forceinline__ void attn_simple_phase(Frame& F, const bf16* Q, const bf16* KB, const bf16* VB, const bf16* QI, const bf16* KI, const float* WI, const float* again, bf16* MIX) {
    LAS unsigned* comp = (LAS unsigned*)F.lds;
    LAS float* lg = (LAS float*)(F.lds + 32768);
    LAS float* qs = lg + 2048;
    LAS float* qis = qs + 512;
    LAS float* wis = qis + 256;
    LAS unsigned* hist = (LAS unsigned*)(wis + 8);
    LAS unsigned* sel = hist + 256;
    LAS unsigned* misc = sel + 256;
    LAS float* red = (LAS float*)(misc + 16);
    const int tid = F.tid;
    asm volatile("" : "+v"(Q), "+v"(KB), "+v"(VB), "+v"(QI), "+v"(KI), "+v"(WI), "+v"(again), "+v"(MIX));
#pragma unroll 1
    for (int r = F.vcu; r < MTOK; r += F.G) {
        const int b = r >> 13, t = r & 8191, n = ((t >> 6) + 1) << 6;
        qs[tid] = bf2f(Q[(size_t)r * ATTN_W + tid]);
        if (tid < 256) qis[tid] = bf2f(QI[(size_t)r * 256 + tid]);
        if (tid < 4) wis[tid] = WI[(size_t)r * 4 + tid];
        __syncthreads();
#pragma unroll 1
        for (int s0 = 0; s0 < n; s0 += 512) {
            const int s = s0 + tid; if (s >= n) continue;
            const v4u* kp = (const v4u*)(KI + (size_t)(b * SEQ + s) * 64);
            float a0 = 0.f, a1 = 0.f, a2 = 0.f, a3 = 0.f;
#pragma unroll 1
            for (int j = 0; j < 8; ++j) { const v4u kv = kp[j]; const float kf[8] = {bflo(kv.x), bfhi(kv.x), bflo(kv.y), bfhi(kv.y), bflo(kv.z), bfhi(kv.z), bflo(kv.w), bfhi(kv.w)};
#pragma unroll
                for (int e = 0; e < 8; ++e) { const int d = 8 * j + e; a0 += qis[d] * kf[e]; a1 += qis[64 + d] * kf[e]; a2 += qis[128 + d] * kf[e]; a3 += qis[192 + d] * kf[e]; } }
            const float sc = wis[0] * fmaxf(a0, 0.f) + wis[1] * fmaxf(a1, 0.f) + wis[2] * fmaxf(a2, 0.f) + wis[3] * fmaxf(a3, 0.f);
            comp[s] = comp_key(sc, s);
        }
        __syncthreads();
        int nsel;
        if (n > TOPK) {
            unsigned prefix = 0u, kneed = TOPK;
#pragma unroll 1
            for (int round = 0; round < 4; ++round) {
                const int shift = 24 - 8 * round;
                if (tid < 256) hist[tid] = 0u;
                __syncthreads();
#pragma unroll 1
                for (int s0 = 0; s0 < n; s0 += 512) { const int s = s0 + tid; const unsigned c = (s < n) ? comp[s] : 0u; const bool match = (s < n) && ((round == 0) || ((c >> (shift + 8)) == prefix));
                    if (match) __hip_atomic_fetch_add(&hist[(c >> shift) & 255u], 1u, __ATOMIC_RELAXED, __HIP_MEMORY_SCOPE_WORKGROUP); }
                __syncthreads();
                if (tid < 64) {
                    const unsigned h0 = hist[4 * tid], h1 = hist[4 * tid + 1], h2 = hist[4 * tid + 2], h3 = hist[4 * tid + 3], tot = h0 + h1 + h2 + h3;
                    unsigned v = tot;
#pragma unroll
                    for (int o = 1; o < 64; o <<= 1) { const unsigned up = __shfl_down(v, o); if (tid + o < 64) v += up; }
                    const unsigned above = v - tot, c3 = above + h3, c2 = c3 + h2, c1 = c2 + h1, c0 = c1 + h0;
                    const bool f3 = (c3 >= kneed) & (above < kneed), f2 = (c2 >= kneed) & (c3 < kneed), f1 = (c1 >= kneed) & (c2 < kneed), f0 = (c0 >= kneed) & (c1 < kneed);
                    const unsigned dsel = 4u * tid + (f3 ? 3u : f2 ? 2u : f1 ? 1u : 0u), below = f3 ? above : f2 ? c3 : f1 ? c2 : c1;
                    if (f3 | f2 | f1 | f0) { misc[0] = dsel; misc[1] = kneed - below; }
                }
                __syncthreads();
                prefix = (prefix << 8) | misc[0]; kneed = misc[1];
            }
            unsigned base = 0u;
#pragma unroll 1
            for (int s0 = 0; s0 < n; s0 += 512) {
                const int s = s0 + tid; const bool f = (s < n) && (comp[s] >= prefix);
                const unsigned long long bal = __ballot(f);
                if (F.lane == 0) misc[8 + F.wave] = (unsigned)__popcll(bal);
                __syncthreads();
                unsigned off = base, tot = 0u;
#pragma unroll
                for (int w = 0; w < 8; ++w) { const unsigned c = misc[8 + w]; if (w < F.wave) off += c; tot += c; }
                if (f) { const unsigned pos = off + (unsigned)__popcll(bal & ((1ull << F.lane) - 1ull)); if (pos < TOPK) sel[pos] = (unsigned)s; }
                base += tot;
                __syncthreads();
            }
            nsel = TOPK;
        } else { if (tid < n) sel[tid] = (unsigned)tid; nsel = n; }
        __syncthreads();
        {
            const int k = tid & 255, hh = tid >> 8; float a0 = 0.f, a1 = 0.f, a2 = 0.f, a3 = 0.f;
            if (k < nsel) { const v4u* kp = (const v4u*)(KB + (size_t)(b * SEQ + (int)sel[k]) * 64); const LAS float* qh = qs + hh * 256;
#pragma unroll 1
                for (int j = 0; j < 8; ++j) { const v4u kv = kp[j]; const float kf[8] = {bflo(kv.x), bfhi(kv.x), bflo(kv.y), bfhi(kv.y), bflo(kv.z), bfhi(kv.z), bflo(kv.w), bfhi(kv.w)};
#pragma unroll
                    for (int e = 0; e < 8; ++e) { const int d = 8 * j + e; a0 += qh[d] * kf[e]; a1 += qh[64 + d] * kf[e]; a2 += qh[128 + d] * kf[e]; a3 += qh[192 + d] * kf[e]; } } }
            const float ninf = -__builtin_inff(); const bool ok = k < nsel;
            lg[(4 * hh + 0) * 256 + k] = ok ? a0 : ninf; lg[(4 * hh + 1) * 256 + k] = ok ? a1 : ninf; lg[(4 * hh + 2) * 256 + k] = ok ? a2 : ninf; lg[(4 * hh + 3) * 256 + k] = ok ? a3 : ninf;
        }
        __syncthreads();
        {
            LAS float* lh = lg + F.wave * 256; float v0 = lh[F.lane], v1 = lh[F.lane + 64], v2 = lh[F.lane + 128], v3 = lh[F.lane + 192];
            const float mx = wave_max(fmaxf(fmaxf(v0, v1), fmaxf(v2, v3)));
            v0 = __builtin_amdgcn_exp2f(v0 - mx); v1 = __builtin_amdgcn_exp2f(v1 - mx); v2 = __builtin_amdgcn_exp2f(v2 - mx); v3 = __builtin_amdgcn_exp2f(v3 - mx);
            const float inv = 1.0f / wave_sum((v0 + v1) + (v2 + v3));
            lh[F.lane] = v0 * inv; lh[F.lane + 64] = v1 * inv; lh[F.lane + 128] = v2 * inv; lh[F.lane + 192] = v3 * inv;
        }
        __syncthreads();
        {
            const LAS float* ph = lg + F.wave * 256; const bf16* vb = VB + (size_t)b * SEQ * 64 + F.lane; float o = 0.f;
#pragma unroll 2
            for (int k = 0; k < nsel; k += 4) { const float x0 = bf2f(vb[(size_t)sel[k] * 64]), x1 = bf2f(vb[(size_t)sel[k + 1] * 64]), x2 = bf2f(vb[(size_t)sel[k + 2] * 64]), x3 = bf2f(vb[(size_t)sel[k + 3] * 64]);
                o += ph[k] * x0 + ph[k + 1] * x1 + ph[k + 2] * x2 + ph[k + 3] * x3; }
            const float ss = wave_sum(o * o);
            if (F.lane == 0) red[F.wave] = ss;
            __syncthreads();
            float tot = 0.f;
#pragma unroll
            for (int w = 0; w < 8; ++w) tot += red[w];
            const float rs = __builtin_amdgcn_rsqf(tot * (1.f / ATTN_W) + EPS);
            MIX[(size_t)r * DM + tid] = (bf16)f2bf(o * rs * again[tid]);
        }
        __syncthreads();
    }
}
#endif

typedef short bf16x8v __attribute__((ext_vector_type(8)));
typedef short v4i16_t __attribute__((ext_vector_type(4)));
typedef float f32x16 __attribute__((ext_vector_type(16)));
constexpr int AQ = 32, ACAP = 1024, ATRIG = 768;
constexpr int A_CNT = LDSCTL_OFF + 1024, A_THR = A_CNT + 128, A_HIST = LDSCTL_OFF + 2048, A_SEL = LDSCTL_OFF + 10240;
constexpr int A_OK = A_THR + 128;
constexpr int A_DUMP = A_SEL;
constexpr int V_RS = 144;
static_assert(A_SEL + AQ * 256 * 2 <= LDS_BYTES, "attention LDS map");
constexpr float QK_SCALE = 0.125f * 1.4426950408889634f;

__device__ __forceinline__ unsigned ord_of(unsigned c) { const unsigned m = (unsigned)((int)c >> 31); return c ^ ((m & 0x7FFFE000u) | 0x80000000u); }
#define DPPU(old, x, ctrl, rm) ((unsigned)__builtin_amdgcn_update_dpp((int)(old), (int)(x), ctrl, rm, 0xF, false))
__device__ __forceinline__ unsigned wave_scan_add(unsigned x) {
    x += DPPU(0u, x, 0x111, 0xF); x += DPPU(0u, x, 0x112, 0xF); x += DPPU(0u, x, 0x114, 0xF); x += DPPU(0u, x, 0x118, 0xF);
    x += DPPU(0u, x, 0x142, 0xA); x += DPPU(0u, x, 0x143, 0xC); return x; }
__device__ __forceinline__ unsigned wave_red_max(unsigned x) {
    x = max(x, DPPU(0u, x, 0x111, 0xF)); x = max(x, DPPU(0u, x, 0x112, 0xF)); x = max(x, DPPU(0u, x, 0x114, 0xF)); x = max(x, DPPU(0u, x, 0x118, 0xF));
    x = max(x, DPPU(0u, x, 0x142, 0xA)); x = max(x, DPPU(0u, x, 0x143, 0xC)); return (unsigned)__builtin_amdgcn_readlane((int)x, 63); }
__device__ __forceinline__ unsigned wave_red_min(unsigned x) {
    x = min(x, DPPU(~0u, x, 0x111, 0xF)); x = min(x, DPPU(~0u, x, 0x112, 0xF)); x = min(x, DPPU(~0u, x, 0x114, 0xF)); x = min(x, DPPU(~0u, x, 0x118, 0xF));
    x = min(x, DPPU(~0u, x, 0x142, 0xA)); x = min(x, DPPU(~0u, x, 0x143, 0xC)); return (unsigned)__builtin_amdgcn_readlane((int)x, 63); }
__device__ __forceinline__ unsigned lane_count_ge(const unsigned (&o)[16], const unsigned mid) {
    unsigned c0 = 0u, c1 = 0u, c2 = 0u, c3 = 0u;
#pragma unroll
    for (int j = 0; j < 16; j += 4) { unsigned long long m0, m1, m2, m3, d0, d1, d2, d3;
        asm volatile("v_cmp_le_u32 %4, %12, %13\n\tv_cmp_le_u32 %5, %12, %14\n\tv_cmp_le_u32 %6, %12, %15\n\tv_cmp_le_u32 %7, %12, %16\n\t"
                     "v_addc_co_u32 %0, %8, 0, %0, %4\n\tv_addc_co_u32 %1, %9, 0, %1, %5\n\tv_addc_co_u32 %2, %10, 0, %2, %6\n\tv_addc_co_u32 %3, %11, 0, %3, %7"
                     : "+v"(c0), "+v"(c1), "+v"(c2), "+v"(c3), "=&s"(m0), "=&s"(m1), "=&s"(m2), "=&s"(m3), "=&s"(d0), "=&s"(d1), "=&s"(d2), "=&s"(d3)
                     : "s"(mid), "v"(o[j]), "v"(o[j + 1]), "v"(o[j + 2]), "v"(o[j + 3])); }
    return (c0 + c1) + (c2 + c3);
}
template <int MODE, unsigned KTH_> __device__ __forceinline__ void wave_select(LAS unsigned* cand, LAS unsigned* cntp, LAS float* thrp, LAS unsigned* H, unsigned short* selq, const int lane, const int qx, const unsigned kth_rt = KTH_, const unsigned kmax_rt = 384u) {
    const unsigned KTH = (MODE == 0) ? kth_rt : KTH_, KMAX = (MODE == 0) ? kmax_rt : (MODE == 1) ? KTH_ : KTH_ + 16u;
    const int m = __builtin_amdgcn_readfirstlane((int)*cntp);
    unsigned e[16], o[16]; unsigned mx = 0u, mn = ~0u;
#pragma unroll
    for (int j = 0; j < 4; ++j) { const int i0 = 4 * (lane + 64 * j); v4u q = (v4u){0u, 0u, 0u, 0u}; if (256 * j < m) q = *(LAS v4u*)(cand + i0);
#pragma unroll
        for (int k = 0; k < 4; ++k) { const bool v = ((i0 + k) ^ qx) < m; e[4 * j + k] = q[k]; const unsigned ok = ord_of(q[k]); o[4 * j + k] = v ? ok : 0u; mx = max(mx, v ? ok : 0u); mn = min(mn, v ? ok : ~0u); } }
    mx = wave_red_max(mx); mn = wave_red_min(mn);
    unsigned lo = mn, hi = mx + 1u, T = mn;
    bool done = false;
    if (MODE == 1 && (unsigned)m > KMAX) {
        unsigned slo = mn >> 13, shi = (mx >> 13) + 1u, clo = (unsigned)m, chi = 0u;
#pragma unroll 1
        while (shi - slo > 1u) {
            const unsigned smid = slo + ((shi - slo) >> 1), mid = smid << 13;
            unsigned cl = 0u;
            cl = lane_count_ge(o, mid);
            const unsigned c = (unsigned)__builtin_amdgcn_readlane((int)wave_scan_add(cl), 63);
            if (c >= KTH) { slo = smid; clo = c; } else { shi = smid; chi = c; }
        }
        lo = slo << 13; hi = shi << 13;
        if (clo == KTH) { T = lo; done = true; }
        else if (KTH - chi <= 4u) {
            unsigned Tc = hi;
#pragma unroll 1
            for (unsigned i = chi; i < KTH; ++i) { unsigned bm = 0u;
#pragma unroll
                for (int j = 0; j < 16; ++j) { const unsigned v = (o[j] >= lo && o[j] < Tc) ? o[j] : 0u; bm = max(bm, v); }
                Tc = wave_red_max(bm); }
            T = Tc; done = true;
        }
    }
    if (!done && (unsigned)m > KMAX) {
#pragma unroll 1
        for (int it = 0; it < 40; ++it) {
            const unsigned mid = lo + ((hi - lo) >> 1);
            unsigned cl = 0u;
            cl = lane_count_ge(o, mid);
            const unsigned c = (unsigned)__builtin_amdgcn_readlane((int)wave_scan_add(cl), 63);
            if (c > KMAX) lo = mid; else if (c < KTH) hi = mid; else { T = mid; break; }
            if (hi - lo <= 1u) { T = lo; break; }
        }
    }
    if (MODE == 2) {
        if (lane == 0) { *cntp = 0u; const unsigned cb = (T & 0x80000000u) ? (T & 0x7FFFE000u) : ((T ^ 0xFFFFE000u) | 0x1FFFu); *thrp = __builtin_bit_cast(float, cb); }
    } else if (MODE == 0) {
        unsigned base = 0u;
#pragma unroll
        for (int j = 0; j < 16; ++j) { const bool f = (o[j] != 0u) && (o[j] >= T); const unsigned long long bal = __ballot(f);
            const unsigned pos = base + (unsigned)__builtin_amdgcn_mbcnt_hi((unsigned)(bal >> 32), __builtin_amdgcn_mbcnt_lo((unsigned)bal, 0u));
            if (f) cand[pos ^ (unsigned)qx] = e[j]; base += (unsigned)__popcll(bal); }
        if (lane == 0) { *cntp = base; const unsigned cb = (T & 0x80000000u) ? (T & 0x7FFFE000u) : ((T ^ 0xFFFFE000u) | 0x1FFFu); *thrp = __builtin_bit_cast(float, cb); }
    } else {
        LAS unsigned* BM = H;
        *(LAS v4u*)(BM + 4 * lane) = (v4u){0u, 0u, 0u, 0u};
#pragma unroll
        for (int j = 0; j < 16; ++j) { const bool f = (o[j] != 0u) && (o[j] >= T); const unsigned key = 8191u - (e[j] & 0x1FFFu);
            if (f) __hip_atomic_fetch_or(&BM[key >> 5], 1u << (key & 31u), __ATOMIC_RELAXED, __HIP_MEMORY_SCOPE_WAVEFRONT); }
        const v4u w4 = *(LAS v4u*)(BM + 4 * lane);
        const unsigned tot = __popc(w4.x) + __popc(w4.y) + __popc(w4.z) + __popc(w4.w);
        unsigned pos = wave_scan_add(tot) - tot;
        LAS unsigned short* st = (LAS unsigned short*)H;
#pragma unroll 1
        for (int k = 0; k < 4; ++k) { unsigned ww = (k == 0) ? w4.x : (k == 1) ? w4.y : (k == 2) ? w4.z : w4.w;
            while (ww) { const unsigned bit = (unsigned)__builtin_ctz(ww); ww &= ww - 1u; st[pos] = (unsigned short)(128u * lane + 32u * k + bit); ++pos; } }
        *((unsigned long long*)selq + lane) = *((LAS unsigned long long*)st + lane);
    }
}

__device__ __forceinline__ void lds_barrier() { asm volatile("s_waitcnt lgkmcnt(0)\n\ts_barrier" ::: "memory"); }
__device__ __forceinline__ int attn_unit_of(const Frame& F, int ui) {
    if (F.G == 256) { const int b = F.vcu >> 6, j = F.vcu & 63; const int qt = (ui == 0) ? j : (ui == 1) ? 127 - j : (ui == 2) ? 128 + j : 255 - j; return 4 * qt + b; }
    const int u = F.vcu + ui * F.G; return u < 1024 ? u : -1;
}
__device__ __forceinline__ void idx_tile(const bf16x8v (&Ak)[4], const bf16x8v (&Bq)[4][4], const float (&lo)[4], const float (&hi)[4], const int t, const int h2, const float thr_r,
                                         LAS unsigned* cntq, LAS unsigned* myc, LAS unsigned* dump, const unsigned qx) {
    float sc[16];
#pragma unroll
    for (int hd = 0; hd < 4; ++hd) { f32x16 acc;
#pragma unroll
        for (int i = 0; i < 16; ++i) acc[i] = 0.f;
#pragma unroll
        for (int kk = 0; kk < 4; ++kk) acc = __builtin_amdgcn_mfma_f32_32x32x16_bf16(Ak[kk], Bq[hd][kk], acc, 0, 0, 0);
#pragma unroll
        for (int i = 0; i < 16; ++i) { const float mclamp = __builtin_amdgcn_fmed3f(acc[i], lo[hd], hi[hd]); sc[i] = (hd == 0) ? mclamp : sc[i] + mclamp; } }
    const unsigned Bt = (unsigned)(8191 - 32 * t) ^ (unsigned)(4 * h2);
    unsigned c[16]; unsigned pm = 0u;
#pragma unroll
    for (int i = 0; i < 16; ++i) { const unsigned rowc = (unsigned)((i & 3) + 8 * (i >> 2));
        c[i] = (__builtin_bit_cast(unsigned, sc[i]) & 0xFFFFE000u) | (Bt ^ rowc);
        asm volatile("v_cmp_le_f32 vcc, %1, %2\n\tv_addc_co_u32 %0, vcc, %0, %0, vcc" : "+v"(pm) : "v"(thr_r), "v"(c[i]) : "vcc"); }
    if (pm) {
        unsigned slot = __hip_atomic_fetch_add(cntq, (unsigned)__popc(pm), __ATOMIC_RELAXED, __HIP_MEMORY_SCOPE_WORKGROUP);
#pragma unroll
        for (int i = 0; i < 16; ++i) { const unsigned p = (pm >> (15 - i)) & 1u; LAS unsigned* dstp = p ? (myc + (slot ^ qx)) : dump; *dstp = c[i]; slot += p; }
    }
}
template <int MODE> __device__ __forceinline__ void attn_index_phase(Frame& F, const int ui, const bf16* QI, const bf16* KI, const float* WI, unsigned short* SEL, const int safe = 0) {
    const int tid = F.tid, lane = F.lane, wave = F.wave;
    LAS unsigned* const cand = (LAS unsigned*)F.lds;
    LAS unsigned* const cnt = (LAS unsigned*)(F.lds + A_CNT);
    LAS float* const thr = (LAS float*)(F.lds + A_THR);
    LAS unsigned* const H = (LAS unsigned*)(F.lds + A_HIST) + wave * 256;
    const int r32 = lane & 31, h2 = lane >> 5;
    {
        const int u = attn_unit_of(F, ui); if (u < 0) return;
        const int b = u & 3, qt = u >> 2, t0 = qt * AQ, q0 = b * SEQ + t0, n = ((t0 >> 6) + 1) << 6;
        unsigned short* const sel = SEL + (size_t)q0 * 256;
        if (n <= TOPK) { if (MODE == 1 && tid == 0) *(LAS unsigned*)(F.lds + A_OK) = 1u; return; }
        if constexpr (MODE == 0) {
        if (tid < AQ) { cnt[tid] = 0u; thr[tid] = -__builtin_inff(); }
        __syncthreads();
        {
            bf16x8v Bq[4][4]; float lo[4], hi[4];
            { const f32x4 wv = *(const f32x4*)(WI + (size_t)(q0 + r32) * 4);
#pragma unroll
              for (int hd = 0; hd < 4; ++hd) { const float w = wv[hd]; lo[hd] = (w >= 0.f) ? 0.f : -__builtin_inff(); hi[hd] = (w >= 0.f) ? __builtin_inff() : 0.f;
#pragma unroll
                  for (int kk = 0; kk < 4; ++kk) { const v4u qv = *(const v4u*)(QI + (size_t)q0 * 256 + (size_t)(((hd * 8 + 2 * kk + h2) * 32 + r32) * 8));
                      v4u o; o.x = pk2(bflo(qv.x) * w, bfhi(qv.x) * w); o.y = pk2(bflo(qv.y) * w, bfhi(qv.y) * w); o.z = pk2(bflo(qv.z) * w, bfhi(qv.z) * w); o.w = pk2(bflo(qv.w) * w, bfhi(qv.w) * w);
                      Bq[hd][kk] = __builtin_bit_cast(bf16x8v, o); } } }
            const int ntile = n >> 5, nround = (ntile + 7) >> 3;
            const bf16* kib = KI + (size_t)b * SEQ * 64 + (size_t)((h2 * 32 + r32) * 8);
            float thr_r = -__builtin_inff();
            bool first = true; unsigned kspec = (unsigned)(SPEC_NUM * 1024) / (unsigned)n; kspec = (safe || kspec > (unsigned)TOPK) ? (unsigned)TOPK : (kspec < 32u ? 32u : kspec);
            LAS unsigned* const myc = cand + r32 * ACAP;
            LAS unsigned* const dump = (LAS unsigned*)(F.lds + A_DUMP) + tid;
            bf16x8v Ak[4];
            { const int t = wave; if (t < ntile) {
#pragma unroll
                for (int kk = 0; kk < 4; ++kk) Ak[kk] = *(const bf16x8v*)(kib + (size_t)t * 32 * 64 + 512 * kk); } }
            bf16x8v An[4];
#pragma unroll
            for (int kk = 0; kk < 4; ++kk) An[kk] = Ak[kk];
#pragma unroll 1
            for (int rd = 0; rd < nround; ++rd) {
                const int t = 8 * rd + wave;
                if (t < ntile) {
#pragma unroll
                    for (int kk = 0; kk < 4; ++kk) Ak[kk] = An[kk];
                    const int tn = t + 8;
                    if (tn < ntile) {
#pragma unroll
                        for (int kk = 0; kk < 4; ++kk) An[kk] = *(const bf16x8v*)(kib + (size_t)tn * 32 * 64 + 512 * kk); }
                    idx_tile(Ak, Bq, lo, hi, t, h2, thr_r, cnt + r32, myc, dump, (unsigned)r32);
                    if (PROBE_DUP == 11) idx_tile(Ak, Bq, lo, hi, t, h2, __builtin_inff(), cnt + r32, myc, dump, (unsigned)r32);
                }
                lds_barrier();
                if (PROBE_DUP == 10) { lds_barrier(); lds_barrier(); }
                const unsigned cq = (lane < AQ) ? cnt[lane] : 0u;
                const unsigned need = (unsigned)__ballot(cq > (unsigned)ATRIG), comp = (unsigned)__ballot(cq > 448u);
                lds_barrier();
                if (DEBUG_STAT == 9 && need && tid == 0) atomicAdd((unsigned*)(F.ws + WS_CTL) + 32768 + 8, 1u);
                if (need) {
                    const unsigned kth = first ? kspec : (unsigned)TOPK, kmax = kth + (kth >> 1);
#pragma unroll 1
                    for (int q = wave; q < AQ; q += 8) if ((comp >> q) & 1u) { if (DEBUG_STAT == 8 && lane == 0) atomicAdd((unsigned*)(F.ws + WS_CTL) + 32768 + 7, 1u); wave_select<0, TOPK>(cand + q * ACAP, cnt + q, thr + q, H, sel + q * 256, lane, q, kth, kmax); }
                    lds_barrier();
                    first = false;
                }
                thr_r = thr[r32];
            }
        }
        } else {
            { const unsigned cq = (lane < AQ) ? cnt[lane] : (unsigned)TOPK; const bool bad = __ballot(cq < (unsigned)TOPK) != 0ull;
              if (tid == 0) *(LAS unsigned*)(F.lds + A_OK) = bad ? 0u : 1u;
              if (bad) return; }
#pragma unroll 1
            for (int q = wave; q < AQ; q += 8) wave_select<1, TOPK>(cand + q * ACAP, cnt + q, thr + q, H, sel + q * 256, lane, q);
            __syncthreads();
        }
    }
}
__device__ __forceinline__ void attn_gather_phase(Frame& F, const bf16* Q, const bf16* KB, const bf16* VB, const unsigned short* SEL, const float* again, bf16* MIX) {
    const int lane = F.lane, wave = F.wave;
    const int hd = lane & 15, kq = lane >> 4;
    LAS unsigned char* const vb = F.lds + wave * (64 * V_RS);
    LAS unsigned short* const sq = (LAS unsigned short*)(F.lds + 8 * 64 * V_RS) + wave * 256;
    LAS unsigned char* const kb = vb;
#pragma unroll 1
    for (int ui = 0; ui < 4; ++ui) {
        const int u = attn_unit_of(F, ui); if (u < 0) break;
        const int b = u & 3, qt = u >> 2, t0 = qt * AQ, q0 = b * SEQ + t0, n = ((t0 >> 6) + 1) << 6;
        const int nsel = n < TOPK ? n : TOPK, nchunk = nsel >> 6;
        const bf16* const kbat = KB + (size_t)b * SEQ * 64; const bf16* const vbat = VB + (size_t)b * SEQ * 64;
#pragma unroll 1
        for (int qq = wave; qq < AQ; qq += 8) {
            const int r = q0 + qq;
            if (n > TOPK) { const unsigned long long iv = *((const unsigned long long*)(SEL + (size_t)r * 256) + lane); *((LAS unsigned long long*)sq + lane) = iv; }
            else { const unsigned i0 = 4u * lane; *((LAS unsigned long long*)sq + lane) = (unsigned long long)(i0 | ((i0 + 1u) << 16)) | ((unsigned long long)((i0 + 2u) | ((i0 + 3u) << 16)) << 32); }
            asm volatile("s_waitcnt lgkmcnt(0)" ::: "memory");
            bf16x8v bq0, bq1;
            { v4u z = (v4u){0u, 0u, 0u, 0u}; const v4u a0 = (hd < 8) ? *(const v4u*)(Q + (size_t)r * ATTN_W + hd * 64 + 8 * kq) : z, a1 = (hd < 8) ? *(const v4u*)(Q + (size_t)r * ATTN_W + hd * 64 + 32 + 8 * kq) : z;
              bq0 = __builtin_bit_cast(bf16x8v, a0); bq1 = __builtin_bit_cast(bf16x8v, a1); }
            f32x4 lg[16];
#pragma unroll
            for (int hb2 = 0; hb2 < 2; ++hb2) {
                v4u kk[2][8];
#pragma unroll
                for (int c2 = 0; c2 < 2; ++c2) { const int c = 2 * hb2 + c2; if (c < nchunk) {
#pragma unroll
                    for (int jj = 0; jj < 8; ++jj) { const unsigned off = (unsigned)sq[64 * c + (lane >> 3) + 8 * jj] * 128u + 16u * (lane & 7); kk[c2][jj] = *(const v4u*)((const char*)kbat + off); } } }
#pragma unroll
                for (int c2 = 0; c2 < 2; ++c2) { const int c = 2 * hb2 + c2;
                    if (c < nchunk) {
#pragma unroll
                        for (int jj = 0; jj < 8; ++jj) *(LAS v4u*)(kb + ((lane >> 3) + 8 * jj) * V_RS + (lane & 7) * 16) = kk[c2][jj];
                        asm volatile("s_waitcnt lgkmcnt(0)" ::: "memory");
#pragma unroll
                        for (int g = 0; g < 4; ++g) { const bf16x8v k0 = *(const LAS bf16x8v*)(kb + (16 * g + hd) * V_RS + 16 * kq), k1 = *(const LAS bf16x8v*)(kb + (16 * g + hd) * V_RS + 64 + 16 * kq);
                            f32x4 a = (f32x4){0.f, 0.f, 0.f, 0.f}; a = __builtin_amdgcn_mfma_f32_16x16x32_bf16(k0, bq0, a, 0, 0, 0); a = __builtin_amdgcn_mfma_f32_16x16x32_bf16(k1, bq1, a, 0, 0, 0); lg[4 * c + g] = a; }
                        asm volatile("s_waitcnt lgkmcnt(0)" ::: "memory");
                    } else {
                        const float ni = -__builtin_inff();
#pragma unroll
                        for (int g = 0; g < 4; ++g) lg[4 * c + g] = (f32x4){ni, ni, ni, ni};
                    }
                }
            }
            float mxv = -__builtin_inff();
#pragma unroll
            for (int g = 0; g < 16; ++g) { mxv = __builtin_fmaxf(__builtin_fmaxf(mxv, lg[g][0]), lg[g][1]); mxv = __builtin_fmaxf(__builtin_fmaxf(mxv, lg[g][2]), lg[g][3]); }
            mxv = fmaxf(mxv, __shfl_xor(mxv, 16)); mxv = fmaxf(mxv, __shfl_xor(mxv, 32));
            float sum = 0.f; bf16x8v pb[8];
#pragma unroll
            for (int ks = 0; ks < 8; ++ks) { float p[8];
#pragma unroll
                for (int e = 0; e < 4; ++e) { p[e] = __builtin_amdgcn_exp2f(lg[2 * ks][e] - mxv); p[4 + e] = __builtin_amdgcn_exp2f(lg[2 * ks + 1][e] - mxv); }
#pragma unroll
                for (int e = 0; e < 8; ++e) sum += p[e];
                v4u o; o.x = pk2(p[0], p[1]); o.y = pk2(p[2], p[3]); o.z = pk2(p[4], p[5]); o.w = pk2(p[6], p[7]); pb[ks] = __builtin_bit_cast(bf16x8v, o); }
            sum += __shfl_xor(sum, 16); sum += __shfl_xor(sum, 32);
            asm volatile("" ::: "memory");
            f32x4 O[4];
#pragma unroll
            for (int mt = 0; mt < 4; ++mt) O[mt] = (f32x4){0.f, 0.f, 0.f, 0.f};
#pragma unroll
            for (int hb2 = 0; hb2 < 2; ++hb2) {
                v4u vv[2][8];
#pragma unroll
                for (int c2 = 0; c2 < 2; ++c2) { const int c = 2 * hb2 + c2; if (c < nchunk) {
#pragma unroll
                    for (int j = 0; j < 8; ++j) { const unsigned off = (unsigned)sq[64 * c + (lane >> 3) + 8 * j] * 128u + 16u * (lane & 7); vv[c2][j] = *(const v4u*)((const char*)vbat + off); } } }
#pragma unroll
                for (int c2 = 0; c2 < 2; ++c2) { const int c = 2 * hb2 + c2;
                    if (c < nchunk) {
#pragma unroll
                        for (int j = 0; j < 8; ++j) *(LAS v4u*)(vb + ((lane >> 3) + 8 * j) * V_RS + (lane & 7) * 16) = vv[c2][j];
                        asm volatile("s_waitcnt lgkmcnt(0)" ::: "memory");
#pragma unroll
                        for (int ksl = 0; ksl < 2; ++ksl) {
                            const int rowa = 32 * ksl + 4 * kq + (hd >> 2);
#pragma unroll
                            for (int mt = 0; mt < 4; ++mt) {
                                const v4i16_t alo = __builtin_amdgcn_ds_read_tr16_b64_v4i16((LAS v4i16_t*)(vb + rowa * V_RS + (16 * mt + 4 * (hd & 3)) * 2));
                                const v4i16_t ahi = __builtin_amdgcn_ds_read_tr16_b64_v4i16((LAS v4i16_t*)(vb + (rowa + 16) * V_RS + (16 * mt + 4 * (hd & 3)) * 2));
                                bf16x8v A; A[0] = alo[0]; A[1] = alo[1]; A[2] = alo[2]; A[3] = alo[3]; A[4] = ahi[0]; A[5] = ahi[1]; A[6] = ahi[2]; A[7] = ahi[3];
                                O[mt] = __builtin_amdgcn_mfma_f32_16x16x32_bf16(A, pb[2 * c + ksl], O[mt], 0, 0, 0);
                            }
                        }
                        asm volatile("s_waitcnt lgkmcnt(0)" ::: "memory");
                    }
                }
            }
            const float inv = 1.0f / sum; float ss = 0.f;
#pragma unroll
            for (int mt = 0; mt < 4; ++mt) { O[mt] = O[mt] * inv; ss += (O[mt][0] * O[mt][0] + O[mt][1] * O[mt][1]) + (O[mt][2] * O[mt][2] + O[mt][3] * O[mt][3]); }
            ss = wave_sum((hd < 8) ? ss : 0.f);
            const float rs = __builtin_amdgcn_rsqf(ss * (1.f / ATTN_W) + EPS);
            if (hd < 8) {
#pragma unroll
                for (int mt = 0; mt < 4; ++mt) { const int col = hd * 64 + 16 * mt + 4 * kq; const f32x4 gn = *(const f32x4*)(again + col); const f32x4 y = O[mt] * rs * gn;
                    *(unsigned long long*)(MIX + (size_t)r * DM + col) = (unsigned long long)pk2(y[0], y[1]) | ((unsigned long long)pk2(y[2], y[3]) << 32); }
            }
        }
    }
}

constexpr int PH_PER_LAYER = 15, N_PHASES = 2 + DEPTH * PH_PER_LAYER;
#define NOINL __attribute__((noinline, not_tail_called))
typedef LAS unsigned char* ldsp_t;
__device__ __forceinline__ Frame make_frame(ldsp_t lds, const CArgs* A) {
    const unsigned ldsw = (unsigned)(size_t)lds;
    Frame F; F.lds = (ldsp_t)(size_t)(ldsw & 0xFFFFFFu); F.ws = A->ws; F.wave = __builtin_amdgcn_readfirstlane((int)(ldsw >> 24)); F.lane = (int)__builtin_amdgcn_mbcnt_hi(~0u, __builtin_amdgcn_mbcnt_lo(~0u, 0u)); F.tid = (int)(ldsw >> 24) * 64 + F.lane;
    __builtin_assume(F.lane >= 0 && F.lane < 64); __builtin_assume(F.wave >= 0 && F.wave < 8); __builtin_assume(F.tid >= 0 && F.tid < 512);
    F.G = gridDim.x; { const int bx = blockIdx.x; F.vcu = (F.G % 8 == 0) ? (bx % 8) * (F.G / 8) + bx / 8 : bx; }
    return F;
}
__device__ NOINL void ph_grid_bar(const CArgs* A0, ldsp_t lds_w) { const CArgs* A = karg(A0); const unsigned ldsw = (unsigned)__builtin_amdgcn_readfirstlane((int)(unsigned)(size_t)lds_w); const ldsp_t lds = (ldsp_t)(size_t)(ldsw & 0xFFFFFFu);
    const bool t0 = (ldsw >> 24) == 0u && __builtin_amdgcn_mbcnt_hi(~0u, __builtin_amdgcn_mbcnt_lo(~0u, 0u)) == 0u; XcdBarrier b; b.bar = (unsigned*)(A->ws + WS_CTL) + CW_BAR; b.x = xb_xcc_id(); b.st = (volatile LAS unsigned*)(lds + MISC_OFF) + 8; xcd_barrier(b, t0); }
__device__ NOINL void ph_pro_ssm(const CArgs* A0, ldsp_t lds) { const CArgs* A = karg(A0); Frame F = make_frame(lds, A); pro_ssm(A, F); }
__device__ NOINL void ph_pro_mod(const CArgs* A0, ldsp_t lds) { const CArgs* A = karg(A0); Frame F = make_frame(lds, A); pro_mod(A, F); }
__device__ NOINL void ph_pro_wt(const CArgs* A0, ldsp_t lds) { const CArgs* A = karg(A0); Frame F = make_frame(lds, A); pro_wt(A, F); }
__device__ NOINL void ph_pro_rope(const CArgs* A0, ldsp_t lds) { const CArgs* A = karg(A0); Frame F = make_frame(lds, A); pro_rope(A, F); }
__device__ NOINL void ph_norm(const CArgs* A0, ldsp_t lds, int l, int which, int first) { l = __builtin_amdgcn_readfirstlane(l); which = __builtin_amdgcn_readfirstlane(which); first = __builtin_amdgcn_readfirstlane(first); const CArgs* A = karg(A0); Frame F = make_frame(lds, A); unsigned char* ws = A->ws;
    const float* g = (const float*)A->in[5] + (size_t)(l * 3 + which) * DM; const float* modl = (const float*)(ws + WS_MOD) + (size_t)l * NB * NMOD * DM; bf16* XB = (bf16*)(ws + WS_XB);
    if (first) norm_mod_phase<true, false>(F, A->in[0], g, modl, 3 * which, (bf16*)(ws + WS_H), XB);
    else if (which == 1) norm_mod_phase<false, true>(F, XB, g, modl, 3 * which, (bf16*)(ws + WS_H), XB);
    else norm_mod_phase<true, true>(F, XB, g, modl, 3 * which, (bf16*)(ws + WS_H), XB); }
__device__ NOINL void ph_ffn_up(const CArgs* A0, ldsp_t lds, int l, int f) { l = __builtin_amdgcn_readfirstlane(l); f = __builtin_amdgcn_readfirstlane(f); const CArgs* A = karg(A0); unsigned char* ws = A->ws;
    typedef pg8::GemmF8<DM, DM, DM / 128, 124> GP; typedef pg8::StaticOrder<MTOK / 256, NFF1 / 256> SO; GP g{ws + WS_H, ws + WS_W13 + (size_t)(l * 2 + f) * NFF1 * DM}; SO S; S.init(gridDim.x, (int)blockIdx.x);
    EpiSwiGLU E{ws + WS_R}; pg8::gemm_phase<GP, EpiSwiGLU, SO, FFN_ALIGN, FFN_SP2>(lds, g, S, E); }
#if PROBE_DUP >= 13 && PROBE_DUP <= 16
__device__ NOINL void ph_ffn_up_p(const CArgs* A0, ldsp_t lds, int l, int f) { l = __builtin_amdgcn_readfirstlane(l); f = __builtin_amdgcn_readfirstlane(f); const CArgs* A = karg(A0); unsigned char* ws = A->ws;
    typedef pg8::GemmF8<DM, DM, DM / 128, 124, 0, 0, PROBE_DUP - 13> GP; typedef pg8::StaticOrder<MTOK / 256, NFF1 / 256> SO; GP g{ws + WS_H, ws + WS_W13 + (size_t)(l * 2 + f) * NFF1 * DM}; SO S; S.init(gridDim.x, (int)blockIdx.x);
    EpiSwiGLU E{ws + WS_R + 96 * MiB}; pg8::gemm_phase<GP, EpiSwiGLU, SO, FFN_ALIGN, FFN_SP2>(lds, g, S, E); }
#endif
__device__ NOINL void ph_ffn_down(const CArgs* A0, ldsp_t lds, int l, int f, int first) { l = __builtin_amdgcn_readfirstlane(l); f = __builtin_amdgcn_readfirstlane(f); first = __builtin_amdgcn_readfirstlane(first); const CArgs* A = karg(A0); unsigned char* ws = A->ws;
    typedef pg8::GemmF8<DFF, DFF, DFF / 128, 124> GP; typedef pg8::StaticOrder<MTOK / 256, DM / 256> SO; GP g{ws + WS_R, ws + WS_W2 + (size_t)(l * 2 + f) * DM * DFF}; SO S; S.init(gridDim.x, (int)blockIdx.x);
    EpiResid E{(const bf16*)(ws + WS_XB), (bf16*)(ws + WS_XB), (const float*)(ws + WS_MOD) + (size_t)l * NB * NMOD * DM + (2 + 6 * f) * DM, 0.5f}; pg8::gemm_phase<GP, EpiResid, SO, true, true>(lds, g, S, E); }
__device__ NOINL void ph_win(const CArgs* A0, ldsp_t lds, int l) { const CArgs* A = karg(A0); unsigned char* ws = A->ws;
    typedef pg8::GemmRM<DM, DM, DM / 64> GP; typedef pg8::StaticOrder<MTOK / 256, NWIN / 256> SO; GP g{(const bf16*)(ws + WS_H), (const bf16*)(ws + WS_WIN) + (size_t)l * NWIN * DM}; SO S; S.init(gridDim.x, (int)blockIdx.x);
    EpiWin E{ws}; pg8::gemm_phase<GP, EpiWin, SO, true, true>(lds, g, S, E); }
#if ATTN_FAST
__device__ NOINL void ph_attn_a(const CArgs* A0, ldsp_t lds, int ui, int safe) { ui = __builtin_amdgcn_readfirstlane(ui); safe = __builtin_amdgcn_readfirstlane(safe); const CArgs* A = karg(A0); Frame F = make_frame(lds, A); unsigned char* ws = A->ws;
    attn_index_phase<0>(F, ui, (const bf16*)(ws + R_QI), (const bf16*)(ws + R_KI), (const float*)(ws + R_WI), (unsigned short*)(ws + R_SEL), safe); }
__device__ NOINL void ph_attn_b(const CArgs* A0, ldsp_t lds, int ui) { ui = __builtin_amdgcn_readfirstlane(ui); const CArgs* A = karg(A0); Frame F = make_frame(lds, A); unsigned char* ws = A->ws;
    attn_index_phase<1>(F, ui, (const bf16*)(ws + R_QI), (const bf16*)(ws + R_KI), (const float*)(ws + R_WI), (unsigned short*)(ws + R_SEL));
    asm volatile("s_waitcnt vmcnt(0)" ::: "memory"); __syncthreads(); }
#else
__device__ NOINL void ph_attn(const CArgs* A0, ldsp_t lds, int l) { l = __builtin_amdgcn_readfirstlane(l); const CArgs* A = karg(A0); Frame F = make_frame(lds, A); unsigned char* ws = A->ws;
    attn_simple_phase(F, (const bf16*)(ws + R_Q), (const bf16*)(ws + R_KB), (const bf16*)(ws + R_VB), (const bf16*)(ws + R_QI), (const bf16*)(ws + R_KI), (const float*)(ws + R_WI), (const float*)A->in[14] + (size_t)l * ATTN_W, (bf16*)(ws + WS_H)); }
#endif
__device__ NOINL void ph_attn2(const CArgs* A0, ldsp_t lds, int l) { l = __builtin_amdgcn_readfirstlane(l); const CArgs* A = karg(A0); Frame F = make_frame(lds, A); unsigned char* ws = A->ws;
    attn_gather_phase(F, (const bf16*)(ws + R_Q), (const bf16*)(ws + R_KB), (const bf16*)(ws + R_VB), (const unsigned short*)(ws + R_SEL), (const float*)A->in[14] + (size_t)l * ATTN_W, (bf16*)(ws + WS_H)); }
__device__ NOINL void ph_ssm_state(const CArgs* A0, ldsp_t lds, int l) { l = __builtin_amdgcn_readfirstlane(l); const CArgs* A = karg(A0); unsigned char* ws = A->ws;
    typedef pg8::GemmSsm<KSS, KT, KT / 64, 128> GP; typedef pg8::StaticOrder<SG * NCHK / 256, 1> SO; GP g{(const bf16*)(ws + R_UG), (const bf16*)(ws + WS_BW) + (size_t)l * SG * 128 * KT}; SO S; S.init(gridDim.x, (int)blockIdx.x);
    EpiSsmState E{(float*)(ws + R_SINC)}; pg8::gemm_phase<GP, EpiSsmState, SO, true, true>(lds, g, S, E); }
__device__ NOINL void ph_ssm_scan(const CArgs* A0, ldsp_t lds, int l) { l = __builtin_amdgcn_readfirstlane(l); const CArgs* A = karg(A0); Frame F = make_frame(lds, A); unsigned char* ws = A->ws;
    ssm_scan_phase(F, (const float*)(ws + WS_AL) + (size_t)l * SG * SP * 2, (const float*)(ws + R_SINC), (bf16*)(ws + R_UG)); }
__device__ NOINL void ph_ssm_out(const CArgs* A0, ldsp_t lds, int l) { l = __builtin_amdgcn_readfirstlane(l); const CArgs* A = karg(A0); unsigned char* ws = A->ws;
    typedef pg8::GemmSsm<KSS, KSS, KSS / 64, KT> GP; typedef pg8::StaticOrder<SG * NCHK / 256, KT / 256> SO; GP g{(const bf16*)(ws + R_UG), (const bf16*)(ws + WS_BTV) + (size_t)l * SG * KT * KSS}; SO S; S.init(gridDim.x, (int)blockIdx.x);
    EpiSsmOut E{(bf16*)(ws + R_YG)}; pg8::gemm_phase<GP, EpiSsmOut, SO, true, true>(lds, g, S, E); }
__device__ NOINL void ph_glu(const CArgs* A0, ldsp_t lds, int l) { l = __builtin_amdgcn_readfirstlane(l); const CArgs* A = karg(A0); unsigned char* ws = A->ws;
    pg8::GemmGlu g{(const bf16*)(ws + R_YG), (const bf16*)(ws + WS_GLU) + (size_t)l * SSM_W * SSM_W}; typedef pg8::StaticOrder<MTOK / 256, SSM_W / 256> SO; SO S; S.init(gridDim.x, (int)blockIdx.x);
    EpiGlu E{(const bf16*)(ws + R_YG), (bf16*)(ws + R_Y2), (const float*)A->in[25] + (size_t)l * SSM_W}; pg8::gemm_phase<pg8::GemmGlu, EpiGlu, SO, true, true>(lds, g, S, E); }
__device__ NOINL void ph_ssm_norm(const CArgs* A0, ldsp_t lds, int l) { l = __builtin_amdgcn_readfirstlane(l); const CArgs* A = karg(A0); Frame F = make_frame(lds, A); unsigned char* ws = A->ws;
    ssm_norm_phase(F, (const bf16*)(ws + R_Y2), (const float*)A->in[15] + (size_t)l * SSM_W, (bf16*)(ws + WS_H)); }
__device__ NOINL void ph_wout(const CArgs* A0, ldsp_t lds, int l) { l = __builtin_amdgcn_readfirstlane(l); const CArgs* A = karg(A0); unsigned char* ws = A->ws;
    typedef pg8::GemmRM<DM, DM, DM / 64> GP; typedef pg8::StaticOrder<MTOK / 256, DM / 256> SO; GP g{(const bf16*)(ws + WS_H), (const bf16*)(ws + WS_WOUT) + (size_t)l * DM * DM}; SO S; S.init(gridDim.x, (int)blockIdx.x);
    EpiResid E{(const bf16*)(ws + WS_XB), (bf16*)(ws + WS_XB), (const float*)(ws + WS_MOD) + (size_t)l * NB * NMOD * DM + 5 * DM, 1.0f}; pg8::gemm_phase<GP, EpiResid, SO, true, true>(lds, g, S, E); }
__device__ NOINL void ph_final(const CArgs* A0, ldsp_t lds) { const CArgs* A = karg(A0); Frame F = make_frame(lds, A); final_norm_phase(F, (const bf16*)(F.ws + WS_XB), (const float*)A->in[26], A->out);
#if DEBUG_STAT
    { const unsigned* ctr = (const unsigned*)(F.ws + WS_CTL) + 32768; const float den = (DEBUG_STAT == 8) ? 131072.0f : (DEBUG_STAT == 9) ? 4096.0f : 1.0f;
      const float k = 1.0f + (float)ctr[DEBUG_STAT - 1] / den;
      asm volatile("s_waitcnt vmcnt(0)" ::: "memory"); __syncthreads();
      const int gw = F.vcu * 8 + F.wave, NGW = F.G * 8;
      for (int r = gw; r < MTOK; r += NGW) { f32x4* o = (f32x4*)(A->out + (size_t)r * DM) + F.lane; for (int j = 0; j < 4; ++j) o[64 * j] = o[64 * j] * k; } }
#endif
}

__global__ void __launch_bounds__(512, 2) fwd(Args args) {
    extern __shared__ __attribute__((aligned(16))) unsigned char lds_raw[];
    const ldsp_t lds = (ldsp_t)lds_raw;
    const CArgs* const KA = (const CArgs*)__builtin_amdgcn_kernarg_segment_ptr();
    for (int u = threadIdx.x; u < (LDS_BYTES - LDSCTL_OFF) / 4; u += 512) ((LAS unsigned*)(lds + LDSCTL_OFF))[u] = 0u;
    __syncthreads();
    const int lo = args.ph_lo, hi = args.ph_hi;
    if (hi - lo > 1) (void)xcd_barrier_post((unsigned*)(args.ws + WS_CTL) + CW_BAR, (volatile LAS unsigned*)(lds + MISC_OFF) + 8);
    const ldsp_t lw = (ldsp_t)(size_t)((unsigned)(size_t)lds | ((unsigned)__builtin_amdgcn_readfirstlane((int)threadIdx.x >> 6) << 24));
#define IN(k) (lo <= (k) && (k) < hi)
#define SEAM(k) do { if (IN(k) && IN((k) + 1)) ph_grid_bar(KA, lw); } while (0)
    if (IN(0)) { for (int rep = 0; rep < (PROBE_DUP == 7 ? 2 : 1); ++rep) { ph_pro_ssm(KA, lw); ph_pro_mod(KA, lw); ph_pro_wt(KA, lw); ph_pro_rope(KA, lw); __syncthreads(); } }
    SEAM(0);
    for (int sl = 0; sl < 3 * DEPTH; ++sl) {
        const int l = sl / 3, ty = sl - 3 * l, f = ty >> 1;
        if (ty != 1) {
            const int pf = 1 + l * PH_PER_LAYER + (f ? 12 : 0);
            if (IN(pf)) { ph_norm(KA, lw, l, 2 * f, sl == 0); if (PROBE_DUP == 6) ph_norm(KA, lw, l, 2 * f, sl == 0); }
            SEAM(pf);
            if (IN(pf + 1)) { ph_ffn_up(KA, lw, l, f); if (PROBE_DUP == 3) ph_ffn_up(KA, lw, l, f);
#if PROBE_DUP >= 13 && PROBE_DUP <= 16
                ph_ffn_up_p(KA, lw, l, f);
#endif
            }
            SEAM(pf + 1);
            if (IN(pf + 2)) ph_ffn_down(KA, lw, l, f, sl == 0);
            SEAM(pf + 2);
        } else {
            const int p0 = 1 + l * PH_PER_LAYER;
            if (IN(p0 + 3)) { ph_norm(KA, lw, l, 1, 0); if (PROBE_DUP == 6) ph_norm(KA, lw, l, 1, 0); }
            SEAM(p0 + 3);
            if (IN(p0 + 4)) { ph_win(KA, lw, l); if (PROBE_DUP == 4) ph_win(KA, lw, l); }
            SEAM(p0 + 4);
#if ATTN_FAST
            if (IN(p0 + 5)) { for (int rep = 0; rep < (PROBE_DUP == 1 ? 2 : 1); ++rep) for (int ui = 0; ui < 4; ++ui) {
                                  ph_attn_a(KA, lw, ui, 0); if (PROBE_DUP == 12) ph_attn_a(KA, lw, ui, 0);
                                  ph_attn_b(KA, lw, ui);
                                  __syncthreads(); const unsigned okv = (unsigned)__builtin_amdgcn_readfirstlane((int)*(volatile LAS unsigned*)(lds + A_OK)); __syncthreads();
                                  if (!okv) { ph_attn_a(KA, lw, ui, 1); ph_attn_b(KA, lw, ui); }
                                  if (PROBE_DUP == 9) ph_attn_b(KA, lw, ui); }
                              for (int rep = 0; rep < (PROBE_DUP == 2 ? 2 : 1); ++rep) ph_attn2(KA, lw, l); }
#else
            if (IN(p0 + 5)) ph_attn(KA, lw, l);
#endif
            if (PROBE_DUP == 5) SEAM(p0 + 5); else __syncthreads();
            for (int rep = 0; rep < (PROBE_DUP == 5 ? 2 : 1); ++rep) {
            if (IN(p0 + 6)) ph_ssm_state(KA, lw, l);
            SEAM(p0 + 6);
            if (IN(p0 + 7)) ph_ssm_scan(KA, lw, l);
            SEAM(p0 + 7);
            if (IN(p0 + 8)) ph_ssm_out(KA, lw, l);
            SEAM(p0 + 8);
            if (IN(p0 + 9)) ph_glu(KA, lw, l);
            SEAM(p0 + 9);
            if (IN(p0 + 10)) ph_ssm_norm(KA, lw, l);
            SEAM(p0 + 10);
            }
            if (IN(p0 + 11)) ph_wout(KA, lw, l);
            SEAM(p0 + 11);
        }
    }
    if (IN(N_PHASES - 1)) ph_final(KA, lw);
#undef IN
#undef SEAM
}

extern "C" void kernel_launch(void* const* d_in, const int* in_sizes, int n_in, void* d_out, int out_size, void* d_ws, size_t ws_size, hipStream_t stream) {
    static int grid = 0;
    if (grid == 0) {
        if (n_in != 27 || in_sizes[0] != MTOK * DM || out_size != MTOK * DM || ws_size < WS_END) { fprintf(stderr, "kernel_launch: unexpected shapes (n_in %d, in0 %d, out %d, ws %zu < %zu)\n", n_in, n_in > 0 ? in_sizes[0] : -1, out_size, ws_size, (size_t)WS_END); grid = -1; return; }
        int dev = 0, cus = 0;
        if (hipGetDevice(&dev) != hipSuccess || hipDeviceGetAttribute(&cus, hipDeviceAttributeMultiprocessorCount, dev) != hipSuccess) { grid = -1; return; }
        if (hipFuncSetAttribute((const void*)fwd, hipFuncAttributeMaxDynamicSharedMemorySize, LDS_BYTES) != hipSuccess) { fprintf(stderr, "kernel_launch: hipFuncSetAttribute failed\n"); grid = -1; return; }
        int per_cu = 0;
        if (hipOccupancyMaxActiveBlocksPerMultiprocessor(&per_cu, (const void*)fwd, 512, LDS_BYTES) != hipSuccess || per_cu < 1) fprintf(stderr, "kernel_launch: occupancy query reports %d\n", per_cu);
        (void)hipGetLastError();
        grid = cus;
    }
    if (grid < 0) return;
    (void)hipMemsetAsync((char*)d_ws + WS_CTL, 0, CTL_ZERO_BYTES, stream);
    Args a{};
    for (int i = 0; i < 27; ++i) a.in[i] = d_in[i];
    a.out = (float*)d_out; a.ws = (unsigned char*)d_ws;
#if MK_ONE_LAUNCH
    a.ph_lo = 0; a.ph_hi = N_PHASES;
    hipLaunchKernelGGL(fwd, dim3(grid), dim3(512), LDS_BYTES, stream, a);
#else
    for (int p = 0; p < N_PHASES; ++p) { a.ph_lo = p; a.ph_hi = p + 1; hipLaunchKernelGGL(fwd, dim3(grid), dim3(512), LDS_BYTES, stream, a); }
#endif
}
```

```cpp
#include <hip/hip_runtime.h>
#include <cstdio>
#include <cstdint>

#ifndef ATTN_FAST
#define ATTN_FAST 1
#endif
#ifndef PROBE_DUP
#define PROBE_DUP 0
#endif
#ifndef ATTN_SAMPLE
#define ATTN_SAMPLE 0
#endif
#ifndef SPEC_NUM
#define SPEC_NUM 704
#endif
#ifndef PROBE_FALLBACK
#define PROBE_FALLBACK 0
#endif
#ifndef DEBUG_STAT
#define DEBUG_STAT 0
#endif
#ifndef FFN_ALIGN
#define FFN_ALIGN true
#endif
#ifndef FFN_SP2
#define FFN_SP2 true
#endif
#ifndef MK_ONE_LAUNCH
#define MK_ONE_LAUNCH 1
#endif

constexpr int NB = 4, SEQ = 8192, DM = 1024, DEPTH = 4, MTOK = NB * SEQ;
constexpr int DFF = 2816, NFF1 = 2 * DFF;
constexpr int ATTN_W = 512, NH = 8, HD = 64, IDXH = 4, TOPK = 256;
constexpr int SSM_W = 512, SG = 32, GC = 16, SP = 64;
constexpr int LCH = 32, NCHK = MTOK / LCH, CHB = SEQ / LCH, KT = LCH * GC, KSS = KT + 2 * SP;
constexpr int INC = 1476, NWIN = 1536, NMOD = 9;
constexpr float EPS = 1e-6f, ATT_SCALE = 0.125f, IDX_SCALE = 0.0625f;

namespace pg8 {
#define PG8_LAS __attribute__((address_space(3)))
typedef unsigned short bf16_t;
typedef short bf16x8 __attribute__((ext_vector_type(8)));
typedef float f32x4 __attribute__((ext_vector_type(4)));
typedef unsigned u32x4 __attribute__((ext_vector_type(4)));
constexpr int BM = 256, BK = 64, HALF = 128, HTB = HALF * BK * 2, STAGE_BYTES = 8 * HTB, NXCD = 8, WGM = 8;

__host__ __device__ __forceinline__ int lds_byte(int r, int c) { const int st = (r >> 4) * 2 + (c >> 5), rr = r & 15, cc = c & 31, ob = rr * 64 + cc * 2; return st * 1024 + (ob ^ (((ob >> 9) & 1) << 5)); }
__host__ __device__ __forceinline__ void stage_rc(int b, int& R, int& C) { const int st = b / 1024, sb = b % 1024, swz = sb ^ (((sb >> 9) & 1) << 5); R = (st >> 1) * 16 + swz / 64; C = (st & 1) * 32 + (swz % 64) / 2; }
__host__ __device__ __forceinline__ int perm32(int rho) { const int n = rho >> 4, i = rho & 15; return 8 * (i >> 2) + 4 * n + (i & 3); }

struct Unit { int pm, pn; };

template <int NM, int NN> struct StaticOrder {
    static constexpr int nM = NM, nN = NN, nwg = NM * NN;
    int G, c;
    __host__ __device__ void init(int G_, int c_) { G = G_; c = c_; }
    __host__ __device__ bool next(int i, Unit& u) const {
        const long L = (long)i * G + c; if (L >= nwg) return false;
        int wgid = (int)L; { constexpr int q = nwg / NXCD, r = nwg % NXCD; const int xcd = wgid % NXCD, off = wgid / NXCD; wgid = (xcd < r ? xcd * (q + 1) : r * (q + 1) + (xcd - r) * q) + off; }
        constexpr int nig = WGM * nN; const int gid = wgid / nig, fm = gid * WGM, gsz = (nM - fm) < WGM ? (nM - fm) : WGM;
        u.pm = fm + ((wgid % nig) % gsz); u.pn = (wgid % nig) / gsz; return true;
    }
    __device__ __forceinline__ void a_ready(const Unit&) const {}
    __device__ __forceinline__ void done(const Unit&) const {}
};

__device__ __forceinline__ unsigned cvt_pk_bf16(float lo, float hi) { unsigned r; asm volatile("v_cvt_pk_bf16_f32 %0, %1, %2" : "=v"(r) : "v"(lo), "v"(hi)); return r; }

template <int LDA, int LDB, int NKT> struct GemmRM {
    const bf16_t* A; const bf16_t* Bt;
    static constexpr int nkt = NKT;
    __device__ __forceinline__ unsigned aVoff(int R, int C) const { return (unsigned)(R * LDA + C) * 2u; }
    __device__ __forceinline__ unsigned bVoff(int R, int C) const { return (unsigned)(R * LDB + C) * 2u; }
    __device__ __forceinline__ unsigned aK() const { return 128u; }
    __device__ __forceinline__ unsigned bK() const { return 128u; }
    __device__ __forceinline__ unsigned aH() const { return (unsigned)HALF * LDA * 2u; }
    __device__ __forceinline__ unsigned bH() const { return (unsigned)HALF * LDB * 2u; }
    __device__ __forceinline__ unsigned aOff(const Unit& u) const { return (unsigned)u.pm * (256u * LDA * 2u); }
    __device__ __forceinline__ unsigned bOff(const Unit& u) const { return (unsigned)u.pn * (256u * LDB * 2u); }
};
template <int LDA, int LDB, int NKT, int SCALE_W, int SKM_ = 0, int SKN_ = 0, int PROBE_ = 0  > struct GemmF8 {
    const unsigned char* A; const unsigned char* Bt;
    static constexpr int nkt = NKT; static constexpr bool F8 = true; static constexpr int SW = SCALE_W; static constexpr int SKM = SKM_, SKN = SKN_, PROBE = PROBE_;
    __device__ __forceinline__ unsigned aVoff(int R, int C) const { return (unsigned)(R * LDA + 2 * C); }
    __device__ __forceinline__ unsigned bVoff(int R, int C) const { return (unsigned)(R * LDB + 2 * C); }
    __device__ __forceinline__ unsigned aK() const { return 128u; }
    __device__ __forceinline__ unsigned bK() const { return 128u; }
    __device__ __forceinline__ unsigned aH() const { return (unsigned)HALF * LDA; }
    __device__ __forceinline__ unsigned bH() const { return (unsigned)HALF * LDB; }
    __device__ __forceinline__ unsigned aOff(const Unit& u) const { return (unsigned)u.pm * (256u * LDA); }
    __device__ __forceinline__ unsigned bOff(const Unit& u) const { return (unsigned)u.pn * (256u * LDB); }
};
template <class GP, class = void> struct gp_is_f8 { static constexpr bool value = false; static constexpr int sw = 127; };
template <class GP> struct gp_is_f8<GP, decltype((void)GP::F8)> { static constexpr bool value = GP::F8; static constexpr int sw = GP::SW; };
template <class GP, class = void> struct gp_probe { static constexpr int value = 0; };
template <class GP> struct gp_probe<GP, decltype((void)GP::PROBE)> { static constexpr int value = GP::PROBE; };
template <class GP, class = void> struct gp_skew { static constexpr bool value = false; static constexpr int SKM = 0, SKN = 0; };
template <class GP> struct gp_skew<GP, decltype((void)GP::SKM)> { static constexpr bool value = (GP::SKM != 0 || GP::SKN != 0); static constexpr int SKM = GP::SKM, SKN = GP::SKN; };
typedef int i32x8 __attribute__((ext_vector_type(8)));
typedef int i32x4 __attribute__((ext_vector_type(4)));
__device__ __forceinline__ i32x8 cat32(bf16x8 lo, bf16x8 hi) { const i32x4 a = __builtin_bit_cast(i32x4, lo), b = __builtin_bit_cast(i32x4, hi); return __builtin_shufflevector(a, b, 0, 1, 2, 3, 4, 5, 6, 7); }
template <int LDA, int LDB, int NKT, int BROWS> struct GemmSsm {
    const bf16_t* A; const bf16_t* Bt;
    static constexpr int nkt = NKT;
    __device__ __forceinline__ unsigned aVoff(int R, int C) const { return (unsigned)(R * LDA + C) * 2u; }
    __device__ __forceinline__ unsigned bVoff(int R, int C) const { return (unsigned)(R * LDB + C) * 2u; }
    __device__ __forceinline__ unsigned aK() const { return 128u; }
    __device__ __forceinline__ unsigned bK() const { return 128u; }
    __device__ __forceinline__ unsigned aH() const { return (unsigned)HALF * LDA * 2u; }
    __device__ __forceinline__ unsigned bH() const { return (unsigned)HALF * LDB * 2u; }
    __device__ __forceinline__ unsigned aOff(const Unit& u) const { return (unsigned)u.pm * (256u * LDA * 2u); }
    __device__ __forceinline__ unsigned bOff(const Unit& u) const { return ((unsigned)(u.pm >> 2) * BROWS + (unsigned)u.pn * 256u) * (LDB * 2u); }
};
struct GemmGlu {
    const bf16_t* A; const bf16_t* Bt;
    static constexpr int nkt = 8;
    __device__ __forceinline__ unsigned aVoff(int R, int C) const { return (unsigned)((C >> 4) * (NCHK * KT) + (R >> 5) * KT + (R & 31) * 16 + (C & 15)) * 2u; }
    __device__ __forceinline__ unsigned bVoff(int R, int C) const { return (unsigned)(R * 512 + C) * 2u; }
    __device__ __forceinline__ unsigned aK() const { return 4u * NCHK * KT * 2u; }
    __device__ __forceinline__ unsigned bK() const { return 128u; }
    __device__ __forceinline__ unsigned aH() const { return 4u * KT * 2u; }
    __device__ __forceinline__ unsigned bH() const { return (unsigned)HALF * 512u * 2u; }
    __device__ __forceinline__ unsigned aOff(const Unit& u) const { return (unsigned)u.pm * (8u * KT * 2u); }
    __device__ __forceinline__ unsigned bOff(const Unit& u) const { return (unsigned)u.pn * (256u * 512u * 2u); }
};

template <class GP, class Epi, class Sched, bool ALIGN_EPI = false, bool SP2 = false>
__device__ __forceinline__ void gemm_phase(PG8_LAS unsigned char* lds_w, const GP g, const Sched& S, const Epi& E) {
    const unsigned ldsq = (unsigned)__builtin_amdgcn_readfirstlane((int)(unsigned)(size_t)lds_w);
    PG8_LAS unsigned char* const lds = (PG8_LAS unsigned char*)(size_t)(ldsq & 0xFFFFFFu);
    const int wid0 = (int)(ldsq >> 24), wid = (gp_probe<GP>::value == 3) ? (((wid0 & 1) << 2) | (wid0 >> 1)) : wid0, lane = (int)__builtin_amdgcn_mbcnt_hi(~0u, __builtin_amdgcn_mbcnt_lo(~0u, 0u)), tid = wid * 64 + lane, wr = wid >> 2, wc = wid & 3, fr = lane & 15, fq = lane >> 4;
    const int nt = g.nkt;
    unsigned voffA[2], voffB[2];
#pragma unroll
    for (int i = 0; i < 2; ++i) { int R, C; stage_rc(tid * 16 + i * 8192, R, C); const int Rb = Epi::PERM ? ((R & ~31) + perm32(R & 31)) : R;
        voffA[i] = g.aVoff(R, C); voffB[i] = g.bVoff(Rb, C); }
    const unsigned kstepA = g.aK(), kstepB = g.bK(), hstepA = g.aH(), hstepB = g.bH();
    const char* const baseA = (const char*)g.A; const char* const baseB = (const char*)g.Bt;
    const unsigned ldsw = (unsigned)wid * 1024u;
    const int aoff = lds_byte(wr * 64 + fr, fq * 8), boff = lds_byte(wc * 32 + fr, fq * 8);
#define PG8_SA(b, h) (((b) * 2 + (h)) * HTB)
#define PG8_SB(b, h) ((4 + (b) * 2 + (h)) * HTB)
#define PG8_STAGE_(bufoff, base, goff, voff) do { if constexpr (gp_probe<GP>::value != 2) _Pragma("unroll") for (int _i = 0; _i < 2; ++_i) \
        __builtin_amdgcn_global_load_lds((const unsigned*)((base) + (unsigned)((goff) + (voff)[_i])), (PG8_LAS unsigned*)(lds + (bufoff) + ldsw + _i * 8192), 16, 0, 0); } while (0)
#define PG8_STAGE(bufoff, goff, voff) PG8_STAGE_(bufoff, PG8_BASE_##voff, goff, voff)
#define PG8_BASE_voffA baseA
#define PG8_BASE_voffB baseB
#define PG8_LDA(dst, b, h) do { _Pragma("unroll") for (int m = 0; m < 4; ++m) { \
        if constexpr (gp_is_f8<GP>::value) dst##8[m] = cat32(*(const PG8_LAS bf16x8*)(lds + PG8_SA(b, h) + aoff + m * 2048), *(const PG8_LAS bf16x8*)(lds + PG8_SA(b, h) + aoff + m * 2048 + 1024)); \
        else { _Pragma("unroll") for (int k = 0; k < 2; ++k) dst[m][k] = *(const PG8_LAS bf16x8*)(lds + PG8_SA(b, h) + aoff + m * 2048 + k * 1024); } } } while (0)
#define PG8_LDB(dst, b, h) do { _Pragma("unroll") for (int n = 0; n < 2; ++n) { \
        if constexpr (gp_is_f8<GP>::value) dst##8[n] = cat32(*(const PG8_LAS bf16x8*)(lds + PG8_SB(b, h) + boff + n * 2048), *(const PG8_LAS bf16x8*)(lds + PG8_SB(b, h) + boff + n * 2048 + 1024)); \
        else { _Pragma("unroll") for (int k = 0; k < 2; ++k) dst[n][k] = *(const PG8_LAS bf16x8*)(lds + PG8_SB(b, h) + boff + n * 2048 + k * 1024); } } } while (0)
#define PG8_MMA(ai, bj, At, Bt) do { __builtin_amdgcn_s_setprio(1); _Pragma("unroll") for (int m = 0; m < 4; ++m) _Pragma("unroll") for (int n = 0; n < 2; ++n) { \
        if constexpr (gp_probe<GP>::value == 1) { asm volatile("" :: "v"(Bt##8[n]), "v"(At##8[m])); } else \
        if constexpr (gp_is_f8<GP>::value) acc[ai][bj][m][n] = __builtin_amdgcn_mfma_scale_f32_16x16x128_f8f6f4(Bt##8[n], At##8[m], acc[ai][bj][m][n], 0, 0, 0, gp_is_f8<GP>::sw, 0, gp_is_f8<GP>::sw); \
        else { _Pragma("unroll") for (int k = 0; k < 2; ++k) acc[ai][bj][m][n] = __builtin_amdgcn_mfma_f32_16x16x32_bf16(Bt[n][k], At[m][k], acc[ai][bj][m][n], 0, 0, 0); } } __builtin_amdgcn_s_setprio(0); } while (0)
#define PG8_WAIT_V(n) asm volatile("s_waitcnt vmcnt(" #n ")" ::: "memory")
#define PG8_WAIT_L(n) asm volatile("s_waitcnt lgkmcnt(" #n ")" ::: "memory")
#define PG8_BAR __builtin_amdgcn_s_barrier()
#define PG8_SCHED __builtin_amdgcn_sched_barrier(0)
    Unit cur, nxt; int ui = 0;
    if (!S.next(0, cur)) return;
    f32x4 acc[2][2][4][2];
#pragma unroll
    for (int a = 0; a < 2; ++a)
#pragma unroll
        for (int b = 0; b < 2; ++b)
#pragma unroll
            for (int m = 0; m < 4; ++m)
#pragma unroll
                for (int n = 0; n < 2; ++n) acc[a][b][m][n] = (f32x4){0.f, 0.f, 0.f, 0.f};
    bf16x8 At[4][2], B0[2][2], B1[2][2];
    i32x8 At8[4], B08[2], B18[2];
    unsigned cA = g.aOff(cur), cB = g.bOff(cur);
    constexpr bool SKEW = gp_skew<GP>::value;
    auto kof = [&](const Unit& u) -> int { if constexpr (SKEW) return (int)((unsigned)(gp_skew<GP>::SKM * u.pm + gp_skew<GP>::SKN * u.pn) % (unsigned)GP::nkt); else return 0; };
    auto kx = [&](int t, int off) -> unsigned { if constexpr (SKEW) { int k = t + off; if (k >= nt) k -= nt; return (unsigned)k; } else return (unsigned)t; };
    int offc = kof(cur);
    S.a_ready(cur);
    { const unsigned p0A = cA + kx(0, offc) * kstepA, p0B = cB + kx(0, offc) * kstepB, p1A = cA + kx(1, offc) * kstepA, p1B = cB + kx(1, offc) * kstepB;
    if constexpr (SP2) {
        PG8_STAGE(PG8_SB(0, 0), p0B, voffB); PG8_STAGE(PG8_SB(0, 1), p0B + hstepB, voffB); PG8_STAGE(PG8_SA(0, 0), p0A, voffA); PG8_STAGE(PG8_SA(0, 1), p0A + hstepA, voffA);
        if (wr == 1) PG8_BAR;
        PG8_WAIT_V(2); PG8_BAR;
        PG8_STAGE(PG8_SB(1, 0), p1B, voffB); PG8_STAGE(PG8_SA(1, 0), p1A, voffA); PG8_STAGE(PG8_SB(1, 1), p1B + hstepB, voffB);
        PG8_WAIT_V(6); PG8_BAR;
    } else {
        PG8_STAGE(PG8_SB(0, 0), p0B, voffB); PG8_STAGE(PG8_SA(0, 0), p0A, voffA); PG8_STAGE(PG8_SB(0, 1), p0B + hstepB, voffB); PG8_STAGE(PG8_SA(0, 1), p0A + hstepA, voffA);
        if (wr == 1) PG8_BAR;
        PG8_WAIT_V(4); PG8_BAR;
        PG8_STAGE(PG8_SB(1, 0), p1B, voffB); PG8_STAGE(PG8_SA(1, 0), p1A, voffA); PG8_STAGE(PG8_SB(1, 1), p1B + hstepB, voffB);
        PG8_WAIT_V(6); PG8_BAR;
    } }
    for (;;) {
        const bool has_next = S.next(ui + 1, nxt);
        const unsigned nA = has_next ? g.aOff(nxt) : cA, nB = has_next ? g.bOff(nxt) : cB;
        const int offn = has_next ? kof(nxt) : offc;
#pragma unroll 1
        for (int t = 0; t < nt; t += 2) {
            const bool last = (t == nt - 2);
            const unsigned a1 = cA + kx(t + 1, offc) * kstepA;
            const unsigned k2 = last ? kx(0, offn) : kx(t + 2, offc), k3 = last ? kx(1, offn) : kx(t + 3, offc);
            const unsigned a2 = (last ? nA : cA) + k2 * kstepA, b2 = (last ? nB : cB) + k2 * kstepB;
            const unsigned a3 = SKEW ? (last ? nA : cA) + k3 * kstepA : a2 + kstepA, b3 = SKEW ? (last ? nB : cB) + k3 * kstepB : b2 + kstepB;
            if (last && has_next) S.a_ready(nxt);
            if constexpr (SP2) {
            PG8_LDB(B0, 0, 0); PG8_LDB(B1, 0, 1); PG8_SCHED; PG8_LDA(At, 0, 0); PG8_STAGE(PG8_SA(1, 1), a1 + hstepA, voffA);
            PG8_WAIT_V(8); PG8_WAIT_L(0); PG8_BAR; PG8_MMA(0, 0, At, B0); PG8_MMA(0, 1, At, B1); PG8_BAR; PG8_SCHED;
            PG8_LDA(At, 0, 1); PG8_STAGE(PG8_SB(0, 0), b2, voffB); PG8_STAGE(PG8_SB(0, 1), b2 + hstepB, voffB); PG8_STAGE(PG8_SA(0, 0), a2, voffA);
            PG8_WAIT_V(8); PG8_WAIT_L(0); PG8_BAR; PG8_MMA(1, 0, At, B0); PG8_MMA(1, 1, At, B1); PG8_BAR; PG8_SCHED;
            PG8_LDB(B0, 1, 0); PG8_LDB(B1, 1, 1); PG8_SCHED; PG8_LDA(At, 1, 0); PG8_STAGE(PG8_SA(0, 1), a2 + hstepA, voffA);
            PG8_WAIT_V(8); PG8_WAIT_L(0); PG8_BAR; PG8_MMA(0, 0, At, B0); PG8_MMA(0, 1, At, B1); PG8_BAR; PG8_SCHED;
            PG8_LDA(At, 1, 1); PG8_STAGE(PG8_SB(1, 0), b3, voffB); PG8_STAGE(PG8_SB(1, 1), b3 + hstepB, voffB); PG8_STAGE(PG8_SA(1, 0), a3, voffA);
            PG8_WAIT_V(8); PG8_WAIT_L(0); PG8_BAR; PG8_MMA(1, 0, At, B0); PG8_MMA(1, 1, At, B1); PG8_BAR; PG8_SCHED;
            } else {
            PG8_LDB(B0, 0, 0); PG8_SCHED; PG8_LDA(At, 0, 0); PG8_STAGE(PG8_SA(1, 1), a1 + hstepA, voffA);
            PG8_WAIT_L(8); PG8_BAR; PG8_WAIT_L(0); PG8_MMA(0, 0, At, B0); PG8_BAR; PG8_SCHED;
            PG8_LDB(B1, 0, 1); PG8_STAGE(PG8_SB(0, 0), b2, voffB);
            PG8_BAR; PG8_WAIT_L(0); PG8_MMA(0, 1, At, B1); PG8_BAR;
            PG8_LDA(At, 0, 1); PG8_STAGE(PG8_SA(0, 0), a2, voffA);
            PG8_BAR; PG8_WAIT_L(0); PG8_MMA(1, 0, At, B0); PG8_BAR; PG8_SCHED;
            PG8_STAGE(PG8_SB(0, 1), b2 + hstepB, voffB);
            PG8_WAIT_V(6); PG8_BAR; PG8_MMA(1, 1, At, B1); PG8_BAR;
            PG8_LDB(B0, 1, 0); PG8_SCHED; PG8_LDA(At, 1, 0); PG8_STAGE(PG8_SA(0, 1), a2 + hstepA, voffA);
            PG8_WAIT_L(8); PG8_BAR; PG8_WAIT_L(0); PG8_MMA(0, 0, At, B0); PG8_BAR; PG8_SCHED;
            PG8_LDB(B1, 1, 1); PG8_STAGE(PG8_SB(1, 0), b3, voffB);
            PG8_BAR; PG8_WAIT_L(0); PG8_MMA(0, 1, At, B1); PG8_BAR;
            PG8_LDA(At, 1, 1); PG8_STAGE(PG8_SA(1, 0), a3, voffA);
            PG8_BAR; PG8_WAIT_L(0); PG8_MMA(1, 0, At, B0); PG8_BAR; PG8_SCHED;
            PG8_STAGE(PG8_SB(1, 1), b3 + hstepB, voffB);
            PG8_WAIT_V(6); PG8_BAR; PG8_MMA(1, 1, At, B1); PG8_BAR;
            }
        }
        if constexpr (ALIGN_EPI) { if (wr == 0) PG8_BAR; }
        E(acc, cur, wr, wc, fr, fq); S.done(cur);
        if (!has_next) break;
#pragma unroll
        for (int a = 0; a < 2; ++a)
#pragma unroll
            for (int b = 0; b < 2; ++b)
#pragma unroll
                for (int m = 0; m < 4; ++m)
#pragma unroll
                    for (int n = 0; n < 2; ++n) acc[a][b][m][n] = (f32x4){0.f, 0.f, 0.f, 0.f};
        cur = nxt; cA = nA; cB = nB; offc = offn; ++ui;
        if constexpr (ALIGN_EPI) { if (wr == 1) PG8_BAR; }
    }
    PG8_WAIT_V(0);
    if constexpr (!ALIGN_EPI) { if (wr == 0) PG8_BAR; }
    PG8_BAR;
#undef PG8_SA
#undef PG8_SB
#undef PG8_STAGE
#undef PG8_STAGE_
#undef PG8_BASE_voffA
#undef PG8_BASE_voffB
#undef PG8_LDA
#undef PG8_LDB
#undef PG8_MMA
#undef PG8_WAIT_V
#undef PG8_WAIT_L
#undef PG8_BAR
#undef PG8_SCHED
}
}

constexpr size_t MiB = 1u << 20;
constexpr size_t WS_CTL = 0, CTL_ZERO_BYTES = 1 * MiB;
constexpr size_t WS_MOD = 1 * MiB;
constexpr size_t WS_ROPE = 2 * MiB;
constexpr size_t WS_AL = 4 * MiB;
constexpr size_t WS_W13 = 5 * MiB;
constexpr size_t WS_W2 = 49 * MiB;
constexpr size_t WS_XB = 72 * MiB;
constexpr size_t WS_WIN = 137 * MiB;
constexpr size_t WS_WOUT = 149 * MiB;
constexpr size_t WS_GLU = 157 * MiB;
constexpr size_t WS_BTV = 159 * MiB;
constexpr size_t WS_BW = 239 * MiB;
constexpr size_t WS_H = 256 * MiB;
constexpr size_t WS_R = 320 * MiB;
constexpr size_t R_Q = WS_R, R_KB = WS_R + 32 * MiB, R_VB = WS_R + 36 * MiB, R_QI = WS_R + 40 * MiB, R_KI = WS_R + 56 * MiB, R_WI = WS_R + 60 * MiB;
constexpr size_t R_UG = WS_R + 61 * MiB;
constexpr size_t R_SINC = WS_R + 101 * MiB;
constexpr size_t R_YG = WS_R + 117 * MiB;
constexpr size_t R_Y2 = WS_R + 149 * MiB;
constexpr size_t R_SEL = WS_R + 181 * MiB;
constexpr size_t WS_END = 517 * MiB;
constexpr int CW_BAR = 4096;

constexpr int RING_BYTES = 131072, LDSCTL_OFF = RING_BYTES, MISC_OFF = LDSCTL_OFF + 320, LDS_BYTES = 163840;

#define GAS __attribute__((address_space(1)))
#define LAS __attribute__((address_space(3)))
typedef unsigned short bf16;
typedef unsigned v4u __attribute__((ext_vector_type(4)));
typedef float f32x4 __attribute__((ext_vector_type(4)));
typedef GAS unsigned gu32;
#define RLX_AGENT __ATOMIC_RELAXED, __HIP_MEMORY_SCOPE_AGENT
#define LDS_WAIT() asm volatile("s_waitcnt lgkmcnt(0)" ::: "memory")
__device__ __forceinline__ unsigned f2bf(float f) { unsigned u = __builtin_bit_cast(unsigned, f); return (u + 0x7fffu + ((u >> 16) & 1u)) >> 16; }
__device__ __forceinline__ unsigned pk2(float lo, float hi) { unsigned r; asm("v_cvt_pk_bf16_f32 %0, %1, %2" : "=v"(r) : "v"(lo), "v"(hi)); return r; }
__device__ __forceinline__ unsigned pk8(float a, float b, float c, float d) {
    a = __builtin_amdgcn_fmed3f(a, -448.f, 448.f); b = __builtin_amdgcn_fmed3f(b, -448.f, 448.f); c = __builtin_amdgcn_fmed3f(c, -448.f, 448.f); d = __builtin_amdgcn_fmed3f(d, -448.f, 448.f);
    int v = __builtin_amdgcn_cvt_pk_fp8_f32(a, b, 0, false); v = __builtin_amdgcn_cvt_pk_fp8_f32(c, d, v, true); return (unsigned)v; }
__device__ __forceinline__ float bf2f(unsigned short b) { return __builtin_bit_cast(float, (unsigned)b << 16); }
__device__ __forceinline__ float bflo(unsigned w) { return __builtin_bit_cast(float, w << 16); }
__device__ __forceinline__ float bfhi(unsigned w) { return __builtin_bit_cast(float, w & 0xffff0000u); }

#define XB_TMO      128
#define XB_XCNT(j)  (256  + 64 * (j))
#define XB_XSUB(j)  (1280 + 64 * (j))
#define XB_XGEN(j)  (2304 + 64 * (j))
#define XB_TOP      3328
#define XB_TOPGEN   3392
#define XCD_BAR_WORDS 3456
#define XB_SPIN_CAP (1u << 18)
__device__ __forceinline__ unsigned xb_ld(unsigned* p)              { return __hip_atomic_load(p, __ATOMIC_RELAXED, __HIP_MEMORY_SCOPE_AGENT); }
__device__ __forceinline__ unsigned xb_add(unsigned* p, unsigned v) { return __hip_atomic_fetch_add(p, v, __ATOMIC_RELAXED, __HIP_MEMORY_SCOPE_AGENT); }
__device__ __forceinline__ unsigned xb_xcc_id() { return (unsigned)__builtin_amdgcn_s_getreg((3 << 11) | 20) & 0xFu; }
#define XB_SPIN(cond, bar) do { unsigned _sp = 0; while (cond) { __builtin_amdgcn_s_sleep(1); \
    if ((++_sp & 255u) == 0u) { if (xb_ld(&(bar)[XB_TMO])) break; if (_sp > XB_SPIN_CAP) { atomicAdd(&(bar)[XB_TMO], 1u); break; } } } } while (0)
struct XcdBarrier { unsigned* bar; unsigned x; volatile LAS unsigned* st; };
__device__ __forceinline__ XcdBarrier xcd_barrier_post(unsigned* bar, volatile LAS unsigned* st) {
    XcdBarrier b; b.bar = bar; b.x = xb_xcc_id(); b.st = st;
    if (threadIdx.x == 0) (void)xb_add(&bar[XB_XCNT(b.x)], 1u);
    return b;
}
__device__ __forceinline__ void xcd_barrier_complete(unsigned* bar, unsigned x, unsigned& nloc, unsigned& nx) {
    const unsigned G = gridDim.x * gridDim.y * gridDim.z;
    unsigned sum, cnt, mine, sp = 0u;
    for (;;) {
        sum = 0u; cnt = 0u; mine = 0u;
#pragma unroll
        for (unsigned j = 0; j < 16; ++j) { const unsigned c = xb_ld(&bar[XB_XCNT(j)]); sum += c; cnt += (c > 0u) ? 1u : 0u; mine = (j == x) ? c : mine; }
        if (sum == G) break;
        __builtin_amdgcn_s_sleep(1);
        if ((++sp & 255u) == 0u) { if (xb_ld(&bar[XB_TMO])) break; if (sp > XB_SPIN_CAP) { atomicAdd(&bar[XB_TMO], 1u); break; } }
    }
    nloc = mine > 0u ? mine : 1u; nx = cnt > 0u ? cnt : 1u;
}
__device__ __forceinline__ void xcd_barrier(const XcdBarrier& b, const bool t0) {
    asm volatile("s_waitcnt vmcnt(0)" ::: "memory");
    __syncthreads();
    if (t0) {
        unsigned* bar = b.bar;
        __builtin_amdgcn_s_waitcnt(0);
        unsigned nloc = b.st[0], nx = b.st[1];
        if (nloc == 0u) { xcd_barrier_complete(bar, b.x, nloc, nx); b.st[0] = nloc; b.st[1] = nx; }
        const unsigned old = xb_add(&bar[XB_XSUB(b.x)], 1u);
        const unsigned gen = old / nloc;
        if (old + 1u == (gen + 1u) * nloc) {
            __builtin_amdgcn_fence(__ATOMIC_RELEASE, "agent");
            asm volatile("s_waitcnt vmcnt(0)" ::: "memory");
            const unsigned og = xb_add(&bar[XB_TOP], 1u);
            const unsigned tg = og / nx;
            if (og + 1u == (tg + 1u) * nx) xb_add(&bar[XB_TOPGEN], 1u);
            else XB_SPIN(xb_ld(&bar[XB_TOPGEN]) == tg, bar);
            __builtin_amdgcn_fence(__ATOMIC_ACQUIRE, "agent");
            xb_add(&bar[XB_XGEN(b.x)], 1u);
            asm volatile("s_waitcnt vmcnt(0)" ::: "memory");
        } else {
            XB_SPIN(xb_ld(&bar[XB_XGEN(b.x)]) == gen, bar);
            __builtin_amdgcn_fence(__ATOMIC_ACQUIRE, "agent");
            asm volatile("s_waitcnt vmcnt(0)" ::: "memory");
        }
    }
    __syncthreads();
}

struct Args { const void* in[27]; float* out; unsigned char* ws; int ph_lo, ph_hi, pad0, pad1; };
typedef const __attribute__((address_space(4))) Args CArgs;
__device__ __forceinline__ const CArgs* karg(const CArgs* p) { const unsigned long long v = (unsigned long long)p; const unsigned lo = __builtin_amdgcn_readfirstlane((unsigned)v), hi = __builtin_amdgcn_readfirstlane((unsigned)(v >> 32)); return (const CArgs*)(((unsigned long long)hi << 32) | lo); }
struct Frame {
    LAS unsigned char* lds; unsigned char* ws;
    int tid, lane, wave, vcu, G;
};
__device__ __forceinline__ float wave_sum(float v) {
#define WS_DPP(x, ctrl, rm) __builtin_bit_cast(float, __builtin_amdgcn_update_dpp(0, __builtin_bit_cast(int, (x)), ctrl, rm, 0xF, false))
    v += WS_DPP(v, 0x111, 0xF); v += WS_DPP(v, 0x112, 0xF); v += WS_DPP(v, 0x114, 0xF); v += WS_DPP(v, 0x118, 0xF);
    v += WS_DPP(v, 0x142, 0xA); v += WS_DPP(v, 0x143, 0xC);
#undef WS_DPP
    return __builtin_bit_cast(float, __builtin_amdgcn_readlane(__builtin_bit_cast(int, v), 63));
}
__device__ __forceinline__ float wave_max(float v) {
#pragma unroll
    for (int o = 1; o < 64; o <<= 1) v = fmaxf(v, __shfl_xor(v, o));
    return v;
}
__device__ __forceinline__ float sigmoidf_(float x) { return __builtin_amdgcn_rcpf(1.0f + __expf(-x)); }
__device__ __forceinline__ float gelu_tanh(float x) { const float u = 0.7978845608028654f * (x + 0.044715f * x * x * x); return x * sigmoidf_(2.0f * u); }

using pg8::Unit; using pg8::cvt_pk_bf16;
struct EpiSwiGLU {
    static constexpr bool PERM = true;
    unsigned char* O;
    __device__ __forceinline__ void operator()(const f32x4 (&acc)[2][2][4][2], const Unit& u, int wr, int wc, int fr, int fq) const {
        { int ln; asm volatile("v_mbcnt_lo_u32_b32 %0, -1, 0\n\tv_mbcnt_hi_u32_b32 %0, -1, %0" : "=v"(ln)); fr = ln & 15; fq = ln >> 4; }
        const int row0 = u.pm * 256 + wr * 64 + fr, col0 = u.pn * 128 + wc * 32 + 8 * fq;
#pragma unroll
        for (int ai = 0; ai < 2; ++ai)
#pragma unroll
            for (int m = 0; m < 4; ++m) {
                unsigned char* p = O + (size_t)(row0 + ai * 128 + m * 16) * DFF + col0;
                float o[8];
#pragma unroll
                for (int n = 0; n < 2; ++n)
#pragma unroll
                    for (int e = 0; e < 4; ++e) { const float a = acc[ai][0][m][n][e], b = acc[ai][1][m][n][e]; o[4 * n + e] = (a + a) * sigmoidf_(a) * b; }
                *(unsigned long long*)p = (unsigned long long)pk8(o[0], o[1], o[2], o[3]) | ((unsigned long long)pk8(o[4], o[5], o[6], o[7]) << 32);
            }
    }
};
struct EpiResid {
    static constexpr bool PERM = true;
    const bf16* xin; bf16* xout; const float* gate; float coef;
    __device__ __forceinline__ void operator()(const f32x4 (&acc)[2][2][4][2], const Unit& u, int wr, int wc, int fr, int fq) const {
        { int ln; asm volatile("v_mbcnt_lo_u32_b32 %0, -1, 0\n\tv_mbcnt_hi_u32_b32 %0, -1, %0" : "=v"(ln)); fr = ln & 15; fq = ln >> 4; }
        const unsigned row0 = (unsigned)(u.pm * 256 + wr * 64 + fr), col0 = (unsigned)(u.pn * 256 + wc * 32 + 8 * fq);
        const float* gp = gate + (size_t)((u.pm * 256) >> 13) * (NMOD * DM) + col0;
        f32x4 gv[2][2];
#pragma unroll
        for (int bj = 0; bj < 2; ++bj)
#pragma unroll
            for (int n = 0; n < 2; ++n) gv[bj][n] = *(const f32x4*)(gp + bj * 128 + n * 4) * coef;
#pragma unroll
        for (int ai = 0; ai < 2; ++ai)
#pragma unroll
            for (int m = 0; m < 4; ++m) { const unsigned off = (row0 + ai * 128 + m * 16) * (unsigned)DM + col0;
#pragma unroll
                for (int bj = 0; bj < 2; ++bj) { const v4u q = *(const v4u*)(xin + off + bj * 128);
                    const f32x4 a0 = gv[bj][0] * acc[ai][bj][m][0], a1 = gv[bj][1] * acc[ai][bj][m][1];
                    v4u o; o.x = pk2(bflo(q.x) + a0.x, bfhi(q.x) + a0.y); o.y = pk2(bflo(q.y) + a0.z, bfhi(q.y) + a0.w); o.z = pk2(bflo(q.z) + a1.x, bfhi(q.z) + a1.y); o.w = pk2(bflo(q.w) + a1.z, bfhi(q.w) + a1.w);
                    *(v4u*)(xout + off + bj * 128) = o; } }
    }
};
struct EpiWin {
    static constexpr bool PERM = true;
    unsigned char* ws;
    __device__ __forceinline__ void operator()(const f32x4 (&acc)[2][2][4][2], const Unit& u, int wr, int wc, int fr, int fq) const {
        const int row0 = u.pm * 256 + wr * 64 + fr;
#pragma unroll 1
        for (int bj = 0; bj < 2; ++bj) {
            const int C0 = u.pn * 256 + bj * 128 + wc * 32, G64 = C0 >> 6, w0 = (C0 & 63) + 8 * fq;
            const bool do_rope = ((C0 & 63) == 0) && (G64 <= 8 || (G64 >= 10 && G64 <= 14));
            size_t boff; int S1, S2, loff = w0; float scl = 1.0f;
            if (G64 < 8) { boff = R_Q + (size_t)G64 * 128; S2 = ATTN_W; S1 = 32 * ATTN_W; scl = ATT_SCALE * 1.4426950408889634f; }
            else if (G64 == 8) { boff = R_KB; S2 = 64; S1 = 32 * 64; }
            else if (G64 == 9) { boff = R_VB; S2 = 64; S1 = 32 * 64; }
            else if (G64 < 14) { boff = R_QI + (size_t)(G64 - 10) * 4096; S2 = 8; S1 = 32 * 256; loff = (w0 >> 3) * 256; }
            else if (G64 == 14) { boff = R_KI; S2 = 8; S1 = 32 * 64; loff = (w0 >> 3) * 256; }
            else if (G64 == 15) { boff = R_WI; S2 = 8; S1 = 32 * 8; scl = IDX_SCALE; loff = 0; }
            else { boff = R_UG + (size_t)((C0 - 1024) >> 4) * ((size_t)NCHK * KSS * 2); S2 = 16; S1 = KSS; loff = (fq >> 1) * (NCHK * KSS) + 8 * (fq & 1); }
            bf16* const dst = (bf16*)(ws + boff) + loff;
            const float* const rope = (const float*)(ws + WS_ROPE);
            const float sg = (fq == 0) ? -1.f : 1.f;
#pragma unroll
            for (int ai = 0; ai < 2; ++ai)
#pragma unroll
                for (int m = 0; m < 4; ++m) {
                    const int row = row0 + ai * 128 + m * 16;
                    float v[8];
#pragma unroll
                    for (int n = 0; n < 2; ++n)
#pragma unroll
                        for (int e = 0; e < 4; ++e) v[4 * n + e] = (bj == 0) ? acc[ai][0][m][n][e] : acc[ai][1][m][n][e];
                    if (do_rope) {
                        const f32x4 c0 = *(const f32x4*)(rope + (size_t)row * 16), c1 = *(const f32x4*)(rope + (size_t)row * 16 + 4);
                        const f32x4 s0 = *(const f32x4*)(rope + (size_t)row * 16 + 8), s1 = *(const f32x4*)(rope + (size_t)row * 16 + 12);
                        const float cs[8] = {c0[0], c0[1], c0[2], c0[3], c1[0], c1[1], c1[2], c1[3]}, sn[8] = {s0[0], s0[1], s0[2], s0[3], s1[0], s1[1], s1[2], s1[3]};
#pragma unroll
                        for (int i = 0; i < 8; ++i) { const float pr = __shfl_xor(v[i], 16); const float r = v[i] * cs[i] + sg * pr * sn[i]; v[i] = (fq < 2) ? r : v[i]; }
                    }
#pragma unroll
                    for (int i = 0; i < 8; ++i) v[i] *= scl;
                    bf16* const p = dst + (size_t)((row >> 5) * S1 + (row & 31) * S2);
                    if (G64 == 15) { if (w0 == 0) *(f32x4*)p = (f32x4){v[0], v[1], v[2], v[3]}; }
                    else { v4u w; w.x = cvt_pk_bf16(v[0], v[1]); w.y = cvt_pk_bf16(v[2], v[3]); w.z = cvt_pk_bf16(v[4], v[5]); w.w = cvt_pk_bf16(v[6], v[7]); *(v4u*)p = w; }
                }
        }
    }
};
struct EpiSsmState {
    static constexpr bool PERM = false;
    float* S;
    __device__ __forceinline__ void operator()(const f32x4 (&acc)[2][2][4][2], const Unit& u, int wr, int wc, int fr, int fq) const {
        const int row0 = u.pm * 256 + wr * 64 + fr, col0 = wc * 32 + 4 * fq;
#pragma unroll
        for (int ai = 0; ai < 2; ++ai)
#pragma unroll
            for (int m = 0; m < 4; ++m)
#pragma unroll
                for (int n = 0; n < 2; ++n) *(f32x4*)(S + (size_t)(row0 + ai * 128 + m * 16) * 128 + col0 + n * 16) = acc[ai][0][m][n];
    }
};
struct EpiSsmOut {
    static constexpr bool PERM = true;
    bf16* Y;
    __device__ __forceinline__ void operator()(const f32x4 (&acc)[2][2][4][2], const Unit& u, int wr, int wc, int fr, int fq) const {
        const int row0 = u.pm * 256 + wr * 64 + fr, col0 = u.pn * 256 + wc * 32 + 8 * fq;
#pragma unroll
        for (int ai = 0; ai < 2; ++ai)
#pragma unroll
            for (int m = 0; m < 4; ++m)
#pragma unroll
                for (int bj = 0; bj < 2; ++bj) {
                    float o[8];
#pragma unroll
                    for (int n = 0; n < 2; ++n)
#pragma unroll
                        for (int e = 0; e < 4; ++e) o[4 * n + e] = gelu_tanh(acc[ai][bj][m][n][e]);
                    v4u w; w.x = cvt_pk_bf16(o[0], o[1]); w.y = cvt_pk_bf16(o[2], o[3]); w.z = cvt_pk_bf16(o[4], o[5]); w.w = cvt_pk_bf16(o[6], o[7]);
                    *(v4u*)(Y + (size_t)(row0 + ai * 128 + m * 16) * KT + col0 + bj * 128) = w;
                }
    }
};
struct EpiGlu {
    static constexpr bool PERM = true;
    const bf16* YG; bf16* Y2; const float* gb;
    __device__ __forceinline__ void operator()(const f32x4 (&acc)[2][2][4][2], const Unit& u, int wr, int wc, int fr, int fq) const {
        const int row0 = u.pm * 256 + wr * 64 + fr, col0 = u.pn * 256 + wc * 32 + 8 * fq;
#pragma unroll
        for (int bj = 0; bj < 2; ++bj) {
            const int col = col0 + bj * 128, gg = col >> 4, cc = col & 15;
            const f32x4 b0 = *(const f32x4*)(gb + col), b1 = *(const f32x4*)(gb + col + 4);
            const float bb[8] = {b0[0], b0[1], b0[2], b0[3], b1[0], b1[1], b1[2], b1[3]};
#pragma unroll
            for (int ai = 0; ai < 2; ++ai)
#pragma unroll
                for (int m = 0; m < 4; ++m) {
                    const int row = row0 + ai * 128 + m * 16;
                    const v4u yv = *(const v4u*)(YG + ((size_t)(gg * NCHK + (row >> 5))) * KT + (row & 31) * 16 + cc);
                    const float y[8] = {bflo(yv.x), bfhi(yv.x), bflo(yv.y), bfhi(yv.y), bflo(yv.z), bfhi(yv.z), bflo(yv.w), bfhi(yv.w)};
                    float o[8];
#pragma unroll
                    for (int n = 0; n < 2; ++n)
#pragma unroll
                        for (int e = 0; e < 4; ++e) o[4 * n + e] = y[4 * n + e] * sigmoidf_(acc[ai][bj][m][n][e] + bb[4 * n + e]);
                    v4u w; w.x = cvt_pk_bf16(o[0], o[1]); w.y = cvt_pk_bf16(o[2], o[3]); w.z = cvt_pk_bf16(o[4], o[5]); w.w = cvt_pk_bf16(o[6], o[7]);
                    *(v4u*)(Y2 + (size_t)row * SSM_W + col) = w;
                }
        }
    }
};

__device__ __forceinline__ void transpose_tile(const float* colp, int srcN, int k0, bf16* WT, int Kd, int n0, LAS float* scr, int lane) {
    float tv[32];
#pragma unroll
    for (int i = 0; i < 32; ++i) { const int kk = 2 * i + (lane >> 5); tv[i] = colp ? colp[(size_t)(k0 + kk) * srcN] : 0.f; }
#pragma unroll
    for (int i = 0; i < 32; ++i) { const int kk = 2 * i + (lane >> 5); scr[kk * 33 + (lane & 31)] = tv[i]; }
    LDS_WAIT(); asm volatile("" ::: "memory");
    const int c = lane & 7;
#pragma unroll
    for (int j = 0; j < 4; ++j) { const int n = (lane >> 3) + 8 * j; const LAS float* s = scr + (8 * c) * 33 + n;
        v4u o; o.x = pk2(s[0 * 33], s[1 * 33]); o.y = pk2(s[2 * 33], s[3 * 33]); o.z = pk2(s[4 * 33], s[5 * 33]); o.w = pk2(s[6 * 33], s[7 * 33]);
        *(v4u*)(WT + (size_t)(n0 + n) * Kd + k0 + 8 * c) = o; }
    LDS_WAIT(); asm volatile("" ::: "memory");
}
__device__ __forceinline__ void transpose_tile_f8(const float* colp, int srcN, int k0, unsigned char* WT, int Kd, int n0, LAS float* scr, int lane) {
    float tv[32];
#pragma unroll
    for (int i = 0; i < 32; ++i) { const int kk = 2 * i + (lane >> 5); tv[i] = colp ? colp[(size_t)(k0 + kk) * srcN] : 0.f; }
#pragma unroll
    for (int i = 0; i < 32; ++i) { const int kk = 2 * i + (lane >> 5); scr[kk * 33 + (lane & 31)] = tv[i]; }
    LDS_WAIT(); asm volatile("" ::: "memory");
#pragma unroll
    for (int j = 0; j < 2; ++j) { const int p = lane + 64 * j, n = p >> 2, kc = p & 3; const LAS float* sp = scr + (16 * kc) * 33 + n;
        v4u o;
        o.x = pk8(sp[0 * 33] * 32.f, sp[1 * 33] * 32.f, sp[2 * 33] * 32.f, sp[3 * 33] * 32.f); o.y = pk8(sp[4 * 33] * 32.f, sp[5 * 33] * 32.f, sp[6 * 33] * 32.f, sp[7 * 33] * 32.f);
        o.z = pk8(sp[8 * 33] * 32.f, sp[9 * 33] * 32.f, sp[10 * 33] * 32.f, sp[11 * 33] * 32.f); o.w = pk8(sp[12 * 33] * 32.f, sp[13 * 33] * 32.f, sp[14 * 33] * 32.f, sp[15 * 33] * 32.f);
        *(v4u*)(WT + (size_t)(n0 + n) * Kd + k0 + 16 * kc) = o; }
    LDS_WAIT(); asm volatile("" ::: "memory");
}
constexpr int IT_W13 = 16 * 176, IT_W2 = 44 * 32, IT_WIN = 16 * 48, IT_WOUT = 16 * 32, IT_GLU = 8 * 16;
constexpr int IT_LAYER = 2 * IT_W13 + 2 * IT_W2 + IT_WIN + IT_WOUT + IT_GLU, IT_ALL = DEPTH * IT_LAYER;
__device__ __forceinline__ void wt_item(const CArgs* ap, unsigned char* ws, int item, LAS float* scr, int lane) {
    const int l = item / IT_LAYER; int r = item % IT_LAYER; const int nl = lane & 31;
    if (r < 2 * IT_W13) { const int f = r / IT_W13; r -= f * IT_W13; const int kb = r / 176, nb = r % 176, np = 32 * nb + nl;
        const float* w = (const float*)ap->in[((np >> 7) & 1) ? (f ? 10 : 7) : (f ? 9 : 6)] + (size_t)l * DM * DFF + 128 * (np >> 8) + (np & 127);
        transpose_tile_f8(w, DFF, 64 * kb, ws + WS_W13 + (size_t)(l * 2 + f) * NFF1 * DM, DM, 32 * nb, scr, lane); return; }
    r -= 2 * IT_W13;
    if (r < 2 * IT_W2) { const int f = r / IT_W2; r -= f * IT_W2; const int kb = r / 32, nb = r % 32;
        const float* w = (const float*)ap->in[f ? 11 : 8] + (size_t)l * DFF * DM + 32 * nb + nl;
        transpose_tile_f8(w, DM, 64 * kb, ws + WS_W2 + (size_t)(l * 2 + f) * DM * DFF, DFF, 32 * nb, scr, lane); return; }
    r -= 2 * IT_W2;
    if (r < IT_WIN) { const int kb = r / 48, nb = r % 48, np = 32 * nb + nl;
        const int col = (np < 964) ? np : (np < 1024 ? -1 : np - 60);
        const float* w = (col >= 0) ? (const float*)ap->in[12] + (size_t)l * DM * INC + col : nullptr;
        transpose_tile(w, INC, 64 * kb, (bf16*)(ws + WS_WIN) + (size_t)l * NWIN * DM, DM, 32 * nb, scr, lane); return; }
    r -= IT_WIN;
    if (r < IT_WOUT) { const int kb = r / 32, nb = r % 32;
        const float* w = (const float*)ap->in[13] + (size_t)l * DM * DM + 32 * nb + nl;
        transpose_tile(w, DM, 64 * kb, (bf16*)(ws + WS_WOUT) + (size_t)l * DM * DM, DM, 32 * nb, scr, lane); return; }
    r -= IT_WOUT;
    { const int kb = r / 16, nb = r % 16;
        const float* w = (const float*)ap->in[24] + (size_t)l * SSM_W * SSM_W + 32 * nb + nl;
        transpose_tile(w, SSM_W, 64 * kb, (bf16*)(ws + WS_GLU) + (size_t)l * SSM_W * SSM_W, SSM_W, 32 * nb, scr, lane); }
}
__device__ __forceinline__ void mod_item(const CArgs* ap, Frame& F, int item, const LAS float* sc  , LAS float* red  ) {
    const int l = item / 144, n0 = (item % 144) * 64;
    const float* W = (const float*)ap->in[3] + ((size_t)l * DM + F.wave * 128) * (NMOD * DM) + n0 + F.lane;
    asm volatile("" : "+v"(W));
    float acc0 = 0.f, acc1 = 0.f, acc2 = 0.f, acc3 = 0.f;
#pragma unroll 1
    for (int k = 0; k < 128; k += 32) {
        float w[32];
#pragma unroll
        for (int j = 0; j < 32; ++j) { w[j] = *(const GAS float*)W; W += NMOD * DM; }
#pragma unroll
        for (int j = 0; j < 32; ++j) { const int kk = (F.tid >> 6) * 128 + k + j; acc0 += sc[kk] * w[j]; acc1 += sc[1024 + kk] * w[j]; acc2 += sc[2048 + kk] * w[j]; acc3 += sc[3072 + kk] * w[j]; }
    }
    red[(F.wave * 4 + 0) * 64 + F.lane] = acc0; red[(F.wave * 4 + 1) * 64 + F.lane] = acc1; red[(F.wave * 4 + 2) * 64 + F.lane] = acc2; red[(F.wave * 4 + 3) * 64 + F.lane] = acc3;
    __syncthreads();
    if (F.tid < 256) { const int b = F.tid >> 6, ln = F.tid & 63; float s = ((const float*)ap->in[4])[(size_t)l * NMOD * DM + n0 + ln];
#pragma unroll
        for (int w = 0; w < 8; ++w) s += red[(w * 4 + b) * 64 + ln];
        ((float*)(F.ws + WS_MOD))[((size_t)l * NB + b) * (NMOD * DM) + n0 + ln] = s; }
    __syncthreads();
}
__device__ __forceinline__ void ssm_pre_item(const CArgs* ap, Frame& F, int item) {
    const int l = item >> 5, g = item & 31; int tid = F.tid; asm volatile("" : "+v"(tid)); __builtin_assume(tid >= 0 && tid < 512);
    LAS float* Ere = (LAS float*)F.lds;
    LAS float* Eim = Ere + 33 * 64;
    LAS float* Bre = Eim + 33 * 64;
    LAS float* Bim = Bre + 1024;
    LAS float* Cre = Bim + 1024;
    LAS float* Cim = Cre + 1024;
    LAS float* Kk = Cim + 1024;
    LAS float* Dd = Kk + 8192;
    asm volatile("" : "+s"(ap));
    const float* a_re = (const float*)ap->in[16] + (size_t)(l * SG + g) * SP; const float* a_im = (const float*)ap->in[17] + (size_t)(l * SG + g) * SP;
    asm volatile("" : "+v"(a_re), "+v"(a_im));
    const float dt = __expf(((const float*)ap->in[18])[l * SG + g]);
    const double INV2PI = 0.15915494309189533576888;
    for (int idx = tid; idx < 33 * 64; idx += 512) { const int k = idx >> 6, p = idx & 63;
        const float mag = __expf(a_re[p] * dt * (float)k);
        const double rev = (double)a_im[p] * (double)dt * (double)k * INV2PI; const float fr = (float)(rev - __builtin_rint(rev));
        Ere[idx] = mag * __builtin_amdgcn_cosf(fr); Eim[idx] = mag * __builtin_amdgcn_sinf(fr); }
    asm volatile("" : "+s"(ap));
    for (int idx = tid; idx < 1024; idx += 512) { Cre[idx] = ((const float*)ap->in[21])[(size_t)(l * SG + g) * 1024 + idx]; Cim[idx] = ((const float*)ap->in[22])[(size_t)(l * SG + g) * 1024 + idx]; }
    if (tid < 16) Dd[tid] = ((const float*)ap->in[23])[(l * SG + g) * GC + tid];
    __syncthreads();
    asm volatile("" : "+s"(ap));
    for (int idx = tid; idx < 1024; idx += 512) { const int p = idx >> 4;
        const double ar = a_re[p], ai = a_im[p], zr = ar * dt, zi = ai * dt; double qr, qi;
        if (zr * zr + zi * zi < 0.25) {
            double tr = 1.0, ti = 0.0, sr = 1.0, si = 0.0;
#pragma unroll 1
            for (int n = 2; n <= 14; ++n) { const double nr = (tr * zr - ti * zi) / n, ni = (tr * zi + ti * zr) / n; tr = nr; ti = ni; sr += tr; si += ti; }
            qr = sr * dt; qi = si * dt;
        } else { const double nr = (double)Ere[64 + p] - 1.0, ni = (double)Eim[64 + p], den = ar * ar + ai * ai; qr = (nr * ar + ni * ai) / den; qi = (ni * ar - nr * ai) / den; }
        const double br = ((const float*)ap->in[19])[(size_t)(l * SG + g) * 1024 + idx], bi = ((const float*)ap->in[20])[(size_t)(l * SG + g) * 1024 + idx];
        Bre[idx] = (float)(qr * br - qi * bi); Bim[idx] = (float)(qr * bi + qi * br); }
    __syncthreads();
    for (int idx = tid; idx < 8192; idx += 512) { const int cp = idx & 15, c = (idx >> 4) & 15, tau = idx >> 8; float s = 0.f;
        for (int p = 0; p < 64; ++p) { const float cr = Cre[c * 64 + p], ci = Cim[c * 64 + p], er = Ere[tau * 64 + p], ei = Eim[tau * 64 + p];
            const float xr = cr * er - ci * ei, xi = cr * ei + ci * er; s += xr * Bre[p * 16 + cp] - xi * Bim[p * 16 + cp]; }
        Kk[idx] = s; }
    __syncthreads();
    bf16* TV = (bf16*)(F.ws + WS_BTV) + ((size_t)(l * SG + g) * KT) * KSS;
    for (int idx = tid; idx < 512 * 80; idx += 512) { const int n = idx / 80, k8 = idx % 80, i = n >> 4, c = n & 15; float v[8];
        if (k8 < 64) { const int ip = k8 >> 1, c0 = (k8 & 1) * 8;
#pragma unroll
            for (int e = 0; e < 8; ++e) { float x = 0.f; if (ip <= i) { x = Kk[((i - ip) * 16 + c) * 16 + c0 + e]; if (ip == i && c == c0 + e) x += Dd[c]; } v[e] = x; }
        } else { const int p0 = (k8 - 64) * 8;
#pragma unroll
            for (int e = 0; e < 8; ++e) { const int pp = p0 + e, p = pp & 63; const float cr = Cre[c * 64 + p], ci = Cim[c * 64 + p], er = Ere[(i + 1) * 64 + p], ei = Eim[(i + 1) * 64 + p];
                v[e] = (pp < 64) ? (cr * er - ci * ei) : -(cr * ei + ci * er); } }
        v4u o; o.x = pk2(v[0], v[1]); o.y = pk2(v[2], v[3]); o.z = pk2(v[4], v[5]); o.w = pk2(v[6], v[7]);
        *(v4u*)(TV + (size_t)n * KSS + k8 * 8) = o; }
    bf16* WW = (bf16*)(F.ws + WS_BW) + ((size_t)(l * SG + g) * 128) * KT;
    for (int idx = tid; idx < 128 * 64; idx += 512) { const int n = idx >> 6, k8 = idx & 63, p = n & 63, ip = k8 >> 1, c0 = (k8 & 1) * 8; float v[8];
        const float er = Ere[(31 - ip) * 64 + p], ei = Eim[(31 - ip) * 64 + p];
#pragma unroll
        for (int e = 0; e < 8; ++e) { const float br = Bre[p * 16 + c0 + e], bi = Bim[p * 16 + c0 + e]; v[e] = (n < 64) ? (er * br - ei * bi) : (er * bi + ei * br); }
        v4u o; o.x = pk2(v[0], v[1]); o.y = pk2(v[2], v[3]); o.z = pk2(v[4], v[5]); o.w = pk2(v[6], v[7]);
        *(v4u*)(WW + (size_t)n * KT + k8 * 8) = o; }
    if (tid < 64) { float* al = (float*)(F.ws + WS_AL) + ((size_t)(l * SG + g) * SP + tid) * 2; al[0] = Ere[32 * 64 + tid]; al[1] = Eim[32 * 64 + tid]; }
    __syncthreads();
}
__device__ __forceinline__ void pro_ssm(const CArgs* ap, Frame& F) {
    for (int it = F.vcu; it < DEPTH * SG; it += F.G) ssm_pre_item(ap, F, it);
    if (F.vcu == F.G - 1) { bf16* pad = (bf16*)(F.ws + WS_BW) + (size_t)DEPTH * SG * 128 * KT; for (int i = F.tid; i < 128 * KT / 8; i += 512) ((v4u*)pad)[i] = (v4u){0u, 0u, 0u, 0u}; }
}
__device__ __forceinline__ void pro_mod(const CArgs* ap, Frame& F) {
    LAS float* sc = (LAS float*)F.lds; LAS float* red = sc + 4096;
    for (int i = F.tid; i < NB * DM; i += 512) { const float x = ((const float*)ap->in[1])[i]; sc[i] = x * sigmoidf_(x); }
    __syncthreads();
    if (F.G == 256) { for (int it = F.vcu; it < 512; it += 256) mod_item(ap, F, it, sc, red); if (F.vcu >= 192) mod_item(ap, F, 512 + F.vcu - 192, sc, red); }
    else
    for (int it = F.vcu; it < DEPTH * 144; it += F.G) mod_item(ap, F, it, sc, red);
    __syncthreads();
}
__device__ __forceinline__ void pro_wt(const CArgs* ap, Frame& F) {
    LAS float* scr = (LAS float*)(F.lds + F.wave * 16384); const int gw = F.vcu * 8 + F.wave, NGW = F.G * 8;
    if (F.G == 256) {
        for (int i = 0; i < 16; ++i) wt_item(ap, F.ws, gw + 2048 * i, scr, F.lane);
        if (F.vcu >= 128) for (int it = 32768 + (F.vcu - 128) * 8 + F.wave; it < IT_ALL; it += 1024) wt_item(ap, F.ws, it, scr, F.lane);
    } else
    for (int it = gw; it < IT_ALL; it += NGW) wt_item(ap, F.ws, it, scr, F.lane);
}
__device__ __forceinline__ void pro_rope(const CArgs* ap, Frame& F) {
    const float invf[8] = {1.0f, 0.193922758102417f, 0.03760603070259094f, 0.00729266507551074f, 0.001414213445968926f, 0.00027424818836152554f, 5.318296462064609e-05f, 1.0313385246263351e-05f};
    const double INV2PI = 0.15915494309189533576888;
    float* rp = (float*)(F.ws + WS_ROPE); const int* pos = (const int*)ap->in[2];
    for (int idx = F.vcu * 512 + F.tid; idx < MTOK * 8; idx += F.G * 512) { const int r = idx >> 3, i = idx & 7; float f = invf[0];
#pragma unroll
        for (int j = 1; j < 8; ++j) f = (i == j) ? invf[j] : f;
        const float ang = (float)pos[r] * f; const double rev = (double)ang * INV2PI; const float fr = (float)(rev - __builtin_rint(rev));
        rp[(size_t)r * 16 + i] = __builtin_amdgcn_cosf(fr); rp[(size_t)r * 16 + 8 + i] = __builtin_amdgcn_sinf(fr); }
}

template <bool XBF> __device__ __forceinline__ int norm_col(int lane, int q) { return XBF ? 8 * lane + 512 * (q >> 1) + 4 * (q & 1) : 4 * lane + 256 * q; }
template <bool XBF> __device__ __forceinline__ void norm_load(const void* x, int r, int lane, f32x4 (&v)[4]) {
    if constexpr (XBF) { const v4u* xr = (const v4u*)((const bf16*)x + (size_t)r * DM) + lane;
#pragma unroll
        for (int j = 0; j < 2; ++j) { const v4u q = xr[64 * j]; v[2 * j] = (f32x4){bflo(q.x), bfhi(q.x), bflo(q.y), bfhi(q.y)}; v[2 * j + 1] = (f32x4){bflo(q.z), bfhi(q.z), bflo(q.w), bfhi(q.w)}; }
    } else { const f32x4* xr = (const f32x4*)((const float*)x + (size_t)r * DM) + lane;
#pragma unroll
        for (int j = 0; j < 4; ++j) v[j] = xr[64 * j]; }
}
template <bool F8OUT, bool XBF> __device__ __forceinline__ void norm_mod_phase(Frame& F, const void* x, const float* g, const float* modl  , int ksh, bf16* H, bf16* XB) {
    const int gw = F.vcu * 8 + F.wave, NGW = F.G * 8, rpw = (MTOK + NGW - 1) / NGW;
    int r0 = gw * rpw, r1 = r0 + rpw; if (r1 > MTOK) r1 = MTOK;
    f32x4 gs[4], sh[4]; int curb = -1;
    for (int r = r0; r < r1; ++r) {
        const int b = r >> 13;
        if (b != curb) { curb = b; const float* sp = modl + (size_t)b * (NMOD * DM) + (size_t)ksh * DM;
#pragma unroll
            for (int j = 0; j < 4; ++j) { const int c = norm_col<XBF>(F.lane, j); const f32x4 gg = *(const f32x4*)(g + c), sc = *(const f32x4*)(sp + DM + c); gs[j] = gg * (sc + 1.0f); sh[j] = *(const f32x4*)(sp + c); } }
        f32x4 v[4]; float s = 0.f;
        norm_load<XBF>(x, r, F.lane, v);
#pragma unroll
        for (int j = 0; j < 4; ++j) s += (v[j].x * v[j].x + v[j].y * v[j].y) + (v[j].z * v[j].z + v[j].w * v[j].w);
        const float rs = __builtin_amdgcn_rsqf(wave_sum(s) * (1.f / DM) + EPS);
        if constexpr (!XBF) { unsigned long long* o8 = (unsigned long long*)(XB + (size_t)r * DM) + F.lane;
#pragma unroll
            for (int j = 0; j < 4; ++j) o8[64 * j] = (unsigned long long)pk2(v[j].x, v[j].y) | ((unsigned long long)pk2(v[j].z, v[j].w) << 32); }
        f32x4 y[4];
#pragma unroll
        for (int j = 0; j < 4; ++j) y[j] = v[j] * rs * gs[j] + sh[j];
        if constexpr (F8OUT) {
            if constexpr (XBF) { unsigned long long* o8 = (unsigned long long*)((unsigned char*)H + (size_t)r * DM) + F.lane;
#pragma unroll
                for (int j = 0; j < 2; ++j) { const f32x4 a = y[2 * j] * 2.0f, c = y[2 * j + 1] * 2.0f; o8[64 * j] = (unsigned long long)pk8(a.x, a.y, a.z, a.w) | ((unsigned long long)pk8(c.x, c.y, c.z, c.w) << 32); }
            } else { unsigned* o4 = (unsigned*)((unsigned char*)H + (size_t)r * DM) + F.lane;
#pragma unroll
                for (int j = 0; j < 4; ++j) { const f32x4 a = y[j] * 2.0f; o4[64 * j] = pk8(a.x, a.y, a.z, a.w); } }
        } else {
            static_assert(XBF || F8OUT, "the f32 input only feeds the first FFN norm");
            v4u* o16 = (v4u*)(H + (size_t)r * DM) + F.lane;
#pragma unroll
            for (int j = 0; j < 2; ++j) { v4u o; o.x = pk2(y[2 * j].x, y[2 * j].y); o.y = pk2(y[2 * j].z, y[2 * j].w); o.z = pk2(y[2 * j + 1].x, y[2 * j + 1].y); o.w = pk2(y[2 * j + 1].z, y[2 * j + 1].w); o16[64 * j] = o; }
        }
    }
}
__device__ __forceinline__ void final_norm_phase(Frame& F, const bf16* x, const float* g, float* out) {
    const int gw = F.vcu * 8 + F.wave, NGW = F.G * 8;
    f32x4 gs[4];
#pragma unroll
    for (int j = 0; j < 4; ++j) gs[j] = *(const f32x4*)(g + norm_col<true>(F.lane, j));
    for (int r = gw; r < MTOK; r += NGW) {
        f32x4 v[4]; float s = 0.f;
        norm_load<true>(x, r, F.lane, v);
#pragma unroll
        for (int j = 0; j < 4; ++j) s += (v[j].x * v[j].x + v[j].y * v[j].y) + (v[j].z * v[j].z + v[j].w * v[j].w);
        const float rs = __builtin_amdgcn_rsqf(wave_sum(s) * (1.f / DM) + EPS);
#pragma unroll
        for (int j = 0; j < 4; ++j) *(f32x4*)(out + (size_t)r * DM + norm_col<true>(F.lane, j)) = v[j] * rs * gs[j];
    }
}
__device__ __forceinline__ void ssm_norm_phase(Frame& F, const bf16* Y2, const float* gain, bf16* MIX) {
    const int gw = F.vcu * 8 + F.wave, NGW = F.G * 8;
    const f32x4 g0 = *(const f32x4*)(gain + 8 * F.lane), g1 = *(const f32x4*)(gain + 8 * F.lane + 4);
    for (int r = gw; r < MTOK; r += NGW) {
        const v4u yv = *((const v4u*)(Y2 + (size_t)r * SSM_W) + F.lane);
        float y[8] = {bflo(yv.x), bfhi(yv.x), bflo(yv.y), bfhi(yv.y), bflo(yv.z), bfhi(yv.z), bflo(yv.w), bfhi(yv.w)};
        float s = 0.f;
#pragma unroll
        for (int e = 0; e < 8; ++e) s += y[e] * y[e];
        const float rs = __builtin_amdgcn_rsqf(wave_sum(s) * (1.f / SSM_W) + EPS);
        v4u w; w.x = pk2(y[0] * rs * g0[0], y[1] * rs * g0[1]); w.y = pk2(y[2] * rs * g0[2], y[3] * rs * g0[3]); w.z = pk2(y[4] * rs * g1[0], y[5] * rs * g1[1]); w.w = pk2(y[6] * rs * g1[2], y[7] * rs * g1[3]);
        *((v4u*)(MIX + (size_t)r * DM + ATTN_W) + F.lane) = w;
    }
}
__device__ __forceinline__ void ssm_scan_phase(Frame& F, const float* AL  , const float* SINC, bf16* UG) {
    if (F.wave != 0) return;
    for (int it = F.vcu; it < NB * SG; it += F.G) {
        const int b = it >> 5, g = it & 31, p = F.lane;
        const float ar = AL[(g * SP + p) * 2], ai = AL[(g * SP + p) * 2 + 1];
        const size_t row0 = (size_t)g * NCHK + (size_t)b * CHB;
        const float* sp = SINC + row0 * 128 + p; bf16* hp = UG + row0 * KSS + KT + p;
        float hr = 0.f, hi = 0.f;
        float sr[16], si[16];
#pragma unroll
        for (int j = 0; j < 16; ++j) { sr[j] = sp[(size_t)j * 128]; si[j] = sp[(size_t)j * 128 + 64]; }
#pragma unroll 1
        for (int j0 = 0; j0 < CHB; j0 += 16) {
            float nr_[16], ni_[16];
            if (j0 + 16 < CHB) {
#pragma unroll
                for (int j = 0; j < 16; ++j) { nr_[j] = sp[(size_t)(j0 + 16 + j) * 128]; ni_[j] = sp[(size_t)(j0 + 16 + j) * 128 + 64]; } }
#pragma unroll
            for (int j = 0; j < 16; ++j) {
                hp[(size_t)(j0 + j) * KSS] = (bf16)f2bf(hr); hp[(size_t)(j0 + j) * KSS + 64] = (bf16)f2bf(hi);
                const float nr = ar * hr - ai * hi + sr[j], ni = ar * hi + ai * hr + si[j]; hr = nr; hi = ni;
            }
            if (j0 + 16 < CHB) {
#pragma unroll
                for (int j = 0; j < 16; ++j) { sr[j] = nr_[j]; si[j] = ni_[j]; } }
        }
    }
}

__device__ __forceinline__ unsigned comp_key(float sc, int s) {
    sc = sc + 0.0f; unsigned u = __builtin_bit_cast(unsigned, sc); u = (u & 0x80000000u) ? ~u : (u | 0x80000000u);
    return (u & 0xFFFFE000u) | (unsigned)(8191 - s);
}
#if !ATTN_FAST
__device__ __forceinline__ void attn_simple_phase(Frame& F, const bf16* Q, const bf16* KB, const bf16* VB, const bf16* QI, const bf16* KI, const float* WI, const float* again, bf16* MIX) {
    LAS unsigned* comp = (LAS unsigned*)F.lds;
    LAS float* lg = (LAS float*)(F.lds + 32768);
    LAS float* qs = lg + 2048;
    LAS float* qis = qs + 512;
    LAS float* wis = qis + 256;
    LAS unsigned* hist = (LAS unsigned*)(wis + 8);
    LAS unsigned* sel = hist + 256;
    LAS unsigned* misc = sel + 256;
    LAS float* red = (LAS float*)(misc + 16);
    const int tid = F.tid;
    asm volatile("" : "+v"(Q), "+v"(KB), "+v"(VB), "+v"(QI), "+v"(KI), "+v"(WI), "+v"(again), "+v"(MIX));
#pragma unroll 1
    for (int r = F.vcu; r < MTOK; r += F.G) {
        const int b = r >> 13, t = r & 8191, n = ((t >> 6) + 1) << 6;
        qs[tid] = bf2f(Q[(size_t)r * ATTN_W + tid]);
        if (tid < 256) qis[tid] = bf2f(QI[(size_t)r * 256 + tid]);
        if (tid < 4) wis[tid] = WI[(size_t)r * 4 + tid];
        __syncthreads();
#pragma unroll 1
        for (int s0 = 0; s0 < n; s0 += 512) {
            const int s = s0 + tid; if (s >= n) continue;
            const v4u* kp = (const v4u*)(KI + (size_t)(b * SEQ + s) * 64);
            float a0 = 0.f, a1 = 0.f, a2 = 0.f, a3 = 0.f;
#pragma unroll 1
            for (int j = 0; j < 8; ++j) { const v4u kv = kp[j]; const float kf[8] = {bflo(kv.x), bfhi(kv.x), bflo(kv.y), bfhi(kv.y), bflo(kv.z), bfhi(kv.z), bflo(kv.w), bfhi(kv.w)};
#pragma unroll
                for (int e = 0; e < 8; ++e) { const int d = 8 * j + e; a0 += qis[d] * kf[e]; a1 += qis[64 + d] * kf[e]; a2 += qis[128 + d] * kf[e]; a3 += qis[192 + d] * kf[e]; } }
            const float sc = wis[0] * fmaxf(a0, 0.f) + wis[1] * fmaxf(a1, 0.f) + wis[2] * fmaxf(a2, 0.f) + wis[3] * fmaxf(a3, 0.f);
            comp[s] = comp_key(sc, s);
        }
        __syncthreads();
        int nsel;
        if (n > TOPK) {
            unsigned prefix = 0u, kneed = TOPK;
#pragma unroll 1
            for (int round = 0; round < 4; ++round) {
                const int shift = 24 - 8 * round;
                if (tid < 256) hist[tid] = 0u;
                __syncthreads();
#pragma unroll 1
                for (int s0 = 0; s0 < n; s0 += 512) { const int s = s0 + tid; const unsigned c = (s < n) ? comp[s] : 0u; const bool match = (s < n) && ((round == 0) || ((c >> (shift + 8)) == prefix));
                    if (match) __hip_atomic_fetch_add(&hist[(c >> shift) & 255u], 1u, __ATOMIC_RELAXED, __HIP_MEMORY_SCOPE_WORKGROUP); }
                __syncthreads();
                if (tid < 64) {
                    const unsigned h0 = hist[4 * tid], h1 = hist[4 * tid + 1], h2 = hist[4 * tid + 2], h3 = hist[4 * tid + 3], tot = h0 + h1 + h2 + h3;
                    unsigned v = tot;
#pragma unroll
                    for (int o = 1; o < 64; o <<= 1) { const unsigned up = __shfl_down(v, o); if (tid + o < 64) v += up; }
                    const unsigned above = v - tot, c3 = above + h3, c2 = c3 + h2, c1 = c2 + h1, c0 = c1 + h0;
                    const bool f3 = (c3 >= kneed) & (above < kneed), f2 = (c2 >= kneed) & (c3 < kneed), f1 = (c1 >= kneed) & (c2 < kneed), f0 = (c0 >= kneed) & (c1 < kneed);
                    const unsigned dsel = 4u * tid + (f3 ? 3u : f2 ? 2u : f1 ? 1u : 0u), below = f3 ? above : f2 ? c3 : f1 ? c2 : c1;
                    if (f3 | f2 | f1 | f0) { misc[0] = dsel; misc[1] = kneed - below; }
                }
                __syncthreads();
                prefix = (prefix << 8) | misc[0]; kneed = misc[1];
            }
            unsigned base = 0u;
#pragma unroll 1
            for (int s0 = 0; s0 < n; s0 += 512) {
                const int s = s0 + tid; const bool f = (s < n) && (comp[s] >= prefix);
                const unsigned long long bal = __ballot(f);
                if (F.lane == 0) misc[8 + F.wave] = (unsigned)__popcll(bal);
                __syncthreads();
                unsigned off = base, tot = 0u;
#pragma unroll
                for (int w = 0; w < 8; ++w) { const unsigned c = misc[8 + w]; if (w < F.wave) off += c; tot += c; }
                if (f) { const unsigned pos = off + (unsigned)__popcll(bal & ((1ull << F.lane) - 1ull)); if (pos < TOPK) sel[pos] = (unsigned)s; }
                base += tot;
                __syncthreads();
            }
            nsel = TOPK;
        } else { if (tid < n) sel[tid] = (unsigned)tid; nsel = n; }
        __syncthreads();
        {
            const int k = tid & 255, hh = tid >> 8; float a0 = 0.f, a1 = 0.f, a2 = 0.f, a3 = 0.f;
            if (k < nsel) { const v4u* kp = (const v4u*)(KB + (size_t)(b * SEQ + (int)sel[k]) * 64); const LAS float* qh = qs + hh * 256;
#pragma unroll 1
                for (int j = 0; j < 8; ++j) { const v4u kv = kp[j]; const float kf[8] = {bflo(kv.x), bfhi(kv.x), bflo(kv.y), bfhi(kv.y), bflo(kv.z), bfhi(kv.z), bflo(kv.w), bfhi(kv.w)};
#pragma unroll
                    for (int e = 0; e < 8; ++e) { const int d = 8 * j + e; a0 += qh[d] * kf[e]; a1 += qh[64 + d] * kf[e]; a2 += qh[128 + d] * kf[e]; a3 += qh[192 + d] * kf[e]; } } }
            const float ninf = -__builtin_inff(); const bool ok = k < nsel;
            lg[(4 * hh + 0) * 256 + k] = ok ? a0 : ninf; lg[(4 * hh + 1) * 256 + k] = ok ? a1 : ninf; lg[(4 * hh + 2) * 256 + k] = ok ? a2 : ninf; lg[(4 * hh + 3) * 256 + k] = ok ? a3 : ninf;
        }
        __syncthreads();
        {
            LAS float* lh = lg + F.wave * 256; float v0 = lh[F.lane], v1 = lh[F.lane + 64], v2 = lh[F.lane + 128], v3 = lh[F.lane + 192];
            const float mx = wave_max(fmaxf(fmaxf(v0, v1), fmaxf(v2, v3)));
            v0 = __builtin_amdgcn_exp2f(v0 - mx); v1 = __builtin_amdgcn_exp2f(v1 - mx); v2 = __builtin_amdgcn_exp2f(v2 - mx); v3 = __builtin_amdgcn_exp2f(v3 - mx);
            const float inv = 1.0f / wave_sum((v0 + v1) + (v2 + v3));
            lh[F.lane] = v0 * inv; lh[F.lane + 64] = v1 * inv; lh[F.lane + 128] = v2 * inv; lh[F.lane + 192] = v3 * inv;
        }
        __syncthreads();
        {
            const LAS float* ph = lg + F.wave * 256; const bf16* vb = VB + (size_t)b * SEQ * 64 + F.lane; float o = 0.f;
#pragma unroll 2
            for (int k = 0; k < nsel; k += 4) { const float x0 = bf2f(vb[(size_t)sel[k] * 64]), x1 = bf2f(vb[(size_t)sel[k + 1] * 64]), x2 = bf2f(vb[(size_t)sel[k + 2] * 64]), x3 = bf2f(vb[(size_t)sel[k + 3] * 64]);
                o += ph[k] * x0 + ph[k + 1] * x1 + ph[k + 2] * x2 + ph[k + 3] * x3; }
            const float ss = wave_sum(o * o);
            if (F.lane == 0) red[F.wave] = ss;
            __syncthreads();
            float tot = 0.f;
#pragma unroll
            for (int w = 0; w < 8; ++w) tot += red[w];
            const float rs = __builtin_amdgcn_rsqf(tot * (1.f / ATTN_W) + EPS);
            MIX[(size_t)r * DM + tid] = (bf16)f2bf(o * rs * again[tid]);
        }
        __syncthreads();
    }
}
#endif

typedef short bf16x8v __attribute__((ext_vector_type(8)));
typedef short v4i16_t __attribute__((ext_vector_type(4)));
typedef float f32x16 __attribute__((ext_vector_type(16)));
constexpr int AQ = 32, ACAP = 1024, ATRIG = 768;
constexpr int A_CNT = LDSCTL_OFF + 1024, A_THR = A_CNT + 128, A_HIST = LDSCTL_OFF + 2048, A_SEL = LDSCTL_OFF + 10240;
constexpr int A_OK = A_THR + 128;
constexpr int A_DUMP = A_SEL;
constexpr int V_RS = 144;
static_assert(A_SEL + AQ * 256 * 2 <= LDS_BYTES, "attention LDS map");
constexpr float QK_SCALE = 0.125f * 1.4426950408889634f;

__device__ __forceinline__ unsigned ord_of(unsigned c) { const unsigned m = (unsigned)((int)c >> 31); return c ^ ((m & 0x7FFFE000u) | 0x80000000u); }
#define DPPU(old, x, ctrl, rm) ((unsigned)__builtin_amdgcn_update_dpp((int)(old), (int)(x), ctrl, rm, 0xF, false))
__device__ __forceinline__ unsigned wave_scan_add(unsigned x) {
    x += DPPU(0u, x, 0x111, 0xF); x += DPPU(0u, x, 0x112, 0xF); x += DPPU(0u, x, 0x114, 0xF); x += DPPU(0u, x, 0x118, 0xF);
    x += DPPU(0u, x, 0x142, 0xA); x += DPPU(0u, x, 0x143, 0xC); return x; }
__device__ __forceinline__ unsigned wave_red_max(unsigned x) {
    x = max(x, DPPU(0u, x, 0x111, 0xF)); x = max(x, DPPU(0u, x, 0x112, 0xF)); x = max(x, DPPU(0u, x, 0x114, 0xF)); x = max(x, DPPU(0u, x, 0x118, 0xF));
    x = max(x, DPPU(0u, x, 0x142, 0xA)); x = max(x, DPPU(0u, x, 0x143, 0xC)); return (unsigned)__builtin_amdgcn_readlane((int)x, 63); }
__device__ __forceinline__ unsigned wave_red_min(unsigned x) {
    x = min(x, DPPU(~0u, x, 0x111, 0xF)); x = min(x, DPPU(~0u, x, 0x112, 0xF)); x = min(x, DPPU(~0u, x, 0x114, 0xF)); x = min(x, DPPU(~0u, x, 0x118, 0xF));
    x = min(x, DPPU(~0u, x, 0x142, 0xA)); x = min(x, DPPU(~0u, x, 0x143, 0xC)); return (unsigned)__builtin_amdgcn_readlane((int)x, 63); }
__device__ __forceinline__ unsigned lane_count_ge(const unsigned (&o)[16], const unsigned mid) {
    unsigned c0 = 0u, c1 = 0u, c2 = 0u, c3 = 0u;
#pragma unroll
    for (int j = 0; j < 16; j += 4) { unsigned long long m0, m1, m2, m3, d0, d1, d2, d3;
        asm volatile("v_cmp_le_u32 %4, %12, %13\n\tv_cmp_le_u32 %5, %12, %14\n\tv_cmp_le_u32 %6, %12, %15\n\tv_cmp_le_u32 %7, %12, %16\n\t"
                     "v_addc_co_u32 %0, %8, 0, %0, %4\n\tv_addc_co_u32 %1, %9, 0, %1, %5\n\tv_addc_co_u32 %2, %10, 0, %2, %6\n\tv_addc_co_u32 %3, %11, 0, %3, %7"
                     : "+v"(c0), "+v"(c1), "+v"(c2), "+v"(c3), "=&s"(m0), "=&s"(m1), "=&s"(m2), "=&s"(m3), "=&s"(d0), "=&s"(d1), "=&s"(d2), "=&s"(d3)
                     : "s"(mid), "v"(o[j]), "v"(o[j + 1]), "v"(o[j + 2]), "v"(o[j + 3])); }
    return (c0 + c1) + (c2 + c3);
}
template <int MODE, unsigned KTH_> __device__ __forceinline__ void wave_select(LAS unsigned* cand, LAS unsigned* cntp, LAS float* thrp, LAS unsigned* H, unsigned short* selq, const int lane, const int qx, const unsigned kth_rt = KTH_, const unsigned kmax_rt = 384u) {
    const unsigned KTH = (MODE == 0) ? kth_rt : KTH_, KMAX = (MODE == 0) ? kmax_rt : (MODE == 1) ? KTH_ : KTH_ + 16u;
    const int m = __builtin_amdgcn_readfirstlane((int)*cntp);
    unsigned e[16], o[16]; unsigned mx = 0u, mn = ~0u;
    const int qlo = qx & 3, qhi = qx & ~3;
#pragma unroll
    for (int j = 0; j < 4; ++j) { const int i0 = 4 * (lane + 64 * j), sb = i0 ^ qhi; v4u q = (v4u){0u, 0u, 0u, 0u}; if (256 * j < m) q = *(LAS v4u*)(cand + i0);
#pragma unroll
        for (int k = 0; k < 4; ++k) { const bool v = sb < m - (k ^ qlo); e[4 * j + k] = q[k]; const unsigned ok = ord_of(q[k]); o[4 * j + k] = v ? ok : 0u; mx = max(mx, v ? ok : 0u); mn = min(mn, v ? ok : ~0u); } }
    mx = wave_red_max(mx); mn = wave_red_min(mn);
    unsigned lo = mn, hi = mx + 1u, T = mn;
    bool done = false;
    if (MODE == 1 && (unsigned)m > KMAX) {
        unsigned slo = mn >> 13, shi = (mx >> 13) + 1u, clo = (unsigned)m, chi = 0u;
#pragma unroll 1
        while (shi - slo > 1u) {
            const unsigned smid = slo + ((shi - slo) >> 1), mid = smid << 13;
            unsigned cl = 0u;
            cl = lane_count_ge(o, mid);
            const unsigned c = (unsigned)__builtin_amdgcn_readlane((int)wave_scan_add(cl), 63);
            if (c >= KTH) { slo = smid; clo = c; } else { shi = smid; chi = c; }
        }
        lo = slo << 13; hi = shi << 13;
        if (clo == KTH) { T = lo; done = true; }
        else if (KTH - chi <= 4u) {
            unsigned Tc = hi;
#pragma unroll 1
            for (unsigned i = chi; i < KTH; ++i) { unsigned bm = 0u;
#pragma unroll
                for (int j = 0; j < 16; ++j) { const unsigned v = (o[j] >= lo && o[j] < Tc) ? o[j] : 0u; bm = max(bm, v); }
                Tc = wave_red_max(bm); }
            T = Tc; done = true;
        }
    }
    if (!done && (unsigned)m > KMAX) {
#pragma unroll 1
        for (int it = 0; it < 40; ++it) {
            const unsigned mid = lo + ((hi - lo) >> 1);
            unsigned cl = 0u;
            cl = lane_count_ge(o, mid);
            const unsigned c = (unsigned)__builtin_amdgcn_readlane((int)wave_scan_add(cl), 63);
            if (c > KMAX) lo = mid; else if (c < KTH) hi = mid; else { T = mid; break; }
            if (hi - lo <= 1u) { T = lo; break; }
        }
    }
    if (MODE == 2) {
        if (lane == 0) { *cntp = 0u; const unsigned cb = (T & 0x80000000u) ? (T & 0x7FFFE000u) : ((T ^ 0xFFFFE000u) | 0x1FFFu); *thrp = __builtin_bit_cast(float, cb); }
    } else if (MODE == 0) {
        unsigned fm = 0u;
#pragma unroll
        for (int j = 0; j < 16; ++j) asm volatile("v_cmp_le_u32 vcc, %1, %2\n\tv_addc_co_u32 %0, vcc, %0, %0, vcc" : "+v"(fm) : "s"(T), "v"(o[j]) : "vcc");
        const unsigned kc = (unsigned)__popc(fm), incl = wave_scan_add(kc), base = (unsigned)__builtin_amdgcn_readlane((int)incl, 63);
        unsigned pos = incl - kc; LAS unsigned* const dumpw = H + lane;
#pragma unroll
        for (int j = 0; j < 16; ++j) { const unsigned pbit = (fm >> (15 - j)) & 1u; LAS unsigned* dstp = pbit ? (cand + (pos ^ (unsigned)qx)) : dumpw; *dstp = e[j]; pos += pbit; }
        if (lane == 0) { *cntp = base; const unsigned cb = (T & 0x80000000u) ? (T & 0x7FFFE000u) : ((T ^ 0xFFFFE000u) | 0x1FFFu); *thrp = __builtin_bit_cast(float, cb); }
    } else {
        LAS unsigned* BM = H;
        *(LAS v4u*)(BM + 4 * lane) = (v4u){0u, 0u, 0u, 0u};
#pragma unroll
        for (int j = 0; j < 16; ++j) { const bool f = o[j] >= T; const unsigned key = 8191u - (e[j] & 0x1FFFu);
            if (f) __hip_atomic_fetch_or(&BM[key >> 5], 1u << (key & 31u), __ATOMIC_RELAXED, __HIP_MEMORY_SCOPE_WAVEFRONT); }
        const v4u w4 = *(LAS v4u*)(BM + 4 * lane);
        const unsigned tot = __popc(w4.x) + __popc(w4.y) + __popc(w4.z) + __popc(w4.w);
        unsigned pos = wave_scan_add(tot) - tot;
        LAS unsigned short* st = (LAS unsigned short*)H;
#pragma unroll 1
        for (int k = 0; k < 4; ++k) { unsigned ww = (k == 0) ? w4.x : (k == 1) ? w4.y : (k == 2) ? w4.z : w4.w;
            while (ww) { const unsigned bit = (unsigned)__builtin_ctz(ww); ww &= ww - 1u; st[pos] = (unsigned short)(128u * lane + 32u * k + bit); ++pos; } }
        *((unsigned long long*)selq + lane) = *((LAS unsigned long long*)st + lane);
    }
}

__device__ __forceinline__ void lds_barrier() { asm volatile("s_waitcnt lgkmcnt(0)\n\ts_barrier" ::: "memory"); }
__device__ __forceinline__ int attn_unit_of(const Frame& F, int ui) {
    if (F.G == 256) { const int b = F.vcu >> 6, j = F.vcu & 63; const int qt = (ui == 0) ? j : (ui == 1) ? 127 - j : (ui == 2) ? 128 + j : 255 - j; return 4 * qt + b; }
    const int u = F.vcu + ui * F.G; return u < 1024 ? u : -1;
}
__device__ __forceinline__ void idx_tile(const bf16x8v (&Ak)[4], const bf16x8v (&Bq)[4][4], const float (&lo)[4], const float (&hi)[4], const int t, const int h2, const float thr_r,
                                         LAS unsigned* cntq, LAS unsigned* myc, LAS unsigned* dump, const unsigned qx) {
    float sc[16];
#pragma unroll
    for (int hd = 0; hd < 4; ++hd) { f32x16 acc;
#pragma unroll
        for (int i = 0; i < 16; ++i) acc[i] = 0.f;
#pragma unroll
        for (int kk = 0; kk < 4; ++kk) acc = __builtin_amdgcn_mfma_f32_32x32x16_bf16(Ak[kk], Bq[hd][kk], acc, 0, 0, 0);
#pragma unroll
        for (int i = 0; i < 16; ++i) { const float mclamp = __builtin_amdgcn_fmed3f(acc[i], lo[hd], hi[hd]); sc[i] = (hd == 0) ? mclamp : sc[i] + mclamp; } }
    const unsigned Bt = (unsigned)(8191 - 32 * t) ^ (unsigned)(4 * h2);
    unsigned c[16]; unsigned pm = 0u;
#pragma unroll
    for (int i = 0; i < 16; ++i) { const unsigned rowc = (unsigned)((i & 3) + 8 * (i >> 2));
        c[i] = (__builtin_bit_cast(unsigned, sc[i]) & 0xFFFFE000u) | (Bt ^ rowc);
        asm volatile("v_cmp_le_f32 vcc, %1, %2\n\tv_addc_co_u32 %0, vcc, %0, %0, vcc" : "+v"(pm) : "v"(thr_r), "v"(c[i]) : "vcc"); }
    if (pm) {
        unsigned slot = __hip_atomic_fetch_add(cntq, (unsigned)__popc(pm), __ATOMIC_RELAXED, __HIP_MEMORY_SCOPE_WORKGROUP);
#pragma unroll
        for (int i = 0; i < 16; ++i) { const unsigned p = (pm >> (15 - i)) & 1u; LAS unsigned* dstp = p ? (myc + (slot ^ qx)) : dump; *dstp = c[i]; slot += p; }
    }
}
template <int MODE> __device__ __forceinline__ void attn_index_phase(Frame& F, const int ui, const bf16* QI, const bf16* KI, const float* WI, unsigned short* SEL, const int safe = 0) {
    const int tid = F.tid, lane = F.lane, wave = F.wave;
    LAS unsigned* const cand = (LAS unsigned*)F.lds;
    LAS unsigned* const cnt = (LAS unsigned*)(F.lds + A_CNT);
    LAS float* const thr = (LAS float*)(F.lds + A_THR);
    LAS unsigned* const H = (LAS unsigned*)(F.lds + A_HIST) + wave * 256;
    const int r32 = lane & 31, h2 = lane >> 5;
    {
        const int u = attn_unit_of(F, ui); if (u < 0) return;
        const int b = u & 3, qt = u >> 2, t0 = qt * AQ, q0 = b * SEQ + t0, n = ((t0 >> 6) + 1) << 6;
        unsigned short* const sel = SEL + (size_t)q0 * 256;
        if (n <= TOPK) { if (MODE == 1 && tid == 0) *(LAS unsigned*)(F.lds + A_OK) = 1u; return; }
        if constexpr (MODE == 0) {
        if (tid < AQ) { cnt[tid] = 0u; thr[tid] = -__builtin_inff(); }
        __syncthreads();
        {
            bf16x8v Bq[4][4]; float lo[4], hi[4];
            { const f32x4 wv = *(const f32x4*)(WI + (size_t)(q0 + r32) * 4);
#pragma unroll
              for (int hd = 0; hd < 4; ++hd) { const float w = wv[hd]; lo[hd] = (w >= 0.f) ? 0.f : -__builtin_inff(); hi[hd] = (w >= 0.f) ? __builtin_inff() : 0.f;
#pragma unroll
                  for (int kk = 0; kk < 4; ++kk) { const v4u qv = *(const v4u*)(QI + (size_t)q0 * 256 + (size_t)(((hd * 8 + 2 * kk + h2) * 32 + r32) * 8));
                      v4u o; o.x = pk2(bflo(qv.x) * w, bfhi(qv.x) * w); o.y = pk2(bflo(qv.y) * w, bfhi(qv.y) * w); o.z = pk2(bflo(qv.z) * w, bfhi(qv.z) * w); o.w = pk2(bflo(qv.w) * w, bfhi(qv.w) * w);
                      Bq[hd][kk] = __builtin_bit_cast(bf16x8v, o); } } }
            const int ntile = n >> 5, nround = (ntile + 7) >> 3;
            const bf16* kib = KI + (size_t)b * SEQ * 64 + (size_t)((h2 * 32 + r32) * 8);
            float thr_r = -__builtin_inff();
            bool first = true; unsigned kspec = (unsigned)(SPEC_NUM * 1024) / (unsigned)n; kspec = (safe || kspec > (unsigned)TOPK) ? (unsigned)TOPK : (kspec < 32u ? 32u : kspec);
            LAS unsigned* const myc = cand + r32 * ACAP;
            LAS unsigned* const dump = (LAS unsigned*)(F.lds + A_DUMP) + tid;
            bf16x8v Ak[4];
            { const int t = wave; if (t < ntile) {
#pragma unroll
                for (int kk = 0; kk < 4; ++kk) Ak[kk] = *(const bf16x8v*)(kib + (size_t)t * 32 * 64 + 512 * kk); } }
            bf16x8v An[4];
#pragma unroll
            for (int kk = 0; kk < 4; ++kk) An[kk] = Ak[kk];
#pragma unroll 1
            for (int rd = 0; rd < nround; ++rd) {
                const int t = 8 * rd + wave;
                if (t < ntile) {
#pragma unroll
                    for (int kk = 0; kk < 4; ++kk) Ak[kk] = An[kk];
                    const int tn = t + 8;
                    if (tn < ntile) {
#pragma unroll
                        for (int kk = 0; kk < 4; ++kk) An[kk] = *(const bf16x8v*)(kib + (size_t)tn * 32 * 64 + 512 * kk); }
                    idx_tile(Ak, Bq, lo, hi, t, h2, thr_r, cnt + r32, myc, dump, (unsigned)r32);
                    if (PROBE_DUP == 11) idx_tile(Ak, Bq, lo, hi, t, h2, __builtin_inff(), cnt + r32, myc, dump, (unsigned)r32);
                }
                lds_barrier();
                if (PROBE_DUP == 10) { lds_barrier(); lds_barrier(); }
                const unsigned cq = (lane < AQ) ? cnt[lane] : 0u;
                const unsigned need = (unsigned)__ballot(cq > (unsigned)ATRIG), comp = (unsigned)__ballot(cq > 448u);
                lds_barrier();
                if (DEBUG_STAT == 9 && need && tid == 0) atomicAdd((unsigned*)(F.ws + WS_CTL) + 32768 + 8, 1u);
                if (need) {
                    const unsigned kth = first ? kspec : (unsigned)TOPK, kmax = kth + (kth >> 1);
#pragma unroll 1
                    for (int q = wave; q < AQ; q += 8) if ((comp >> q) & 1u) { if (DEBUG_STAT == 8 && lane == 0) atomicAdd((unsigned*)(F.ws + WS_CTL) + 32768 + 7, 1u); wave_select<0, TOPK>(cand + q * ACAP, cnt + q, thr + q, H, sel + q * 256, lane, q, kth, kmax); }
                    lds_barrier();
                    first = false;
                }
                thr_r = thr[r32];
            }
        }
        } else {
            { const unsigned cq = (lane < AQ) ? cnt[lane] : (unsigned)TOPK; const bool bad = __ballot(cq < (unsigned)TOPK) != 0ull;
              if (tid == 0) *(LAS unsigned*)(F.lds + A_OK) = bad ? 0u : 1u;
              if (bad) return; }
#pragma unroll 1
            for (int q = wave; q < AQ; q += 8) wave_select<1, TOPK>(cand + q * ACAP, cnt + q, thr + q, H, sel + q * 256, lane, q);
            __syncthreads();
        }
    }
}
__device__ __forceinline__ void attn_gather_phase(Frame& F, const bf16* Q, const bf16* KB, const bf16* VB, const unsigned short* SEL, const float* again, bf16* MIX) {
    const int lane = F.lane, wave = F.wave;
    const int hd = lane & 15, kq = lane >> 4;
    LAS unsigned char* const vb = F.lds + wave * (64 * V_RS);
    LAS unsigned short* const sq = (LAS unsigned short*)(F.lds + 8 * 64 * V_RS) + wave * 256;
    LAS unsigned char* const kb = vb;
#pragma unroll 1
    for (int ui = 0; ui < 4; ++ui) {
        const int u = attn_unit_of(F, ui); if (u < 0) break;
        const int b = u & 3, qt = u >> 2, t0 = qt * AQ, q0 = b * SEQ + t0, n = ((t0 >> 6) + 1) << 6;
        const int nsel = n < TOPK ? n : TOPK, nchunk = nsel >> 6;
        const bf16* const kbat = KB + (size_t)b * SEQ * 64; const bf16* const vbat = VB + (size_t)b * SEQ * 64;
#pragma unroll 1
        for (int qq = wave; qq < AQ; qq += 8) {
            const int r = q0 + qq;
            if (n > TOPK) { const unsigned long long iv = *((const unsigned long long*)(SEL + (size_t)r * 256) + lane); *((LAS unsigned long long*)sq + lane) = iv; }
            else { const unsigned i0 = 4u * lane; *((LAS unsigned long long*)sq + lane) = (unsigned long long)(i0 | ((i0 + 1u) << 16)) | ((unsigned long long)((i0 + 2u) | ((i0 + 3u) << 16)) << 32); }
            asm volatile("s_waitcnt lgkmcnt(0)" ::: "memory");
            bf16x8v bq0, bq1;
            { v4u z = (v4u){0u, 0u, 0u, 0u}; const v4u a0 = (hd < 8) ? *(const v4u*)(Q + (size_t)r * ATTN_W + hd * 64 + 8 * kq) : z, a1 = (hd < 8) ? *(const v4u*)(Q + (size_t)r * ATTN_W + hd * 64 + 32 + 8 * kq) : z;
              bq0 = __builtin_bit_cast(bf16x8v, a0); bq1 = __builtin_bit_cast(bf16x8v, a1); }
            f32x4 lg[16];
#pragma unroll
            for (int hb2 = 0; hb2 < 2; ++hb2) {
                v4u kk[2][8];
#pragma unroll
                for (int c2 = 0; c2 < 2; ++c2) { const int c = 2 * hb2 + c2; if (c < nchunk) {
#pragma unroll
                    for (int jj = 0; jj < 8; ++jj) { const unsigned off = (unsigned)sq[64 * c + (lane >> 3) + 8 * jj] * 128u + 16u * (lane & 7); kk[c2][jj] = *(const v4u*)((const char*)kbat + off); } } }
#pragma unroll
                for (int c2 = 0; c2 < 2; ++c2) { const int c = 2 * hb2 + c2;
                    if (c < nchunk) {
#pragma unroll
                        for (int jj = 0; jj < 8; ++jj) *(LAS v4u*)(kb + ((lane >> 3) + 8 * jj) * V_RS + (lane & 7) * 16) = kk[c2][jj];
                        asm volatile("s_waitcnt lgkmcnt(0)" ::: "memory");
#pragma unroll
                        for (int g = 0; g < 4; ++g) { const bf16x8v k0 = *(const LAS bf16x8v*)(kb + (16 * g + hd) * V_RS + 16 * kq), k1 = *(const LAS bf16x8v*)(kb + (16 * g + hd) * V_RS + 64 + 16 * kq);
                            f32x4 a = (f32x4){0.f, 0.f, 0.f, 0.f}; a = __builtin_amdgcn_mfma_f32_16x16x32_bf16(k0, bq0, a, 0, 0, 0); a = __builtin_amdgcn_mfma_f32_16x16x32_bf16(k1, bq1, a, 0, 0, 0); lg[4 * c + g] = a; }
                        asm volatile("s_waitcnt lgkmcnt(0)" ::: "memory");
                    } else {
                        const float ni = -__builtin_inff();
#pragma unroll
                        for (int g = 0; g < 4; ++g) lg[4 * c + g] = (f32x4){ni, ni, ni, ni};
                    }
                }
            }
            float mxv = -__builtin_inff();
#pragma unroll
            for (int g = 0; g < 16; ++g) { mxv = __builtin_fmaxf(__builtin_fmaxf(mxv, lg[g][0]), lg[g][1]); mxv = __builtin_fmaxf(__builtin_fmaxf(mxv, lg[g][2]), lg[g][3]); }
            mxv = fmaxf(mxv, __shfl_xor(mxv, 16)); mxv = fmaxf(mxv, __shfl_xor(mxv, 32));
            float sum = 0.f; bf16x8v pb[8];
#pragma unroll
            for (int ks = 0; ks < 8; ++ks) { float p[8];
#pragma unroll
                for (int e = 0; e < 4; ++e) { p[e] = __builtin_amdgcn_exp2f(lg[2 * ks][e] - mxv); p[4 + e] = __builtin_amdgcn_exp2f(lg[2 * ks + 1][e] - mxv); }
#pragma unroll
                for (int e = 0; e < 8; ++e) sum += p[e];
                v4u o; o.x = pk2(p[0], p[1]); o.y = pk2(p[2], p[3]); o.z = pk2(p[4], p[5]); o.w = pk2(p[6], p[7]); pb[ks] = __builtin_bit_cast(bf16x8v, o); }
            sum += __shfl_xor(sum, 16); sum += __shfl_xor(sum, 32);
            asm volatile("" ::: "memory");
            f32x4 O[4];
#pragma unroll
            for (int mt = 0; mt < 4; ++mt) O[mt] = (f32x4){0.f, 0.f, 0.f, 0.f};
#pragma unroll
            for (int hb2 = 0; hb2 < 2; ++hb2) {
                v4u vv[2][8];
#pragma unroll
                for (int c2 = 0; c2 < 2; ++c2) { const int c = 2 * hb2 + c2; if (c < nchunk) {
#pragma unroll
                    for (int j = 0; j < 8; ++j) { const unsigned off = (unsigned)sq[64 * c + (lane >> 3) + 8 * j] * 128u + 16u * (lane & 7); vv[c2][j] = *(const v4u*)((const char*)vbat + off); } } }
#pragma unroll
                for (int c2 = 0; c2 < 2; ++c2) { const int c = 2 * hb2 + c2;
                    if (c < nchunk) {
#pragma unroll
                        for (int j = 0; j < 8; ++j) *(LAS v4u*)(vb + ((lane >> 3) + 8 * j) * V_RS + (lane & 7) * 16) = vv[c2][j];
                        asm volatile("s_waitcnt lgkmcnt(0)" ::: "memory");
#pragma unroll
                        for (int ksl = 0; ksl < 2; ++ksl) {
                            const int rowa = 32 * ksl + 4 * kq + (hd >> 2);
#pragma unroll
                            for (int mt = 0; mt < 4; ++mt) {
                                const v4i16_t alo = __builtin_amdgcn_ds_read_tr16_b64_v4i16((LAS v4i16_t*)(vb + rowa * V_RS + (16 * mt + 4 * (hd & 3)) * 2));
                                const v4i16_t ahi = __builtin_amdgcn_ds_read_tr16_b64_v4i16((LAS v4i16_t*)(vb + (rowa + 16) * V_RS + (16 * mt + 4 * (hd & 3)) * 2));
                                bf16x8v A; A[0] = alo[0]; A[1] = alo[1]; A[2] = alo[2]; A[3] = alo[3]; A[4] = ahi[0]; A[5] = ahi[1]; A[6] = ahi[2]; A[7] = ahi[3];
                                O[mt] = __builtin_amdgcn_mfma_f32_16x16x32_bf16(A, pb[2 * c + ksl], O[mt], 0, 0, 0);
                            }
                        }
                        asm volatile("s_waitcnt lgkmcnt(0)" ::: "memory");
                    }
                }
            }
            const float inv = 1.0f / sum; float ss = 0.f;
#pragma unroll
            for (int mt = 0; mt < 4; ++mt) { O[mt] = O[mt] * inv; ss += (O[mt][0] * O[mt][0] + O[mt][1] * O[mt][1]) + (O[mt][2] * O[mt][2] + O[mt][3] * O[mt][3]); }
            ss = wave_sum((hd < 8) ? ss : 0.f);
            const float rs = __builtin_amdgcn_rsqf(ss * (1.f / ATTN_W) + EPS);
            if (hd < 8) {
#pragma unroll
                for (int mt = 0; mt < 4; ++mt) { const int col = hd * 64 + 16 * mt + 4 * kq; const f32x4 gn = *(const f32x4*)(again + col); const f32x4 y = O[mt] * rs * gn;
                    *(unsigned long long*)(MIX + (size_t)r * DM + col) = (unsigned long long)pk2(y[0], y[1]) | ((unsigned long long)pk2(y[2], y[3]) << 32); }
            }
        }
    }
}

constexpr int PH_PER_LAYER = 15, N_PHASES = 2 + DEPTH * PH_PER_LAYER;
#define NOINL __attribute__((noinline, not_tail_called))
typedef LAS unsigned char* ldsp_t;
__device__ __forceinline__ Frame make_frame(ldsp_t lds, const CArgs* A) {
    const unsigned ldsw = (unsigned)(size_t)lds;
    Frame F; F.lds = (ldsp_t)(size_t)(ldsw & 0xFFFFFFu); F.ws = A->ws; F.wave = __builtin_amdgcn_readfirstlane((int)(ldsw >> 24)); F.lane = (int)__builtin_amdgcn_mbcnt_hi(~0u, __builtin_amdgcn_mbcnt_lo(~0u, 0u)); F.tid = (int)(ldsw >> 24) * 64 + F.lane;
    __builtin_assume(F.lane >= 0 && F.lane < 64); __builtin_assume(F.wave >= 0 && F.wave < 8); __builtin_assume(F.tid >= 0 && F.tid < 512);
    F.G = gridDim.x; { const int bx = blockIdx.x; F.vcu = (F.G % 8 == 0) ? (bx % 8) * (F.G / 8) + bx / 8 : bx; }
    return F;
}
__device__ NOINL void ph_grid_bar(const CArgs* A0, ldsp_t lds_w) { const CArgs* A = karg(A0); const unsigned ldsw = (unsigned)__builtin_amdgcn_readfirstlane((int)(unsigned)(size_t)lds_w); const ldsp_t lds = (ldsp_t)(size_t)(ldsw & 0xFFFFFFu);
    const bool t0 = (ldsw >> 24) == 0u && __builtin_amdgcn_mbcnt_hi(~0u, __builtin_amdgcn_mbcnt_lo(~0u, 0u)) == 0u; XcdBarrier b; b.bar = (unsigned*)(A->ws + WS_CTL) + CW_BAR; b.x = xb_xcc_id(); b.st = (volatile LAS unsigned*)(lds + MISC_OFF) + 8; xcd_barrier(b, t0); }
__device__ NOINL void ph_pro_ssm(const CArgs* A0, ldsp_t lds) { const CArgs* A = karg(A0); Frame F = make_frame(lds, A); pro_ssm(A, F); }
__device__ NOINL void ph_pro_mod(const CArgs* A0, ldsp_t lds) { const CArgs* A = karg(A0); Frame F = make_frame(lds, A); pro_mod(A, F); }
__device__ NOINL void ph_pro_wt(const CArgs* A0, ldsp_t lds) { const CArgs* A = karg(A0); Frame F = make_frame(lds, A); pro_wt(A, F); }
__device__ NOINL void ph_pro_rope(const CArgs* A0, ldsp_t lds) { const CArgs* A = karg(A0); Frame F = make_frame(lds, A); pro_rope(A, F); }
__device__ NOINL void ph_norm(const CArgs* A0, ldsp_t lds, int l, int which, int first) { l = __builtin_amdgcn_readfirstlane(l); which = __builtin_amdgcn_readfirstlane(which); first = __builtin_amdgcn_readfirstlane(first); const CArgs* A = karg(A0); Frame F = make_frame(lds, A); unsigned char* ws = A->ws;
    const float* g = (const float*)A->in[5] + (size_t)(l * 3 + which) * DM; const float* modl = (const float*)(ws + WS_MOD) + (size_t)l * NB * NMOD * DM; bf16* XB = (bf16*)(ws + WS_XB);
    if (first) norm_mod_phase<true, false>(F, A->in[0], g, modl, 3 * which, (bf16*)(ws + WS_H), XB);
    else if (which == 1) norm_mod_phase<false, true>(F, XB, g, modl, 3 * which, (bf16*)(ws + WS_H), XB);
    else norm_mod_phase<true, true>(F, XB, g, modl, 3 * which, (bf16*)(ws + WS_H), XB); }
__device__ NOINL void ph_ffn_up(const CArgs* A0, ldsp_t lds, int l, int f) { l = __builtin_amdgcn_readfirstlane(l); f = __builtin_amdgcn_readfirstlane(f); const CArgs* A = karg(A0); unsigned char* ws = A->ws;
    typedef pg8::GemmF8<DM, DM, DM / 128, 124> GP; typedef pg8::StaticOrder<MTOK / 256, NFF1 / 256> SO; GP g{ws + WS_H, ws + WS_W13 + (size_t)(l * 2 + f) * NFF1 * DM}; SO S; S.init(gridDim.x, (int)blockIdx.x);
    EpiSwiGLU E{ws + WS_R}; pg8::gemm_phase<GP, EpiSwiGLU, SO, FFN_ALIGN, FFN_SP2>(lds, g, S, E); }
#if PROBE_DUP >= 13 && PROBE_DUP <= 16
__device__ NOINL void ph_ffn_up_p(const CArgs* A0, ldsp_t lds, int l, int f) { l = __builtin_amdgcn_readfirstlane(l); f = __builtin_amdgcn_readfirstlane(f); const CArgs* A = karg(A0); unsigned char* ws = A->ws;
    typedef pg8::GemmF8<DM, DM, DM / 128, 124, 0, 0, PROBE_DUP - 13> GP; typedef pg8::StaticOrder<MTOK / 256, NFF1 / 256> SO; GP g{ws + WS_H, ws + WS_W13 + (size_t)(l * 2 + f) * NFF1 * DM}; SO S; S.init(gridDim.x, (int)blockIdx.x);
    EpiSwiGLU E{ws + WS_R + 96 * MiB}; pg8::gemm_phase<GP, EpiSwiGLU, SO, FFN_ALIGN, FFN_SP2>(lds, g, S, E); }
#endif
__device__ NOINL void ph_ffn_down(const CArgs* A0, ldsp_t lds, int l, int f, int first) { l = __builtin_amdgcn_readfirstlane(l); f = __builtin_amdgcn_readfirstlane(f); first = __builtin_amdgcn_readfirstlane(first); const CArgs* A = karg(A0); unsigned char* ws = A->ws;
    typedef pg8::GemmF8<DFF, DFF, DFF / 128, 124> GP; typedef pg8::StaticOrder<MTOK / 256, DM / 256> SO; GP g{ws + WS_R, ws + WS_W2 + (size_t)(l * 2 + f) * DM * DFF}; SO S; S.init(gridDim.x, (int)blockIdx.x);
    EpiResid E{(const bf16*)(ws + WS_XB), (bf16*)(ws + WS_XB), (const float*)(ws + WS_MOD) + (size_t)l * NB * NMOD * DM + (2 + 6 * f) * DM, 0.5f}; pg8::gemm_phase<GP, EpiResid, SO, true, true>(lds, g, S, E); }
__device__ NOINL void ph_win(const CArgs* A0, ldsp_t lds, int l) { const CArgs* A = karg(A0); unsigned char* ws = A->ws;
    typedef pg8::GemmRM<DM, DM, DM / 64> GP; typedef pg8::StaticOrder<MTOK / 256, NWIN / 256> SO; GP g{(const bf16*)(ws + WS_H), (const bf16*)(ws + WS_WIN) + (size_t)l * NWIN * DM}; SO S; S.init(gridDim.x, (int)blockIdx.x);
    EpiWin E{ws}; pg8::gemm_phase<GP, EpiWin, SO, true, true>(lds, g, S, E); }
#if ATTN_FAST
__device__ NOINL void ph_attn_a(const CArgs* A0, ldsp_t lds, int ui, int safe) { ui = __builtin_amdgcn_readfirstlane(ui); safe = __builtin_amdgcn_readfirstlane(safe); const CArgs* A = karg(A0); Frame F = make_frame(lds, A); unsigned char* ws = A->ws;
    attn_index_phase<0>(F, ui, (const bf16*)(ws + R_QI), (const bf16*)(ws + R_KI), (const float*)(ws + R_WI), (unsigned short*)(ws + R_SEL), safe); }
__device__ NOINL void ph_attn_b(const CArgs* A0, ldsp_t lds, int ui) { ui = __builtin_amdgcn_readfirstlane(ui); const CArgs* A = karg(A0); Frame F = make_frame(lds, A); unsigned char* ws = A->ws;
    attn_index_phase<1>(F, ui, (const bf16*)(ws + R_QI), (const bf16*)(ws + R_KI), (const float*)(ws + R_WI), (unsigned short*)(ws + R_SEL));
    asm volatile("s_waitcnt vmcnt(0)" ::: "memory"); __syncthreads(); }
#else
__device__ NOINL void ph_attn(const CArgs* A0, ldsp_t lds, int l) { l = __builtin_amdgcn_readfirstlane(l); const CArgs* A = karg(A0); Frame F = make_frame(lds, A); unsigned char* ws = A->ws;
    attn_simple_phase(F, (const bf16*)(ws + R_Q), (const bf16*)(ws + R_KB), (const bf16*)(ws + R_VB), (const bf16*)(ws + R_QI), (const bf16*)(ws + R_KI), (const float*)(ws + R_WI), (const float*)A->in[14] + (size_t)l * ATTN_W, (bf16*)(ws + WS_H)); }
#endif
__device__ NOINL void ph_attn2(const CArgs* A0, ldsp_t lds, int l) { l = __builtin_amdgcn_readfirstlane(l); const CArgs* A = karg(A0); Frame F = make_frame(lds, A); unsigned char* ws = A->ws;
    attn_gather_phase(F, (const bf16*)(ws + R_Q), (const bf16*)(ws + R_KB), (const bf16*)(ws + R_VB), (const unsigned short*)(ws + R_SEL), (const float*)A->in[14] + (size_t)l * ATTN_W, (bf16*)(ws + WS_H)); }
__device__ NOINL void ph_ssm_state(const CArgs* A0, ldsp_t lds, int l) { l = __builtin_amdgcn_readfirstlane(l); const CArgs* A = karg(A0); unsigned char* ws = A->ws;
    typedef pg8::GemmSsm<KSS, KT, KT / 64, 128> GP; typedef pg8::StaticOrder<SG * NCHK / 256, 1> SO; GP g{(const bf16*)(ws + R_UG), (const bf16*)(ws + WS_BW) + (size_t)l * SG * 128 * KT}; SO S; S.init(gridDim.x, (int)blockIdx.x);
    EpiSsmState E{(float*)(ws + R_SINC)}; pg8::gemm_phase<GP, EpiSsmState, SO, true, true>(lds, g, S, E); }
__device__ NOINL void ph_ssm_scan(const CArgs* A0, ldsp_t lds, int l) { l = __builtin_amdgcn_readfirstlane(l); const CArgs* A = karg(A0); Frame F = make_frame(lds, A); unsigned char* ws = A->ws;
    ssm_scan_phase(F, (const float*)(ws + WS_AL) + (size_t)l * SG * SP * 2, (const float*)(ws + R_SINC), (bf16*)(ws + R_UG)); }
__device__ NOINL void ph_ssm_out(const CArgs* A0, ldsp_t lds, int l) { l = __builtin_amdgcn_readfirstlane(l); const CArgs* A = karg(A0); unsigned char* ws = A->ws;
    typedef pg8::GemmSsm<KSS, KSS, KSS / 64, KT> GP; typedef pg8::StaticOrder<SG * NCHK / 256, KT / 256> SO; GP g{(const bf16*)(ws + R_UG), (const bf16*)(ws + WS_BTV) + (size_t)l * SG * KT * KSS}; SO S; S.init(gridDim.x, (int)blockIdx.x);
    EpiSsmOut E{(bf16*)(ws + R_YG)}; pg8::gemm_phase<GP, EpiSsmOut, SO, true, true>(lds, g, S, E); }
__device__ NOINL void ph_glu(const CArgs* A0, ldsp_t lds, int l) { l = __builtin_amdgcn_readfirstlane(l); const CArgs* A = karg(A0); unsigned char* ws = A->ws;
    pg8::GemmGlu g{(const bf16*)(ws + R_YG), (const bf16*)(ws + WS_GLU) + (size_t)l * SSM_W * SSM_W}; typedef pg8::StaticOrder<MTOK / 256, SSM_W / 256> SO; SO S; S.init(gridDim.x, (int)blockIdx.x);
    EpiGlu E{(const bf16*)(ws + R_YG), (bf16*)(ws + R_Y2), (const float*)A->in[25] + (size_t)l * SSM_W}; pg8::gemm_phase<pg8::GemmGlu, EpiGlu, SO, true, true>(lds, g, S, E); }
__device__ NOINL void ph_ssm_norm(const CArgs* A0, ldsp_t lds, int l) { l = __builtin_amdgcn_readfirstlane(l); const CArgs* A = karg(A0); Frame F = make_frame(lds, A); unsigned char* ws = A->ws;
    ssm_norm_phase(F, (const bf16*)(ws + R_Y2), (const float*)A->in[15] + (size_t)l * SSM_W, (bf16*)(ws + WS_H)); }
__device__ NOINL void ph_wout(const CArgs* A0, ldsp_t lds, int l) { l = __builtin_amdgcn_readfirstlane(l); const CArgs* A = karg(A0); unsigned char* ws = A->ws;
    typedef pg8::GemmRM<DM, DM, DM / 64> GP; typedef pg8::StaticOrder<MTOK / 256, DM / 256> SO; GP g{(const bf16*)(ws + WS_H), (const bf16*)(ws + WS_WOUT) + (size_t)l * DM * DM}; SO S; S.init(gridDim.x, (int)blockIdx.x);
    EpiResid E{(const bf16*)(ws + WS_XB), (bf16*)(ws + WS_XB), (const float*)(ws + WS_MOD) + (size_t)l * NB * NMOD * DM + 5 * DM, 1.0f}; pg8::gemm_phase<GP, EpiResid, SO, true, true>(lds, g, S, E); }
__device__ NOINL void ph_final(const CArgs* A0, ldsp_t lds) { const CArgs* A = karg(A0); Frame F = make_frame(lds, A); final_norm_phase(F, (const bf16*)(F.ws + WS_XB), (const float*)A->in[26], A->out);
#if DEBUG_STAT
    { const unsigned* ctr = (const unsigned*)(F.ws + WS_CTL) + 32768; const float den = (DEBUG_STAT == 8) ? 131072.0f : (DEBUG_STAT == 9) ? 4096.0f : 1.0f;
      const float k = 1.0f + (float)ctr[DEBUG_STAT - 1] / den;
      asm volatile("s_waitcnt vmcnt(0)" ::: "memory"); __syncthreads();
      const int gw = F.vcu * 8 + F.wave, NGW = F.G * 8;
      for (int r = gw; r < MTOK; r += NGW) { f32x4* o = (f32x4*)(A->out + (size_t)r * DM) + F.lane; for (int j = 0; j < 4; ++j) o[64 * j] = o[64 * j] * k; } }
#endif
}

__global__ void __launch_bounds__(512, 2) fwd(Args args) {
    extern __shared__ __attribute__((aligned(16))) unsigned char lds_raw[];
    const ldsp_t lds = (ldsp_t)lds_raw;
    const CArgs* const KA = (const CArgs*)__builtin_amdgcn_kernarg_segment_ptr();
    for (int u = threadIdx.x; u < (LDS_BYTES - LDSCTL_OFF) / 4; u += 512) ((LAS unsigned*)(lds + LDSCTL_OFF))[u] = 0u;
    __syncthreads();
    const int lo = args.ph_lo, hi = args.ph_hi;
    if (hi - lo > 1) (void)xcd_barrier_post((unsigned*)(args.ws + WS_CTL) + CW_BAR, (volatile LAS unsigned*)(lds + MISC_OFF) + 8);
    const ldsp_t lw = (ldsp_t)(size_t)((unsigned)(size_t)lds | ((unsigned)__builtin_amdgcn_readfirstlane((int)threadIdx.x >> 6) << 24));
#define IN(k) (lo <= (k) && (k) < hi)
#define SEAM(k) do { if (IN(k) && IN((k) + 1)) ph_grid_bar(KA, lw); } while (0)
    if (IN(0)) { for (int rep = 0; rep < (PROBE_DUP == 7 ? 2 : 1); ++rep) { ph_pro_ssm(KA, lw); ph_pro_mod(KA, lw); ph_pro_wt(KA, lw); ph_pro_rope(KA, lw); __syncthreads(); } }
    SEAM(0);
    for (int sl = 0; sl < 3 * DEPTH; ++sl) {
        const int l = sl / 3, ty = sl - 3 * l, f = ty >> 1;
        if (ty != 1) {
            const int pf = 1 + l * PH_PER_LAYER + (f ? 12 : 0);
            if (IN(pf)) { ph_norm(KA, lw, l, 2 * f, sl == 0); if (PROBE_DUP == 6) ph_norm(KA, lw, l, 2 * f, sl == 0); }
            SEAM(pf);
            if (IN(pf + 1)) { ph_ffn_up(KA, lw, l, f); if (PROBE_DUP == 3) ph_ffn_up(KA, lw, l, f);
#if PROBE_DUP >= 13 && PROBE_DUP <= 16
                ph_ffn_up_p(KA, lw, l, f);
#endif
            }
            SEAM(pf + 1);
            if (IN(pf + 2)) ph_ffn_down(KA, lw, l, f, sl == 0);
            SEAM(pf + 2);
        } else {
            const int p0 = 1 + l * PH_PER_LAYER;
            if (IN(p0 + 3)) { ph_norm(KA, lw, l, 1, 0); if (PROBE_DUP == 6) ph_norm(KA, lw, l, 1, 0); }
            SEAM(p0 + 3);
            if (IN(p0 + 4)) { ph_win(KA, lw, l); if (PROBE_DUP == 4) ph_win(KA, lw, l); }
            SEAM(p0 + 4);
#if ATTN_FAST
            if (IN(p0 + 5)) { for (int rep = 0; rep < (PROBE_DUP == 1 ? 2 : 1); ++rep) for (int ui = 0; ui < 4; ++ui) {
                                  ph_attn_a(KA, lw, ui, 0); if (PROBE_DUP == 12) ph_attn_a(KA, lw, ui, 0);
                                  ph_attn_b(KA, lw, ui);
                                  __syncthreads(); const unsigned okv = (unsigned)__builtin_amdgcn_readfirstlane((int)*(volatile LAS unsigned*)(lds + A_OK)); __syncthreads();
                                  if (!okv) { ph_attn_a(KA, lw, ui, 1); ph_attn_b(KA, lw, ui); }
                                  if (PROBE_DUP == 9) ph_attn_b(KA, lw, ui); }
                              for (int rep = 0; rep < (PROBE_DUP == 2 ? 2 : 1); ++rep) ph_attn2(KA, lw, l); }
#else
            if (IN(p0 + 5)) ph_attn(KA, lw, l);
#endif
            if (PROBE_DUP == 5) SEAM(p0 + 5); else __syncthreads();
            for (int rep = 0; rep < (PROBE_DUP == 5 ? 2 : 1); ++rep) {
            if (IN(p0 + 6)) ph_ssm_state(KA, lw, l);
            SEAM(p0 + 6);
            if (IN(p0 + 7)) ph_ssm_scan(KA, lw, l);
            SEAM(p0 + 7);
            if (IN(p0 + 8)) ph_ssm_out(KA, lw, l);
            SEAM(p0 + 8);
            if (IN(p0 + 9)) ph_glu(KA, lw, l);
            SEAM(p0 + 9);
            if (IN(p0 + 10)) ph_ssm_norm(KA, lw, l);
            SEAM(p0 + 10);
            }
            if (IN(p0 + 11)) ph_wout(KA, lw, l);
            SEAM(p0 + 11);
        }
    }
    if (IN(N_PHASES - 1)) ph_final(KA, lw);
#undef IN
#undef SEAM
}

extern "C" void kernel_launch(void* const* d_in, const int* in_sizes, int n_in, void* d_out, int out_size, void* d_ws, size_t ws_size, hipStream_t stream) {
    static int grid = 0;
    if (grid == 0) {
        if (n_in != 27 || in_sizes[0] != MTOK * DM || out_size != MTOK * DM || ws_size < WS_END) { fprintf(stderr, "kernel_launch: unexpected shapes (n_in %d, in0 %d, out %d, ws %zu < %zu)\n", n_in, n_in > 0 ? in_sizes[0] : -1, out_size, ws_size, (size_t)WS_END); grid = -1; return; }
        int dev = 0, cus = 0;
        if (hipGetDevice(&dev) != hipSuccess || hipDeviceGetAttribute(&cus, hipDeviceAttributeMultiprocessorCount, dev) != hipSuccess) { grid = -1; return; }
        if (hipFuncSetAttribute((const void*)fwd, hipFuncAttributeMaxDynamicSharedMemorySize, LDS_BYTES) != hipSuccess) { fprintf(stderr, "kernel_launch: hipFuncSetAttribute failed\n"); grid = -1; return; }
        int per_cu = 0;
        if (hipOccupancyMaxActiveBlocksPerMultiprocessor(&per_cu, (const void*)fwd, 512, LDS_BYTES) != hipSuccess || per_cu < 1) fprintf(stderr, "kernel_launch: occupancy query reports %d\n", per_cu);
        (void)hipGetLastError();
        grid = cus;
    }
    if (grid < 0) return;
    (void)hipMemsetAsync((char*)d_ws + WS_CTL, 0, CTL_ZERO_BYTES, stream);
    Args a{};
    for (int i = 0; i < 27; ++i) a.in[i] = d_in[i];
    a.out = (float*)d_out; a.ws = (unsigned char*)d_ws;
#if MK_ONE_LAUNCH
    a.ph_lo = 0; a.ph_hi = N_PHASES;
    hipLaunchKernelGGL(fwd, dim3(grid), dim3(512), LDS_BYTES, stream, a);
#else
    for (int p = 0; p < N_PHASES; ++p) { a.ph_lo = p; a.ph_hi = p + 1; hipLaunchKernelGGL(fwd, dim3(grid), dim3(512), LDS_BYTES, stream, a); }
#endif
}
```

```cpp
#include <hip/hip_runtime.h>
#include <cstdio>
#include <cstdint>

#ifndef ATTN_FAST
#define ATTN_FAST 1
#endif
#ifndef PROBE_DUP
#define PROBE_DUP 0
#endif
#ifndef ATTN_SAMPLE
#define ATTN_SAMPLE 0
#endif
#ifndef SPEC_NUM
#define SPEC_NUM 704
#endif
#ifndef PROBE_FALLBACK
#define PROBE_FALLBACK 0
#endif
#ifndef DEBUG_STAT
#define DEBUG_STAT 0
#endif
#ifndef FFN_ALIGN
#define FFN_ALIGN true
#endif
#ifndef FFN_SP2
#define FFN_SP2 true
#endif
#ifndef MK_ONE_LAUNCH
#define MK_ONE_LAUNCH 1
#endif

constexpr int NB = 4, SEQ = 8192, DM = 1024, DEPTH = 4, MTOK = NB * SEQ;
constexpr int DFF = 2816, NFF1 = 2 * DFF;
constexpr int ATTN_W = 512, NH = 8, HD = 64, IDXH = 4, TOPK = 256;
constexpr int SSM_W = 512, SG = 32, GC = 16, SP = 64;
constexpr int LCH = 32, NCHK = MTOK / LCH, CHB = SEQ / LCH, KT = LCH * GC, KSS = KT + 2 * SP;
constexpr int INC = 1476, NWIN = 1536, NMOD = 9;
constexpr float EPS = 1e-6f, ATT_SCALE = 0.125f, IDX_SCALE = 0.0625f;

namespace pg8 {
#define PG8_LAS __attribute__((address_space(3)))
typedef unsigned short bf16_t;
typedef short bf16x8 __attribute__((ext_vector_type(8)));
typedef float f32x4 __attribute__((ext_vector_type(4)));
typedef unsigned u32x4 __attribute__((ext_vector_type(4)));
constexpr int BM = 256, BK = 64, HALF = 128, HTB = HALF * BK * 2, STAGE_BYTES = 8 * HTB, NXCD = 8, WGM = 8;

__host__ __device__ __forceinline__ int lds_byte(int r, int c) { const int st = (r >> 4) * 2 + (c >> 5), rr = r & 15, cc = c & 31, ob = rr * 64 + cc * 2; return st * 1024 + (ob ^ (((ob >> 9) & 1) << 5)); }
__host__ __device__ __forceinline__ void stage_rc(int b, int& R, int& C) { const int st = b / 1024, sb = b % 1024, swz = sb ^ (((sb >> 9) & 1) << 5); R = (st >> 1) * 16 + swz / 64; C = (st & 1) * 32 + (swz % 64) / 2; }
__host__ __device__ __forceinline__ int perm32(int rho) { const int n = rho >> 4, i = rho & 15; return 8 * (i >> 2) + 4 * n + (i & 3); }

struct Unit { int pm, pn; };

template <int NM, int NN> struct StaticOrder {
    static constexpr int nM = NM, nN = NN, nwg = NM * NN;
    int G, c;
    __host__ __device__ void init(int G_, int c_) { G = G_; c = c_; }
    __host__ __device__ bool next(int i, Unit& u) const {
        const long L = (long)i * G + c; if (L >= nwg) return false;
        int wgid = (int)L; { constexpr int q = nwg / NXCD, r = nwg % NXCD; const int xcd = wgid % NXCD, off = wgid / NXCD; wgid = (xcd < r ? xcd * (q + 1) : r * (q + 1) + (xcd - r) * q) + off; }
        constexpr int nig = WGM * nN; const int gid = wgid / nig, fm = gid * WGM, gsz = (nM - fm) < WGM ? (nM - fm) : WGM;
        u.pm = fm + ((wgid % nig) % gsz); u.pn = (wgid % nig) / gsz; return true;
    }
    __device__ __forceinline__ void a_ready(const Unit&) const {}
    __device__ __forceinline__ void done(const Unit&) const {}
};

__device__ __forceinline__ unsigned cvt_pk_bf16(float lo, float hi) { unsigned r; asm volatile("v_cvt_pk_bf16_f32 %0, %1, %2" : "=v"(r) : "v"(lo), "v"(hi)); return r; }

template <int LDA, int LDB, int NKT> struct GemmRM {
    const bf16_t* A; const bf16_t* Bt;
    static constexpr int nkt = NKT;
    __device__ __forceinline__ unsigned aVoff(int R, int C) const { return (unsigned)(R * LDA + C) * 2u; }
    __device__ __forceinline__ unsigned bVoff(int R, int C) const { return (unsigned)(R * LDB + C) * 2u; }
    __device__ __forceinline__ unsigned aK() const { return 128u; }
    __device__ __forceinline__ unsigned bK() const { return 128u; }
    __device__ __forceinline__ unsigned aH() const { return (unsigned)HALF * LDA * 2u; }
    __device__ __forceinline__ unsigned bH() const { return (unsigned)HALF * LDB * 2u; }
    __device__ __forceinline__ unsigned aOff(const Unit& u) const { return (unsigned)u.pm * (256u * LDA * 2u); }
    __device__ __forceinline__ unsigned bOff(const Unit& u) const { return (unsigned)u.pn * (256u * LDB * 2u); }
};
template <int LDA, int LDB, int NKT, int SCALE_W, int SKM_ = 0, int SKN_ = 0, int PROBE_ = 0  > struct GemmF8 {
    const unsigned char* A; const unsigned char* Bt;
    static constexpr int nkt = NKT; static constexpr bool F8 = true; static constexpr int SW = SCALE_W; static constexpr int SKM = SKM_, SKN = SKN_, PROBE = PROBE_;
    __device__ __forceinline__ unsigned aVoff(int R, int C) const { return (unsigned)(R * LDA + 2 * C); }
    __device__ __forceinline__ unsigned bVoff(int R, int C) const { return (unsigned)(R * LDB + 2 * C); }
    __device__ __forceinline__ unsigned aK() const { return 128u; }
    __device__ __forceinline__ unsigned bK() const { return 128u; }
    __device__ __forceinline__ unsigned aH() const { return (unsigned)HALF * LDA; }
    __device__ __forceinline__ unsigned bH() const { return (unsigned)HALF * LDB; }
    __device__ __forceinline__ unsigned aOff(const Unit& u) const { return (unsigned)u.pm * (256u * LDA); }
    __device__ __forceinline__ unsigned bOff(const Unit& u) const { return (unsigned)u.pn * (256u * LDB); }
};
template <class GP, class = void> struct gp_is_f8 { static constexpr bool value = false; static constexpr int sw = 127; };
template <class GP> struct gp_is_f8<GP, decltype((void)GP::F8)> { static constexpr bool value = GP::F8; static constexpr int sw = GP::SW; };
template <class GP, class = void> struct gp_probe { static constexpr int value = 0; };
template <class GP> struct gp_probe<GP, decltype((void)GP::PROBE)> { static constexpr int value = GP::PROBE; };
template <class GP, class = void> struct gp_skew { static constexpr bool value = false; static constexpr int SKM = 0, SKN = 0; };
template <class GP> struct gp_skew<GP, decltype((void)GP::SKM)> { static constexpr bool value = (GP::SKM != 0 || GP::SKN != 0); static constexpr int SKM = GP::SKM, SKN = GP::SKN; };
typedef int i32x8 __attribute__((ext_vector_type(8)));
typedef int i32x4 __attribute__((ext_vector_type(4)));
__device__ __forceinline__ i32x8 cat32(bf16x8 lo, bf16x8 hi) { const i32x4 a = __builtin_bit_cast(i32x4, lo), b = __builtin_bit_cast(i32x4, hi); return __builtin_shufflevector(a, b, 0, 1, 2, 3, 4, 5, 6, 7); }
template <int LDA, int LDB, int NKT, int BROWS> struct GemmSsm {
    const bf16_t* A; const bf16_t* Bt;
    static constexpr int nkt = NKT;
    __device__ __forceinline__ unsigned aVoff(int R, int C) const { return (unsigned)(R * LDA + C) * 2u; }
    __device__ __forceinline__ unsigned bVoff(int R, int C) const { return (unsigned)(R * LDB + C) * 2u; }
    __device__ __forceinline__ unsigned aK() const { return 128u; }
    __device__ __forceinline__ unsigned bK() const { return 128u; }
    __device__ __forceinline__ unsigned aH() const { return (unsigned)HALF * LDA * 2u; }
    __device__ __forceinline__ unsigned bH() const { return (unsigned)HALF * LDB * 2u; }
    __device__ __forceinline__ unsigned aOff(const Unit& u) const { return (unsigned)u.pm * (256u * LDA * 2u); }
    __device__ __forceinline__ unsigned bOff(const Unit& u) const { return ((unsigned)(u.pm >> 2) * BROWS + (unsigned)u.pn * 256u) * (LDB * 2u); }
};
struct GemmGlu {
    const bf16_t* A; const bf16_t* Bt;
    static constexpr int nkt = 8;
    __device__ __forceinline__ unsigned aVoff(int R, int C) const { return (unsigned)((C >> 4) * (NCHK * KT) + (R >> 5) * KT + (R & 31) * 16 + (C & 15)) * 2u; }
    __device__ __forceinline__ unsigned bVoff(int R, int C) const { return (unsigned)(R * 512 + C) * 2u; }
    __device__ __forceinline__ unsigned aK() const { return 4u * NCHK * KT * 2u; }
    __device__ __forceinline__ unsigned bK() const { return 128u; }
    __device__ __forceinline__ unsigned aH() const { return 4u * KT * 2u; }
    __device__ __forceinline__ unsigned bH() const { return (unsigned)HALF * 512u * 2u; }
    __device__ __forceinline__ unsigned aOff(const Unit& u) const { return (unsigned)u.pm * (8u * KT * 2u); }
    __device__ __forceinline__ unsigned bOff(const Unit& u) const { return (unsigned)u.pn * (256u * 512u * 2u); }
};

template <class GP, class Epi, class Sched, bool ALIGN_EPI = false, bool SP2 = false>
__device__ __forceinline__ void gemm_phase(PG8_LAS unsigned char* lds_w, const GP g, const Sched& S, const Epi& E) {
    const unsigned ldsq = (unsigned)__builtin_amdgcn_readfirstlane((int)(unsigned)(size_t)lds_w);
    PG8_LAS unsigned char* const lds = (PG8_LAS unsigned char*)(size_t)(ldsq & 0xFFFFFFu);
    const int wid0 = (int)(ldsq >> 24), wid = (gp_probe<GP>::value == 3) ? (((wid0 & 1) << 2) | (wid0 >> 1)) : wid0, lane = (int)__builtin_amdgcn_mbcnt_hi(~0u, __builtin_amdgcn_mbcnt_lo(~0u, 0u)), tid = wid * 64 + lane, wr = wid >> 2, wc = wid & 3, fr = lane & 15, fq = lane >> 4;
    const int nt = g.nkt;
    unsigned voffA[2], voffB[2];
#pragma unroll
    for (int i = 0; i < 2; ++i) { int R, C; stage_rc(tid * 16 + i * 8192, R, C); const int Rb = Epi::PERM ? ((R & ~31) + perm32(R & 31)) : R;
        voffA[i] = g.aVoff(R, C); voffB[i] = g.bVoff(Rb, C); }
    const unsigned kstepA = g.aK(), kstepB = g.bK(), hstepA = g.aH(), hstepB = g.bH();
    const char* const baseA = (const char*)g.A; const char* const baseB = (const char*)g.Bt;
    const unsigned ldsw = (unsigned)wid * 1024u;
    const int aoff = lds_byte(wr * 64 + fr, fq * 8), boff = lds_byte(wc * 32 + fr, fq * 8);
#define PG8_SA(b, h) (((b) * 2 + (h)) * HTB)
#define PG8_SB(b, h) ((4 + (b) * 2 + (h)) * HTB)
#define PG8_STAGE_(bufoff, base, goff, voff) do { if constexpr (gp_probe<GP>::value != 2) _Pragma("unroll") for (int _i = 0; _i < 2; ++_i) \
        __builtin_amdgcn_global_load_lds((const unsigned*)((base) + (unsigned)((goff) + (voff)[_i])), (PG8_LAS unsigned*)(lds + (bufoff) + ldsw + _i * 8192), 16, 0, 0); } while (0)
#define PG8_STAGE(bufoff, goff, voff) PG8_STAGE_(bufoff, PG8_BASE_##voff, goff, voff)
#define PG8_BASE_voffA baseA
#define PG8_BASE_voffB baseB
#define PG8_LDA(dst, b, h) do { _Pragma("unroll") for (int m = 0; m < 4; ++m) { \
        if constexpr (gp_is_f8<GP>::value) dst##8[m] = cat32(*(const PG8_LAS bf16x8*)(lds + PG8_SA(b, h) + aoff + m * 2048), *(const PG8_LAS bf16x8*)(lds + PG8_SA(b, h) + aoff + m * 2048 + 1024)); \
        else { _Pragma("unroll") for (int k = 0; k < 2; ++k) dst[m][k] = *(const PG8_LAS bf16x8*)(lds + PG8_SA(b, h) + aoff + m * 2048 + k * 1024); } } } while (0)
#define PG8_LDB(dst, b, h) do { _Pragma("unroll") for (int n = 0; n < 2; ++n) { \
        if constexpr (gp_is_f8<GP>::value) dst##8[n] = cat32(*(const PG8_LAS bf16x8*)(lds + PG8_SB(b, h) + boff + n * 2048), *(const PG8_LAS bf16x8*)(lds + PG8_SB(b, h) + boff + n * 2048 + 1024)); \
        else { _Pragma("unroll") for (int k = 0; k < 2; ++k) dst[n][k] = *(const PG8_LAS bf16x8*)(lds + PG8_SB(b, h) + boff + n * 2048 + k * 1024); } } } while (0)
#define PG8_MMA(ai, bj, At, Bt) do { __builtin_amdgcn_s_setprio(1); _Pragma("unroll") for (int m = 0; m < 4; ++m) _Pragma("unroll") for (int n = 0; n < 2; ++n) { \
        if constexpr (gp_probe<GP>::value == 1) { asm volatile("" :: "v"(Bt##8[n]), "v"(At##8[m])); } else \
        if constexpr (gp_is_f8<GP>::value) acc[ai][bj][m][n] = __builtin_amdgcn_mfma_scale_f32_16x16x128_f8f6f4(Bt##8[n], At##8[m], acc[ai][bj][m][n], 0, 0, 0, gp_is_f8<GP>::sw, 0, gp_is_f8<GP>::sw); \
        else { _Pragma("unroll") for (int k = 0; k < 2; ++k) acc[ai][bj][m][n] = __builtin_amdgcn_mfma_f32_16x16x32_bf16(Bt[n][k], At[m][k], acc[ai][bj][m][n], 0, 0, 0); } } __builtin_amdgcn_s_setprio(0); } while (0)
#define PG8_WAIT_V(n) asm volatile("s_waitcnt vmcnt(" #n ")" ::: "memory")
#define PG8_WAIT_L(n) asm volatile("s_waitcnt lgkmcnt(" #n ")" ::: "memory")
#define PG8_BAR __builtin_amdgcn_s_barrier()
#define PG8_SCHED __builtin_amdgcn_sched_barrier(0)
    Unit cur, nxt; int ui = 0;
    if (!S.next(0, cur)) return;
    f32x4 acc[2][2][4][2];
#pragma unroll
    for (int a = 0; a < 2; ++a)
#pragma unroll
        for (int b = 0; b < 2; ++b)
#pragma unroll
            for (int m = 0; m < 4; ++m)
#pragma unroll
                for (int n = 0; n < 2; ++n) acc[a][b][m][n] = (f32x4){0.f, 0.f, 0.f, 0.f};
    bf16x8 At[4][2], B0[2][2], B1[2][2];
    i32x8 At8[4], B08[2], B18[2];
    unsigned cA = g.aOff(cur), cB = g.bOff(cur);
    constexpr bool SKEW = gp_skew<GP>::value;
    auto kof = [&](const Unit& u) -> int { if constexpr (SKEW) return (int)((unsigned)(gp_skew<GP>::SKM * u.pm + gp_skew<GP>::SKN * u.pn) % (unsigned)GP::nkt); else return 0; };
    auto kx = [&](int t, int off) -> unsigned { if constexpr (SKEW) { int k = t + off; if (k >= nt) k -= nt; return (unsigned)k; } else return (unsigned)t; };
    int offc = kof(cur);
    S.a_ready(cur);
    { const unsigned p0A = cA + kx(0, offc) * kstepA, p0B = cB + kx(0, offc) * kstepB, p1A = cA + kx(1, offc) * kstepA, p1B = cB + kx(1, offc) * kstepB;
    if constexpr (SP2) {
        PG8_STAGE(PG8_SB(0, 0), p0B, voffB); PG8_STAGE(PG8_SB(0, 1), p0B + hstepB, voffB); PG8_STAGE(PG8_SA(0, 0), p0A, voffA); PG8_STAGE(PG8_SA(0, 1), p0A + hstepA, voffA);
        if (wr == 1) PG8_BAR;
        PG8_WAIT_V(2); PG8_BAR;
        PG8_STAGE(PG8_SB(1, 0), p1B, voffB); PG8_STAGE(PG8_SA(1, 0), p1A, voffA); PG8_STAGE(PG8_SB(1, 1), p1B + hstepB, voffB);
        PG8_WAIT_V(6); PG8_BAR;
    } else {
        PG8_STAGE(PG8_SB(0, 0), p0B, voffB); PG8_STAGE(PG8_SA(0, 0), p0A, voffA); PG8_STAGE(PG8_SB(0, 1), p0B + hstepB, voffB); PG8_STAGE(PG8_SA(0, 1), p0A + hstepA, voffA);
        if (wr == 1) PG8_BAR;
        PG8_WAIT_V(4); PG8_BAR;
        PG8_STAGE(PG8_SB(1, 0), p1B, voffB); PG8_STAGE(PG8_SA(1, 0), p1A, voffA); PG8_STAGE(PG8_SB(1, 1), p1B + hstepB, voffB);
        PG8_WAIT_V(6); PG8_BAR;
    } }
    for (;;) {
        const bool has_next = S.next(ui + 1, nxt);
        const unsigned nA = has_next ? g.aOff(nxt) : cA, nB = has_next ? g.bOff(nxt) : cB;
        const int offn = has_next ? kof(nxt) : offc;
#pragma unroll 1
        for (int t = 0; t < nt; t += 2) {
            const bool last = (t == nt - 2);
            const unsigned a1 = cA + kx(t + 1, offc) * kstepA;
            const unsigned k2 = last ? kx(0, offn) : kx(t + 2, offc), k3 = last ? kx(1, offn) : kx(t + 3, offc);
            const unsigned a2 = (last ? nA : cA) + k2 * kstepA, b2 = (last ? nB : cB) + k2 * kstepB;
            const unsigned a3 = SKEW ? (last ? nA : cA) + k3 * kstepA : a2 + kstepA, b3 = SKEW ? (last ? nB : cB) + k3 * kstepB : b2 + kstepB;
            if (last && has_next) S.a_ready(nxt);
            if constexpr (SP2) {
            PG8_LDB(B0, 0, 0); PG8_LDB(B1, 0, 1); PG8_SCHED; PG8_LDA(At, 0, 0); PG8_STAGE(PG8_SA(1, 1), a1 + hstepA, voffA);
            PG8_WAIT_V(8); PG8_WAIT_L(0); PG8_BAR; PG8_MMA(0, 0, At, B0); PG8_MMA(0, 1, At, B1); PG8_BAR; PG8_SCHED;
            PG8_LDA(At, 0, 1); PG8_STAGE(PG8_SB(0, 0), b2, voffB); PG8_STAGE(PG8_SB(0, 1), b2 + hstepB, voffB); PG8_STAGE(PG8_SA(0, 0), a2, voffA);
            PG8_WAIT_V(8); PG8_WAIT_L(0); PG8_BAR; PG8_MMA(1, 0, At, B0); PG8_MMA(1, 1, At, B1); PG8_BAR; PG8_SCHED;
            PG8_LDB(B0, 1, 0); PG8_LDB(B1, 1, 1); PG8_SCHED; PG8_LDA(At, 1, 0); PG8_STAGE(PG8_SA(0, 1), a2 + hstepA, voffA);
            PG8_WAIT_V(8); PG8_WAIT_L(0); PG8_BAR; PG8_MMA(0, 0, At, B0); PG8_MMA(0, 1, At, B1); PG8_BAR; PG8_SCHED;
            PG8_LDA(At, 1, 1); PG8_STAGE(PG8_SB(1, 0), b3, voffB); PG8_STAGE(PG8_SB(1, 1), b3 + hstepB, voffB); PG8_STAGE(PG8_SA(1, 0), a3, voffA);
            PG8_WAIT_V(8); PG8_WAIT_L(0); PG8_BAR; PG8_MMA(1, 0, At, B0); PG8_MMA(1, 1, At, B1); PG8_BAR; PG8_SCHED;
            } else {
            PG8_LDB(B0, 0, 0); PG8_SCHED; PG8_LDA(At, 0, 0); PG8_STAGE(PG8_SA(1, 1), a1 + hstepA, voffA);
            PG8_WAIT_L(8); PG8_BAR; PG8_WAIT_L(0); PG8_MMA(0, 0, At, B0); PG8_BAR; PG8_SCHED;
            PG8_LDB(B1, 0, 1); PG8_STAGE(PG8_SB(0, 0), b2, voffB);
            PG8_BAR; PG8_WAIT_L(0); PG8_MMA(0, 1, At, B1); PG8_BAR;
            PG8_LDA(At, 0, 1); PG8_STAGE(PG8_SA(0, 0), a2, voffA);
            PG8_BAR; PG8_WAIT_L(0); PG8_MMA(1, 0, At, B0); PG8_BAR; PG8_SCHED;
            PG8_STAGE(PG8_SB(0, 1), b2 + hstepB, voffB);
            PG8_WAIT_V(6); PG8_BAR; PG8_MMA(1, 1, At, B1); PG8_BAR;
            PG8_LDB(B0, 1, 0); PG8_SCHED; PG8_LDA(At, 1, 0); PG8_STAGE(PG8_SA(0, 1), a2 + hstepA, voffA);
            PG8_WAIT_L(8); PG8_BAR; PG8_WAIT_L(0); PG8_MMA(0, 0, At, B0); PG8_BAR; PG8_SCHED;
            PG8_LDB(B1, 1, 1); PG8_STAGE(PG8_SB(1, 0), b3, voffB);
            PG8_BAR; PG8_WAIT_L(0); PG8_MMA(0, 1, At, B1); PG8_BAR;
            PG8_LDA(At, 1, 1); PG8_STAGE(PG8_SA(1, 0), a3, voffA);
            PG8_BAR; PG8_WAIT_L(0); PG8_MMA(1, 0, At, B0); PG8_BAR; PG8_SCHED;
            PG8_STAGE(PG8_SB(1, 1), b3 + hstepB, voffB);
            PG8_WAIT_V(6); PG8_BAR; PG8_MMA(1, 1, At, B1); PG8_BAR;
            }
        }
        if constexpr (ALIGN_EPI) { if (wr == 0) PG8_BAR; }
        E(acc, cur, wr, wc, fr, fq); S.done(cur);
        if (!has_next) break;
#pragma unroll
        for (int a = 0; a < 2; ++a)
#pragma unroll
            for (int b = 0; b < 2; ++b)
#pragma unroll
                for (int m = 0; m < 4; ++m)
#pragma unroll
                    for (int n = 0; n < 2; ++n) acc[a][b][m][n] = (f32x4){0.f, 0.f, 0.f, 0.f};
        cur = nxt; cA = nA; cB = nB; offc = offn; ++ui;
        if constexpr (ALIGN_EPI) { if (wr == 1) PG8_BAR; }
    }
    PG8_WAIT_V(0);
    if constexpr (!ALIGN_EPI) { if (wr == 0) PG8_BAR; }
    PG8_BAR;
#undef PG8_SA
#undef PG8_SB
#undef PG8_STAGE
#undef PG8_STAGE_
#undef PG8_BASE_voffA
#undef PG8_BASE_voffB
#undef PG8_LDA
#undef PG8_LDB
#undef PG8_MMA
#undef PG8_WAIT_V
#undef PG8_WAIT_L
#undef PG8_BAR
#undef PG8_SCHED
}
}

constexpr size_t MiB = 1u << 20;
constexpr size_t WS_CTL = 0, CTL_ZERO_BYTES = 1 * MiB;
constexpr size_t WS_MOD = 1 * MiB;
constexpr size_t WS_ROPE = 2 * MiB;
constexpr size_t WS_AL = 4 * MiB;
constexpr size_t WS_W13 = 5 * MiB;
constexpr size_t WS_W2 = 49 * MiB;
constexpr size_t WS_XB = 72 * MiB;
constexpr size_t WS_WIN = 137 * MiB;
constexpr size_t WS_WOUT = 149 * MiB;
constexpr size_t WS_GLU = 157 * MiB;
constexpr size_t WS_BTV = 159 * MiB;
constexpr size_t WS_BW = 239 * MiB;
constexpr size_t WS_H = 256 * MiB;
constexpr size_t WS_R = 320 * MiB;
constexpr size_t R_Q = WS_R, R_KB = WS_R + 32 * MiB, R_VB = WS_R + 36 * MiB, R_QI = WS_R + 40 * MiB, R_KI = WS_R + 56 * MiB, R_WI = WS_R + 60 * MiB;
constexpr size_t R_UG = WS_R + 61 * MiB;
constexpr size_t R_SINC = WS_R + 101 * MiB;
constexpr size_t R_YG = WS_R + 117 * MiB;
constexpr size_t R_Y2 = WS_R + 149 * MiB;
constexpr size_t R_SEL = WS_R + 181 * MiB;
constexpr size_t WS_END = 517 * MiB;
constexpr int CW_BAR = 4096;

constexpr int RING_BYTES = 131072, LDSCTL_OFF = RING_BYTES, MISC_OFF = LDSCTL_OFF + 320, LDS_BYTES = 163840;

#define GAS __attribute__((address_space(1)))
#define LAS __attribute__((address_space(3)))
typedef unsigned short bf16;
typedef unsigned v4u __attribute__((ext_vector_type(4)));
typedef float f32x4 __attribute__((ext_vector_type(4)));
typedef GAS unsigned gu32;
#define RLX_AGENT __ATOMIC_RELAXED, __HIP_MEMORY_SCOPE_AGENT
#define LDS_WAIT() asm volatile("s_waitcnt lgkmcnt(0)" ::: "memory")
__device__ __forceinline__ unsigned f2bf(float f) { unsigned u = __builtin_bit_cast(unsigned, f); return (u + 0x7fffu + ((u >> 16) & 1u)) >> 16; }
__device__ __forceinline__ unsigned pk2(float lo, float hi) { unsigned r; asm("v_cvt_pk_bf16_f32 %0, %1, %2" : "=v"(r) : "v"(lo), "v"(hi)); return r; }
__device__ __forceinline__ unsigned pk8(float a, float b, float c, float d) {
    a = __builtin_amdgcn_fmed3f(a, -448.f, 448.f); b = __builtin_amdgcn_fmed3f(b, -448.f, 448.f); c = __builtin_amdgcn_fmed3f(c, -448.f, 448.f); d = __builtin_amdgcn_fmed3f(d, -448.f, 448.f);
    int v = __builtin_amdgcn_cvt_pk_fp8_f32(a, b, 0, false); v = __builtin_amdgcn_cvt_pk_fp8_f32(c, d, v, true); return (unsigned)v; }
__device__ __forceinline__ float bf2f(unsigned short b) { return __builtin_bit_cast(float, (unsigned)b << 16); }
__device__ __forceinline__ float bflo(unsigned w) { return __builtin_bit_cast(float, w << 16); }
__device__ __forceinline__ float bfhi(unsigned w) { return __builtin_bit_cast(float, w & 0xffff0000u); }

#define XB_TMO      128
#define XB_XCNT(j)  (256  + 64 * (j))
#define XB_XSUB(j)  (1280 + 64 * (j))
#define XB_XGEN(j)  (2304 + 64 * (j))
#define XB_TOP      3328
#define XB_TOPGEN   3392
#define XCD_BAR_WORDS 3456
#define XB_SPIN_CAP (1u << 18)
__device__ __forceinline__ unsigned xb_ld(unsigned* p)              { return __hip_atomic_load(p, __ATOMIC_RELAXED, __HIP_MEMORY_SCOPE_AGENT); }
__device__ __forceinline__ unsigned xb_add(unsigned* p, unsigned v) { return __hip_atomic_fetch_add(p, v, __ATOMIC_RELAXED, __HIP_MEMORY_SCOPE_AGENT); }
__device__ __forceinline__ unsigned xb_xcc_id() { return (unsigned)__builtin_amdgcn_s_getreg((3 << 11) | 20) & 0xFu; }
#define XB_SPIN(cond, bar) do { unsigned _sp = 0; while (cond) { __builtin_amdgcn_s_sleep(1); \
    if ((++_sp & 255u) == 0u) { if (xb_ld(&(bar)[XB_TMO])) break; if (_sp > XB_SPIN_CAP) { atomicAdd(&(bar)[XB_TMO], 1u); break; } } } } while (0)
struct XcdBarrier { unsigned* bar; unsigned x; volatile LAS unsigned* st; };
__device__ __forceinline__ XcdBarrier xcd_barrier_post(unsigned* bar, volatile LAS unsigned* st) {
    XcdBarrier b; b.bar = bar; b.x = xb_xcc_id(); b.st = st;
    if (threadIdx.x == 0) (void)xb_add(&bar[XB_XCNT(b.x)], 1u);
    return b;
}
__device__ __forceinline__ void xcd_barrier_complete(unsigned* bar, unsigned x, unsigned& nloc, unsigned& nx) {
    const unsigned G = gridDim.x * gridDim.y * gridDim.z;
    unsigned sum, cnt, mine, sp = 0u;
    for (;;) {
        sum = 0u; cnt = 0u; mine = 0u;
#pragma unroll
        for (unsigned j = 0; j < 16; ++j) { const unsigned c = xb_ld(&bar[XB_XCNT(j)]); sum += c; cnt += (c > 0u) ? 1u : 0u; mine = (j == x) ? c : mine; }
        if (sum == G) break;
        __builtin_amdgcn_s_sleep(1);
        if ((++sp & 255u) == 0u) { if (xb_ld(&bar[XB_TMO])) break; if (sp > XB_SPIN_CAP) { atomicAdd(&bar[XB_TMO], 1u); break; } }
    }
    nloc = mine > 0u ? mine : 1u; nx = cnt > 0u ? cnt : 1u;
}
__device__ __forceinline__ void xcd_barrier(const XcdBarrier& b, const bool t0) {
    asm volatile("s_waitcnt vmcnt(0)" ::: "memory");
    __syncthreads();
    if (t0) {
        unsigned* bar = b.bar;
        __builtin_amdgcn_s_waitcnt(0);
        unsigned nloc = b.st[0], nx = b.st[1];
        if (nloc == 0u) { xcd_barrier_complete(bar, b.x, nloc, nx); b.st[0] = nloc; b.st[1] = nx; }
        const unsigned old = xb_add(&bar[XB_XSUB(b.x)], 1u);
        const unsigned gen = old / nloc;
        if (old + 1u == (gen + 1u) * nloc) {
            __builtin_amdgcn_fence(__ATOMIC_RELEASE, "agent");
            asm volatile("s_waitcnt vmcnt(0)" ::: "memory");
            const unsigned og = xb_add(&bar[XB_TOP], 1u);
            const unsigned tg = og / nx;
            if (og + 1u == (tg + 1u) * nx) xb_add(&bar[XB_TOPGEN], 1u);
            else XB_SPIN(xb_ld(&bar[XB_TOPGEN]) == tg, bar);
            __builtin_amdgcn_fence(__ATOMIC_ACQUIRE, "agent");
            xb_add(&bar[XB_XGEN(b.x)], 1u);
            asm volatile("s_waitcnt vmcnt(0)" ::: "memory");
        } else {
            XB_SPIN(xb_ld(&bar[XB_XGEN(b.x)]) == gen, bar);
            __builtin_amdgcn_fence(__ATOMIC_ACQUIRE, "agent");
            asm volatile("s_waitcnt vmcnt(0)" ::: "memory");
        }
    }
    __syncthreads();
}

struct Args { const void* in[27]; float* out; unsigned char* ws; int ph_lo, ph_hi, pad0, pad1; };
typedef const __attribute__((address_space(4))) Args CArgs;
__device__ __forceinline__ const CArgs* karg(const CArgs* p) { const unsigned long long v = (unsigned long long)p; const unsigned lo = __builtin_amdgcn_readfirstlane((unsigned)v), hi = __builtin_amdgcn_readfirstlane((unsigned)(v >> 32)); return (const CArgs*)(((unsigned long long)hi << 32) | lo); }
struct Frame {
    LAS unsigned char* lds; unsigned char* ws;
    int tid, lane, wave, vcu, G;
};
__device__ __forceinline__ float wave_sum(float v) {
#define WS_DPP(x, ctrl, rm) __builtin_bit_cast(float, __builtin_amdgcn_update_dpp(0, __builtin_bit_cast(int, (x)), ctrl, rm, 0xF, false))
    v += WS_DPP(v, 0x111, 0xF); v += WS_DPP(v, 0x112, 0xF); v += WS_DPP(v, 0x114, 0xF); v += WS_DPP(v, 0x118, 0xF);
    v += WS_DPP(v, 0x142, 0xA); v += WS_DPP(v, 0x143, 0xC);
#undef WS_DPP
    return __builtin_bit_cast(float, __builtin_amdgcn_readlane(__builtin_bit_cast(int, v), 63));
}
__device__ __forceinline__ float wave_max(float v) {
#pragma unroll
    for (int o = 1; o < 64; o <<= 1) v = fmaxf(v, __shfl_xor(v, o));
    return v;
}
__device__ __forceinline__ float sigmoidf_(float x) { return __builtin_amdgcn_rcpf(1.0f + __expf(-x)); }
__device__ __forceinline__ float gelu_tanh(float x) { const float u = 0.7978845608028654f * (x + 0.044715f * x * x * x); return x * sigmoidf_(2.0f * u); }

using pg8::Unit; using pg8::cvt_pk_bf16;
struct EpiSwiGLU {
    static constexpr bool PERM = true;
    unsigned char* O;
    __device__ __forceinline__ void operator()(const f32x4 (&acc)[2][2][4][2], const Unit& u, int wr, int wc, int fr, int fq) const {
        { int ln; asm volatile("v_mbcnt_lo_u32_b32 %0, -1, 0\n\tv_mbcnt_hi_u32_b32 %0, -1, %0" : "=v"(ln)); fr = ln & 15; fq = ln >> 4; }
        const int row0 = u.pm * 256 + wr * 64 + fr, col0 = u.pn * 128 + wc * 32 + 8 * fq;
#pragma unroll
        for (int ai = 0; ai < 2; ++ai)
#pragma unroll
            for (int m = 0; m < 4; ++m) {
                unsigned char* p = O + (size_t)(row0 + ai * 128 + m * 16) * DFF + col0;
                float o[8];
#pragma unroll
                for (int n = 0; n < 2; ++n)
#pragma unroll
                    for (int e = 0; e < 4; ++e) { const float a = acc[ai][0][m][n][e], b = acc[ai][1][m][n][e]; o[4 * n + e] = (a + a) * sigmoidf_(a) * b; }
                *(unsigned long long*)p = (unsigned long long)pk8(o[0], o[1], o[2], o[3]) | ((unsigned long long)pk8(o[4], o[5], o[6], o[7]) << 32);
            }
    }
};
struct EpiResid {
    static constexpr bool PERM = true;
    const bf16* xin; bf16* xout; const float* gate; float coef;
    __device__ __forceinline__ void operator()(const f32x4 (&acc)[2][2][4][2], const Unit& u, int wr, int wc, int fr, int fq) const {
        { int ln; asm volatile("v_mbcnt_lo_u32_b32 %0, -1, 0\n\tv_mbcnt_hi_u32_b32 %0, -1, %0" : "=v"(ln)); fr = ln & 15; fq = ln >> 4; }
        const unsigned row0 = (unsigned)(u.pm * 256 + wr * 64 + fr), col0 = (unsigned)(u.pn * 256 + wc * 32 + 8 * fq);
        const float* gp = gate + (size_t)((u.pm * 256) >> 13) * (NMOD * DM) + col0;
        f32x4 gv[2][2];
#pragma unroll
        for (int bj = 0; bj < 2; ++bj)
#pragma unroll
            for (int n = 0; n < 2; ++n) gv[bj][n] = *(const f32x4*)(gp + bj * 128 + n * 4) * coef;
#pragma unroll
        for (int ai = 0; ai < 2; ++ai)
#pragma unroll
            for (int m = 0; m < 4; ++m) { const unsigned off = (row0 + ai * 128 + m * 16) * (unsigned)DM + col0;
#pragma unroll
                for (int bj = 0; bj < 2; ++bj) { const v4u q = *(const v4u*)(xin + off + bj * 128);
                    const f32x4 a0 = gv[bj][0] * acc[ai][bj][m][0], a1 = gv[bj][1] * acc[ai][bj][m][1];
                    v4u o; o.x = pk2(bflo(q.x) + a0.x, bfhi(q.x) + a0.y); o.y = pk2(bflo(q.y) + a0.z, bfhi(q.y) + a0.w); o.z = pk2(bflo(q.z) + a1.x, bfhi(q.z) + a1.y); o.w = pk2(bflo(q.w) + a1.z, bfhi(q.w) + a1.w);
                    *(v4u*)(xout + off + bj * 128) = o; } }
    }
};
struct EpiWin {
    static constexpr bool PERM = true;
    unsigned char* ws;
    __device__ __forceinline__ void operator()(const f32x4 (&acc)[2][2][4][2], const Unit& u, int wr, int wc, int fr, int fq) const {
        const int row0 = u.pm * 256 + wr * 64 + fr;
#pragma unroll 1
        for (int bj = 0; bj < 2; ++bj) {
            const int C0 = u.pn * 256 + bj * 128 + wc * 32, G64 = C0 >> 6, w0 = (C0 & 63) + 8 * fq;
            const bool do_rope = ((C0 & 63) == 0) && (G64 <= 8 || (G64 >= 10 && G64 <= 14));
            size_t boff; int S1, S2, loff = w0; float scl = 1.0f;
            if (G64 < 8) { boff = R_Q + (size_t)G64 * 128; S2 = ATTN_W; S1 = 32 * ATTN_W; scl = ATT_SCALE * 1.4426950408889634f; }
            else if (G64 == 8) { boff = R_KB; S2 = 64; S1 = 32 * 64; }
            else if (G64 == 9) { boff = R_VB; S2 = 64; S1 = 32 * 64; }
            else if (G64 < 14) { boff = R_QI + (size_t)(G64 - 10) * 4096; S2 = 8; S1 = 32 * 256; loff = (w0 >> 3) * 256; }
            else if (G64 == 14) { boff = R_KI; S2 = 8; S1 = 32 * 64; loff = (w0 >> 3) * 256; }
            else if (G64 == 15) { boff = R_WI; S2 = 8; S1 = 32 * 8; scl = IDX_SCALE; loff = 0; }
            else { boff = R_UG + (size_t)((C0 - 1024) >> 4) * ((size_t)NCHK * KSS * 2); S2 = 16; S1 = KSS; loff = (fq >> 1) * (NCHK * KSS) + 8 * (fq & 1); }
            bf16* const dst = (bf16*)(ws + boff) + loff;
            const float* const rope = (const float*)(ws + WS_ROPE);
            const float sg = (fq == 0) ? -1.f : 1.f;
#pragma unroll
            for (int ai = 0; ai < 2; ++ai)
#pragma unroll
                for (int m = 0; m < 4; ++m) {
                    const int row = row0 + ai * 128 + m * 16;
                    float v[8];
#pragma unroll
                    for (int n = 0; n < 2; ++n)
#pragma unroll
                        for (int e = 0; e < 4; ++e) v[4 * n + e] = (bj == 0) ? acc[ai][0][m][n][e] : acc[ai][1][m][n][e];
                    if (do_rope) {
                        const f32x4 c0 = *(const f32x4*)(rope + (size_t)row * 16), c1 = *(const f32x4*)(rope + (size_t)row * 16 + 4);
                        const f32x4 s0 = *(const f32x4*)(rope + (size_t)row * 16 + 8), s1 = *(const f32x4*)(rope + (size_t)row * 16 + 12);
                        const float cs[8] = {c0[0], c0[1], c0[2], c0[3], c1[0], c1[1], c1[2], c1[3]}, sn[8] = {s0[0], s0[1], s0[2], s0[3], s1[0], s1[1], s1[2], s1[3]};
#pragma unroll
                        for (int i = 0; i < 8; ++i) { const float pr = __shfl_xor(v[i], 16); const float r = v[i] * cs[i] + sg * pr * sn[i]; v[i] = (fq < 2) ? r : v[i]; }
                    }
#pragma unroll
                    for (int i = 0; i < 8; ++i) v[i] *= scl;
                    bf16* const p = dst + (size_t)((row >> 5) * S1 + (row & 31) * S2);
                    if (G64 == 15) { if (w0 == 0) *(f32x4*)p = (f32x4){v[0], v[1], v[2], v[3]}; }
                    else { v4u w; w.x = cvt_pk_bf16(v[0], v[1]); w.y = cvt_pk_bf16(v[2], v[3]); w.z = cvt_pk_bf16(v[4], v[5]); w.w = cvt_pk_bf16(v[6], v[7]); *(v4u*)p = w; }
                }
        }
    }
};
struct EpiSsmState {
    static constexpr bool PERM = false;
    float* S;
    __device__ __forceinline__ void operator()(const f32x4 (&acc)[2][2][4][2], const Unit& u, int wr, int wc, int fr, int fq) const {
        const int row0 = u.pm * 256 + wr * 64 + fr, col0 = wc * 32 + 4 * fq;
#pragma unroll
        for (int ai = 0; ai < 2; ++ai)
#pragma unroll
            for (int m = 0; m < 4; ++m)
#pragma unroll
                for (int n = 0; n < 2; ++n) *(f32x4*)(S + (size_t)(row0 + ai * 128 + m * 16) * 128 + col0 + n * 16) = acc[ai][0][m][n];
    }
};
struct EpiSsmOut {
    static constexpr bool PERM = true;
    bf16* Y;
    __device__ __forceinline__ void operator()(const f32x4 (&acc)[2][2][4][2], const Unit& u, int wr, int wc, int fr, int fq) const {
        const int row0 = u.pm * 256 + wr * 64 + fr, col0 = u.pn * 256 + wc * 32 + 8 * fq;
#pragma unroll
        for (int ai = 0; ai < 2; ++ai)
#pragma unroll
            for (int m = 0; m < 4; ++m)
#pragma unroll
                for (int bj = 0; bj < 2; ++bj) {
                    float o[8];
#pragma unroll
                    for (int n = 0; n < 2; ++n)
#pragma unroll
                        for (int e = 0; e < 4; ++e) o[4 * n + e] = gelu_tanh(acc[ai][bj][m][n][e]);
                    v4u w; w.x = cvt_pk_bf16(o[0], o[1]); w.y = cvt_pk_bf16(o[2], o[3]); w.z = cvt_pk_bf16(o[4], o[5]); w.w = cvt_pk_bf16(o[6], o[7]);
                    *(v4u*)(Y + (size_t)(row0 + ai * 128 + m * 16) * KT + col0 + bj * 128) = w;
                }
    }
};
struct EpiGlu {
    static constexpr bool PERM = true;
    const bf16* YG; bf16* Y2; const float* gb;
    __device__ __forceinline__ void operator()(const f32x4 (&acc)[2][2][4][2], const Unit& u, int wr, int wc, int fr, int fq) const {
        const int row0 = u.pm * 256 + wr * 64 + fr, col0 = u.pn * 256 + wc * 32 + 8 * fq;
#pragma unroll
        for (int bj = 0; bj < 2; ++bj) {
            const int col = col0 + bj * 128, gg = col >> 4, cc = col & 15;
            const f32x4 b0 = *(const f32x4*)(gb + col), b1 = *(const f32x4*)(gb + col + 4);
            const float bb[8] = {b0[0], b0[1], b0[2], b0[3], b1[0], b1[1], b1[2], b1[3]};
#pragma unroll
            for (int ai = 0; ai < 2; ++ai)
#pragma unroll
                for (int m = 0; m < 4; ++m) {
                    const int row = row0 + ai * 128 + m * 16;
                    const v4u yv = *(const v4u*)(YG + ((size_t)(gg * NCHK + (row >> 5))) * KT + (row & 31) * 16 + cc);
                    const float y[8] = {bflo(yv.x), bfhi(yv.x), bflo(yv.y), bfhi(yv.y), bflo(yv.z), bfhi(yv.z), bflo(yv.w), bfhi(yv.w)};
                    float o[8];
#pragma unroll
                    for (int n = 0; n < 2; ++n)
#pragma unroll
                        for (int e = 0; e < 4; ++e) o[4 * n + e] = y[4 * n + e] * sigmoidf_(acc[ai][bj][m][n][e] + bb[4 * n + e]);
                    v4u w; w.x = cvt_pk_bf16(o[0], o[1]); w.y = cvt_pk_bf16(o[2], o[3]); w.z = cvt_pk_bf16(o[4], o[5]); w.w = cvt_pk_bf16(o[6], o[7]);
                    *(v4u*)(Y2 + (size_t)row * SSM_W + col) = w;
                }
        }
    }
};

__device__ __forceinline__ void transpose_tile(const float* colp, int srcN, int k0, bf16* WT, int Kd, int n0, LAS float* scr, int lane) {
    float tv[32];
#pragma unroll
    for (int i = 0; i < 32; ++i) { const int kk = 2 * i + (lane >> 5); tv[i] = colp ? colp[(size_t)(k0 + kk) * srcN] : 0.f; }
#pragma unroll
    for (int i = 0; i < 32; ++i) { const int kk = 2 * i + (lane >> 5); scr[kk * 33 + (lane & 31)] = tv[i]; }
    LDS_WAIT(); asm volatile("" ::: "memory");
    const int c = lane & 7;
#pragma unroll
    for (int j = 0; j < 4; ++j) { const int n = (lane >> 3) + 8 * j; const LAS float* s = scr + (8 * c) * 33 + n;
        v4u o; o.x = pk2(s[0 * 33], s[1 * 33]); o.y = pk2(s[2 * 33], s[3 * 33]); o.z = pk2(s[4 * 33], s[5 * 33]); o.w = pk2(s[6 * 33], s[7 * 33]);
        *(v4u*)(WT + (size_t)(n0 + n) * Kd + k0 + 8 * c) = o; }
    LDS_WAIT(); asm volatile("" ::: "memory");
}
__device__ __forceinline__ void transpose_tile_f8(const float* colp, int srcN, int k0, unsigned char* WT, int Kd, int n0, LAS float* scr, int lane) {
    float tv[32];
#pragma unroll
    for (int i = 0; i < 32; ++i) { const int kk = 2 * i + (lane >> 5); tv[i] = colp ? colp[(size_t)(k0 + kk) * srcN] : 0.f; }
#pragma unroll
    for (int i = 0; i < 32; ++i) { const int kk = 2 * i + (lane >> 5); scr[kk * 33 + (lane & 31)] = tv[i]; }
    LDS_WAIT(); asm volatile("" ::: "memory");
#pragma unroll
    for (int j = 0; j < 2; ++j) { const int p = lane + 64 * j, n = p >> 2, kc = p & 3; const LAS float* sp = scr + (16 * kc) * 33 + n;
        v4u o;
        o.x = pk8(sp[0 * 33] * 32.f, sp[1 * 33] * 32.f, sp[2 * 33] * 32.f, sp[3 * 33] * 32.f); o.y = pk8(sp[4 * 33] * 32.f, sp[5 * 33] * 32.f, sp[6 * 33] * 32.f, sp[7 * 33] * 32.f);
        o.z = pk8(sp[8 * 33] * 32.f, sp[9 * 33] * 32.f, sp[10 * 33] * 32.f, sp[11 * 33] * 32.f); o.w = pk8(sp[12 * 33] * 32.f, sp[13 * 33] * 32.f, sp[14 * 33] * 32.f, sp[15 * 33] * 32.f);
        *(v4u*)(WT + (size_t)(n0 + n) * Kd + k0 + 16 * kc) = o; }
    LDS_WAIT(); asm volatile("" ::: "memory");
}
constexpr int IT_W13 = 16 * 176, IT_W2 = 44 * 32, IT_WIN = 16 * 48, IT_WOUT = 16 * 32, IT_GLU = 8 * 16;
constexpr int IT_LAYER = 2 * IT_W13 + 2 * IT_W2 + IT_WIN + IT_WOUT + IT_GLU, IT_ALL = DEPTH * IT_LAYER;
__device__ __forceinline__ void wt_item(const CArgs* ap, unsigned char* ws, int item, LAS float* scr, int lane) {
    const int l = item / IT_LAYER; int r = item % IT_LAYER; const int nl = lane & 31;
    if (r < 2 * IT_W13) { const int f = r / IT_W13; r -= f * IT_W13; const int kb = r / 176, nb = r % 176, np = 32 * nb + nl;
        const float* w = (const float*)ap->in[((np >> 7) & 1) ? (f ? 10 : 7) : (f ? 9 : 6)] + (size_t)l * DM * DFF + 128 * (np >> 8) + (np & 127);
        transpose_tile_f8(w, DFF, 64 * kb, ws + WS_W13 + (size_t)(l * 2 + f) * NFF1 * DM, DM, 32 * nb, scr, lane); return; }
    r -= 2 * IT_W13;
    if (r < 2 * IT_W2) { const int f = r / IT_W2; r -= f * IT_W2; const int kb = r / 32, nb = r % 32;
        const float* w = (const float*)ap->in[f ? 11 : 8] + (size_t)l * DFF * DM + 32 * nb + nl;
        transpose_tile_f8(w, DM, 64 * kb, ws + WS_W2 + (size_t)(l * 2 + f) * DM * DFF, DFF, 32 * nb, scr, lane); return; }
    r -= 2 * IT_W2;
    if (r < IT_WIN) { const int kb = r / 48, nb = r % 48, np = 32 * nb + nl;
        const int col = (np < 964) ? np : (np < 1024 ? -1 : np - 60);
        const float* w = (col >= 0) ? (const float*)ap->in[12] + (size_t)l * DM * INC + col : nullptr;
        transpose_tile(w, INC, 64 * kb, (bf16*)(ws + WS_WIN) + (size_t)l * NWIN * DM, DM, 32 * nb, scr, lane); return; }
    r -= IT_WIN;
    if (r < IT_WOUT) { const int kb = r / 32, nb = r % 32;
        const float* w = (const float*)ap->in[13] + (size_t)l * DM * DM + 32 * nb + nl;
        transpose_tile(w, DM, 64 * kb, (bf16*)(ws + WS_WOUT) + (size_t)l * DM * DM, DM, 32 * nb, scr, lane); return; }
    r -= IT_WOUT;
    { const int kb = r / 16, nb = r % 16;
        const float* w = (const float*)ap->in[24] + (size_t)l * SSM_W * SSM_W + 32 * nb + nl;
        transpose_tile(w, SSM_W, 64 * kb, (bf16*)(ws + WS_GLU) + (size_t)l * SSM_W * SSM_W, SSM_W, 32 * nb, scr, lane); }
}
__device__ __forceinline__ void mod_item(const CArgs* ap, Frame& F, int item, const LAS float* sc  , LAS float* red  ) {
    const int l = item / 144, n0 = (item % 144) * 64;
    const float* W = (const float*)ap->in[3] + ((size_t)l * DM + F.wave * 128) * (NMOD * DM) + n0 + F.lane;
    asm volatile("" : "+v"(W));
    float acc0 = 0.f, acc1 = 0.f, acc2 = 0.f, acc3 = 0.f;
#pragma unroll 1
    for (int k = 0; k < 128; k += 32) {
        float w[32];
#pragma unroll
        for (int j = 0; j < 32; ++j) { w[j] = *(const GAS float*)W; W += NMOD * DM; }
#pragma unroll
        for (int j = 0; j < 32; ++j) { const int kk = (F.tid >> 6) * 128 + k + j; acc0 += sc[kk] * w[j]; acc1 += sc[1024 + kk] * w[j]; acc2 += sc[2048 + kk] * w[j]; acc3 += sc[3072 + kk] * w[j]; }
    }
    red[(F.wave * 4 + 0) * 64 + F.lane] = acc0; red[(F.wave * 4 + 1) * 64 + F.lane] = acc1; red[(F.wave * 4 + 2) * 64 + F.lane] = acc2; red[(F.wave * 4 + 3) * 64 + F.lane] = acc3;
    __syncthreads();
    if (F.tid < 256) { const int b = F.tid >> 6, ln = F.tid & 63; float s = ((const float*)ap->in[4])[(size_t)l * NMOD * DM + n0 + ln];
#pragma unroll
        for (int w = 0; w < 8; ++w) s += red[(w * 4 + b) * 64 + ln];
        ((float*)(F.ws + WS_MOD))[((size_t)l * NB + b) * (NMOD * DM) + n0 + ln] = s; }
    __syncthreads();
}
__device__ __forceinline__ void ssm_pre_item(const CArgs* ap, Frame& F, int item) {
    const int l = item >> 5, g = item & 31; int tid = F.tid; asm volatile("" : "+v"(tid)); __builtin_assume(tid >= 0 && tid < 512);
    LAS float* Ere = (LAS float*)F.lds;
    LAS float* Eim = Ere + 33 * 64;
    LAS float* Bre = Eim + 33 * 64;
    LAS float* Bim = Bre + 1024;
    LAS float* Cre = Bim + 1024;
    LAS float* Cim = Cre + 1024;
    LAS float* Kk = Cim + 1024;
    LAS float* Dd = Kk + 8192;
    asm volatile("" : "+s"(ap));
    const float* a_re = (const float*)ap->in[16] + (size_t)(l * SG + g) * SP; const float* a_im = (const float*)ap->in[17] + (size_t)(l * SG + g) * SP;
    asm volatile("" : "+v"(a_re), "+v"(a_im));
    const float dt = __expf(((const float*)ap->in[18])[l * SG + g]);
    const double INV2PI = 0.15915494309189533576888;
    for (int idx = tid; idx < 33 * 64; idx += 512) { const int k = idx >> 6, p = idx & 63;
        const float mag = __expf(a_re[p] * dt * (float)k);
        const double rev = (double)a_im[p] * (double)dt * (double)k * INV2PI; const float fr = (float)(rev - __builtin_rint(rev));
        Ere[idx] = mag * __builtin_amdgcn_cosf(fr); Eim[idx] = mag * __builtin_amdgcn_sinf(fr); }
    asm volatile("" : "+s"(ap));
    for (int idx = tid; idx < 1024; idx += 512) { Cre[idx] = ((const float*)ap->in[21])[(size_t)(l * SG + g) * 1024 + idx]; Cim[idx] = ((const float*)ap->in[22])[(size_t)(l * SG + g) * 1024 + idx]; }
    if (tid < 16) Dd[tid] = ((const float*)ap->in[23])[(l * SG + g) * GC + tid];
    __syncthreads();
    asm volatile("" : "+s"(ap));
    for (int idx = tid; idx < 1024; idx += 512) { const int p = idx >> 4;
        const double ar = a_re[p], ai = a_im[p], zr = ar * dt, zi = ai * dt; double qr, qi;
        if (zr * zr + zi * zi < 0.25) {
            double tr = 1.0, ti = 0.0, sr = 1.0, si = 0.0;
#pragma unroll 1
            for (int n = 2; n <= 14; ++n) { const double nr = (tr * zr - ti * zi) / n, ni = (tr * zi + ti * zr) / n; tr = nr; ti = ni; sr += tr; si += ti; }
            qr = sr * dt; qi = si * dt;
        } else { const double nr = (double)Ere[64 + p] - 1.0, ni = (double)Eim[64 + p], den = ar * ar + ai * ai; qr = (nr * ar + ni * ai) / den; qi = (ni * ar - nr * ai) / den; }
        const double br = ((const float*)ap->in[19])[(size_t)(l * SG + g) * 1024 + idx], bi = ((const float*)ap->in[20])[(size_t)(l * SG + g) * 1024 + idx];
        Bre[idx] = (float)(qr * br - qi * bi); Bim[idx] = (float)(qr * bi + qi * br); }
    __syncthreads();
    for (int idx = tid; idx < 8192; idx += 512) { const int cp = idx & 15, c = (idx >> 4) & 15, tau = idx >> 8; float s = 0.f;
        for (int p = 0; p < 64; ++p) { const float cr = Cre[c * 64 + p], ci = Cim[c * 64 + p], er = Ere[tau * 64 + p], ei = Eim[tau * 64 + p];
            const float xr = cr * er - ci * ei, xi = cr * ei + ci * er; s += xr * Bre[p * 16 + cp] - xi * Bim[p * 16 + cp]; }
        Kk[idx] = s; }
    __syncthreads();
    bf16* TV = (bf16*)(F.ws + WS_BTV) + ((size_t)(l * SG + g) * KT) * KSS;
    for (int idx = tid; idx < 512 * 80; idx += 512) { const int n = idx / 80, k8 = idx % 80, i = n >> 4, c = n & 15; float v[8];
        if (k8 < 64) { const int ip = k8 >> 1, c0 = (k8 & 1) * 8;
#pragma unroll
            for (int e = 0; e < 8; ++e) { float x = 0.f; if (ip <= i) { x = Kk[((i - ip) * 16 + c) * 16 + c0 + e]; if (ip == i && c == c0 + e) x += Dd[c]; } v[e] = x; }
        } else { const int p0 = (k8 - 64) * 8;
#pragma unroll
            for (int e = 0; e < 8; ++e) { const int pp = p0 + e, p = pp & 63; const float cr = Cre[c * 64 + p], ci = Cim[c * 64 + p], er = Ere[(i + 1) * 64 + p], ei = Eim[(i + 1) * 64 + p];
                v[e] = (pp < 64) ? (cr * er - ci * ei) : -(cr * ei + ci * er); } }
        v4u o; o.x = pk2(v[0], v[1]); o.y = pk2(v[2], v[3]); o.z = pk2(v[4], v[5]); o.w = pk2(v[6], v[7]);
        *(v4u*)(TV + (size_t)n * KSS + k8 * 8) = o; }
    bf16* WW = (bf16*)(F.ws + WS_BW) + ((size_t)(l * SG + g) * 128) * KT;
    for (int idx = tid; idx < 128 * 64; idx += 512) { const int n = idx >> 6, k8 = idx & 63, p = n & 63, ip = k8 >> 1, c0 = (k8 & 1) * 8; float v[8];
        const float er = Ere[(31 - ip) * 64 + p], ei = Eim[(31 - ip) * 64 + p];
#pragma unroll
        for (int e = 0; e < 8; ++e) { const float br = Bre[p * 16 + c0 + e], bi = Bim[p * 16 + c0 + e]; v[e] = (n < 64) ? (er * br - ei * bi) : (er * bi + ei * br); }
        v4u o; o.x = pk2(v[0], v[1]); o.y = pk2(v[2], v[3]); o.z = pk2(v[4], v[5]); o.w = pk2(v[6], v[7]);
        *(v4u*)(WW + (size_t)n * KT + k8 * 8) = o; }
    if (tid < 64) { float* al = (float*)(F.ws + WS_AL) + ((size_t)(l * SG + g) * SP + tid) * 2; al[0] = Ere[32 * 64 + tid]; al[1] = Eim[32 * 64 + tid]; }
    __syncthreads();
}
__device__ __forceinline__ void pro_ssm(const CArgs* ap, Frame& F) {
    for (int it = F.vcu; it < DEPTH * SG; it += F.G) ssm_pre_item(ap, F, it);
    if (F.vcu == F.G - 1) { bf16* pad = (bf16*)(F.ws + WS_BW) + (size_t)DEPTH * SG * 128 * KT; for (int i = F.tid; i < 128 * KT / 8; i += 512) ((v4u*)pad)[i] = (v4u){0u, 0u, 0u, 0u}; }
}
__device__ __forceinline__ void pro_mod(const CArgs* ap, Frame& F) {
    LAS float* sc = (LAS float*)F.lds; LAS float* red = sc + 4096;
    for (int i = F.tid; i < NB * DM; i += 512) { const float x = ((const float*)ap->in[1])[i]; sc[i] = x * sigmoidf_(x); }
    __syncthreads();
    if (F.G == 256) { for (int it = F.vcu; it < 512; it += 256) mod_item(ap, F, it, sc, red); if (F.vcu >= 192) mod_item(ap, F, 512 + F.vcu - 192, sc, red); }
    else
    for (int it = F.vcu; it < DEPTH * 144; it += F.G) mod_item(ap, F, it, sc, red);
    __syncthreads();
}
__device__ __forceinline__ void pro_wt(const CArgs* ap, Frame& F) {
    LAS float* scr = (LAS float*)(F.lds + F.wave * 16384); const int gw = F.vcu * 8 + F.wave, NGW = F.G * 8;
    if (F.G == 256) {
        for (int i = 0; i < 16; ++i) wt_item(ap, F.ws, gw + 2048 * i, scr, F.lane);
        if (F.vcu >= 128) for (int it = 32768 + (F.vcu - 128) * 8 + F.wave; it < IT_ALL; it += 1024) wt_item(ap, F.ws, it, scr, F.lane);
    } else
    for (int it = gw; it < IT_ALL; it += NGW) wt_item(ap, F.ws, it, scr, F.lane);
}
__device__ __forceinline__ void pro_rope(const CArgs* ap, Frame& F) {
    const float invf[8] = {1.0f, 0.193922758102417f, 0.03760603070259094f, 0.00729266507551074f, 0.001414213445968926f, 0.00027424818836152554f, 5.318296462064609e-05f, 1.0313385246263351e-05f};
    const double INV2PI = 0.15915494309189533576888;
    float* rp = (float*)(F.ws + WS_ROPE); const int* pos = (const int*)ap->in[2];
    for (int idx = F.vcu * 512 + F.tid; idx < MTOK * 8; idx += F.G * 512) { const int r = idx >> 3, i = idx & 7; float f = invf[0];
#pragma unroll
        for (int j = 1; j < 8; ++j) f = (i == j) ? invf[j] : f;
        const float ang = (float)pos[r] * f; const double rev = (double)ang * INV2PI; const float fr = (float)(rev - __builtin_rint(rev));
        rp[(size_t)r * 16 + i] = __builtin_amdgcn_cosf(fr); rp[(size_t)r * 16 + 8 + i] = __builtin_amdgcn_sinf(fr); }
}

template <bool XBF> __device__ __forceinline__ int norm_col(int lane, int q) { return XBF ? 8 * lane + 512 * (q >> 1) + 4 * (q & 1) : 4 * lane + 256 * q; }
template <bool XBF> __device__ __forceinline__ void norm_load(const void* x, int r, int lane, f32x4 (&v)[4]) {
    if constexpr (XBF) { const v4u* xr = (const v4u*)((const bf16*)x + (size_t)r * DM) + lane;
#pragma unroll
        for (int j = 0; j < 2; ++j) { const v4u q = xr[64 * j]; v[2 * j] = (f32x4){bflo(q.x), bfhi(q.x), bflo(q.y), bfhi(q.y)}; v[2 * j + 1] = (f32x4){bflo(q.z), bfhi(q.z), bflo(q.w), bfhi(q.w)}; }
    } else { const f32x4* xr = (const f32x4*)((const float*)x + (size_t)r * DM) + lane;
#pragma unroll
        for (int j = 0; j < 4; ++j) v[j] = xr[64 * j]; }
}
template <bool F8OUT, bool XBF> __device__ __forceinline__ void norm_mod_phase(Frame& F, const void* x, const float* g, const float* modl  , int ksh, bf16* H, bf16* XB) {
    const int gw = F.vcu * 8 + F.wave, NGW = F.G * 8, rpw = (MTOK + NGW - 1) / NGW;
    int r0 = gw * rpw, r1 = r0 + rpw; if (r1 > MTOK) r1 = MTOK;
    f32x4 gs[4], sh[4]; int curb = -1;
    for (int r = r0; r < r1; ++r) {
        const int b = r >> 13;
        if (b != curb) { curb = b; const float* sp = modl + (size_t)b * (NMOD * DM) + (size_t)ksh * DM;
#pragma unroll
            for (int j = 0; j < 4; ++j) { const int c = norm_col<XBF>(F.lane, j); const f32x4 gg = *(const f32x4*)(g + c), sc = *(const f32x4*)(sp + DM + c); gs[j] = gg * (sc + 1.0f); sh[j] = *(const f32x4*)(sp + c); } }
        f32x4 v[4]; float s = 0.f;
        norm_load<XBF>(x, r, F.lane, v);
#pragma unroll
        for (int j = 0; j < 4; ++j) s += (v[j].x * v[j].x + v[j].y * v[j].y) + (v[j].z * v[j].z + v[j].w * v[j].w);
        const float rs = __builtin_amdgcn_rsqf(wave_sum(s) * (1.f / DM) + EPS);
        if constexpr (!XBF) { unsigned long long* o8 = (unsigned long long*)(XB + (size_t)r * DM) + F.lane;
#pragma unroll
            for (int j = 0; j < 4; ++j) o8[64 * j] = (unsigned long long)pk2(v[j].x, v[j].y) | ((unsigned long long)pk2(v[j].z, v[j].w) << 32); }
        f32x4 y[4];
#pragma unroll
        for (int j = 0; j < 4; ++j) y[j] = v[j] * rs * gs[j] + sh[j];
        if constexpr (F8OUT) {
            if constexpr (XBF) { unsigned long long* o8 = (unsigned long long*)((unsigned char*)H + (size_t)r * DM) + F.lane;
#pragma unroll
                for (int j = 0; j < 2; ++j) { const f32x4 a = y[2 * j] * 2.0f, c = y[2 * j + 1] * 2.0f; o8[64 * j] = (unsigned long long)pk8(a.x, a.y, a.z, a.w) | ((unsigned long long)pk8(c.x, c.y, c.z, c.w) << 32); }
            } else { unsigned* o4 = (unsigned*)((unsigned char*)H + (size_t)r * DM) + F.lane;
#pragma unroll
                for (int j = 0; j < 4; ++j) { const f32x4 a = y[j] * 2.0f; o4[64 * j] = pk8(a.x, a.y, a.z, a.w); } }
        } else {
            static_assert(XBF || F8OUT, "the f32 input only feeds the first FFN norm");
            v4u* o16 = (v4u*)(H + (size_t)r * DM) + F.lane;
#pragma unroll
            for (int j = 0; j < 2; ++j) { v4u o; o.x = pk2(y[2 * j].x, y[2 * j].y); o.y = pk2(y[2 * j].z, y[2 * j].w); o.z = pk2(y[2 * j + 1].x, y[2 * j + 1].y); o.w = pk2(y[2 * j + 1].z, y[2 * j + 1].w); o16[64 * j] = o; }
        }
    }
}
__device__ __forceinline__ void final_norm_phase(Frame& F, const bf16* x, const float* g, float* out) {
    const int gw = F.vcu * 8 + F.wave, NGW = F.G * 8;
    f32x4 gs[4];
#pragma unroll
    for (int j = 0; j < 4; ++j) gs[j] = *(const f32x4*)(g + norm_col<true>(F.lane, j));
    for (int r = gw; r < MTOK; r += NGW) {
        f32x4 v[4]; float s = 0.f;
        norm_load<true>(x, r, F.lane, v);
#pragma unroll
        for (int j = 0; j < 4; ++j) s += (v[j].x * v[j].x + v[j].y * v[j].y) + (v[j].z * v[j].z + v[j].w * v[j].w);
        const float rs = __builtin_amdgcn_rsqf(wave_sum(s) * (1.f / DM) + EPS);
#pragma unroll
        for (int j = 0; j < 4; ++j) *(f32x4*)(out + (size_t)r * DM + norm_col<true>(F.lane, j)) = v[j] * rs * gs[j];
    }
}
__device__ __forceinline__ void ssm_norm_phase(Frame& F, const bf16* Y2, const float* gain, bf16* MIX) {
    const int gw = F.vcu * 8 + F.wave, NGW = F.G * 8;
    const f32x4 g0 = *(const f32x4*)(gain + 8 * F.lane), g1 = *(const f32x4*)(gain + 8 * F.lane + 4);
    for (int r = gw; r < MTOK; r += NGW) {
        const v4u yv = *((const v4u*)(Y2 + (size_t)r * SSM_W) + F.lane);
        float y[8] = {bflo(yv.x), bfhi(yv.x), bflo(yv.y), bfhi(yv.y), bflo(yv.z), bfhi(yv.z), bflo(yv.w), bfhi(yv.w)};
        float s = 0.f;
#pragma unroll
        for (int e = 0; e < 8; ++e) s += y[e] * y[e];
        const float rs = __builtin_amdgcn_rsqf(wave_sum(s) * (1.f / SSM_W) + EPS);
        v4u w; w.x = pk2(y[0] * rs * g0[0], y[1] * rs * g0[1]); w.y = pk2(y[2] * rs * g0[2], y[3] * rs * g0[3]); w.z = pk2(y[4] * rs * g1[0], y[5] * rs * g1[1]); w.w = pk2(y[6] * rs * g1[2], y[7] * rs * g1[3]);
        *((v4u*)(MIX + (size_t)r * DM + ATTN_W) + F.lane) = w;
    }
}
__device__ __forceinline__ void ssm_scan_phase(Frame& F, const float* AL  , const float* SINC, bf16* UG) {
    if (F.wave != 0) return;
    for (int it = F.vcu; it < NB * SG; it += F.G) {
        const int b = it >> 5, g = it & 31, p = F.lane;
        const float ar = AL[(g * SP + p) * 2], ai = AL[(g * SP + p) * 2 + 1];
        const size_t row0 = (size_t)g * NCHK + (size_t)b * CHB;
        const float* sp = SINC + row0 * 128 + p; bf16* hp = UG + row0 * KSS + KT + p;
        float hr = 0.f, hi = 0.f;
        float sr[16], si[16];
#pragma unroll
        for (int j = 0; j < 16; ++j) { sr[j] = sp[(size_t)j * 128]; si[j] = sp[(size_t)j * 128 + 64]; }
#pragma unroll 1
        for (int j0 = 0; j0 < CHB; j0 += 16) {
            float nr_[16], ni_[16];
            if (j0 + 16 < CHB) {
#pragma unroll
                for (int j = 0; j < 16; ++j) { nr_[j] = sp[(size_t)(j0 + 16 + j) * 128]; ni_[j] = sp[(size_t)(j0 + 16 + j) * 128 + 64]; } }
#pragma unroll
            for (int j = 0; j < 16; ++j) {
                hp[(size_t)(j0 + j) * KSS] = (bf16)f2bf(hr); hp[(size_t)(j0 + j) * KSS + 64] = (bf16)f2bf(hi);
                const float nr = ar * hr - ai * hi + sr[j], ni = ar * hi + ai * hr + si[j]; hr = nr; hi = ni;
            }
            if (j0 + 16 < CHB) {
#pragma unroll
                for (int j = 0; j < 16; ++j) { sr[j] = nr_[j]; si[j] = ni_[j]; } }
        }
    }
}

__device__ __forceinline__ unsigned comp_key(float sc, int s) {
    sc = sc + 0.0f; unsigned u = __builtin_bit_cast(unsigned, sc); u = (u & 0x80000000u) ? ~u : (u | 0x80000000u);
    return (u & 0xFFFFE000u) | (unsigned)(8191 - s);
}
#if !ATTN_FAST
__device__ __forceinline__ void attn_simple_phase(Frame& F, const bf16* Q, const bf16* KB, const bf16* VB, const bf16* QI, const bf16* KI, const float* WI, const float* again, bf16* MIX) {
    LAS unsigned* comp = (LAS unsigned*)F.lds;
    LAS float* lg = (LAS float*)(F.lds + 32768);
    LAS float* qs = lg + 2048;
    LAS float* qis = qs + 512;
    LAS float* wis = qis + 256;
    LAS unsigned* hist = (LAS unsigned*)(wis + 8);
    LAS unsigned* sel = hist + 256;
    LAS unsigned* misc = sel + 256;
    LAS float* red = (LAS float*)(misc + 16);
    const int tid = F.tid;
    asm volatile("" : "+v"(Q), "+v"(KB), "+v"(VB), "+v"(QI), "+v"(KI), "+v"(WI), "+v"(again), "+v"(MIX));
#pragma unroll 1
    for (int r = F.vcu; r < MTOK; r += F.G) {
        const int b = r >> 13, t = r & 8191, n = ((t >> 6) + 1) << 6;
        qs[tid] = bf2f(Q[(size_t)r * ATTN_W + tid]);
        if (tid < 256) qis[tid] = bf2f(QI[(size_t)r * 256 + tid]);
        if (tid < 4) wis[tid] = WI[(size_t)r * 4 + tid];
        __syncthreads();
#pragma unroll 1
        for (int s0 = 0; s0 < n; s0 += 512) {
            const int s = s0 + tid; if (s >= n) continue;
            const v4u* kp = (const v4u*)(KI + (size_t)(b * SEQ + s) * 64);
            float a0 = 0.f, a1 = 0.f, a2 = 0.f, a3 = 0.f;
#pragma unroll 1
            for (int j = 0; j < 8; ++j) { const v4u kv = kp[j]; const float kf[8] = {bflo(kv.x), bfhi(kv.x), bflo(kv.y), bfhi(kv.y), bflo(kv.z), bfhi(kv.z), bflo(kv.w), bfhi(kv.w)};
#pragma unroll
                for (int e = 0; e < 8; ++e) { const int d = 8 * j + e; a0 += qis[d] * kf[e]; a1 += qis[64 + d] * kf[e]; a2 += qis[128 + d] * kf[e]; a3 += qis[192 + d] * kf[e]; } }
            const float sc = wis[0] * fmaxf(a0, 0.f) + wis[1] * fmaxf(a1, 0.f) + wis[2] * fmaxf(a2, 0.f) + wis[3] * fmaxf(a3, 0.f);
            comp[s] = comp_key(sc, s);
        }
        __syncthreads();
        int nsel;
        if (n > TOPK) {
            unsigned prefix = 0u, kneed = TOPK;
#pragma unroll 1
            for (int round = 0; round < 4; ++round) {
                const int shift = 24 - 8 * round;
                if (tid < 256) hist[tid] = 0u;
                __syncthreads();
#pragma unroll 1
                for (int s0 = 0; s0 < n; s0 += 512) { const int s = s0 + tid; const unsigned c = (s < n) ? comp[s] : 0u; const bool match = (s < n) && ((round == 0) || ((c >> (shift + 8)) == prefix));
                    if (match) __hip_atomic_fetch_add(&hist[(c >> shift) & 255u], 1u, __ATOMIC_RELAXED, __HIP_MEMORY_SCOPE_WORKGROUP); }
                __syncthreads();
                if (tid < 64) {
                    const unsigned h0 = hist[4 * tid], h1 = hist[4 * tid + 1], h2 = hist[4 * tid + 2], h3 = hist[4 * tid + 3], tot = h0 + h1 + h2 + h3;
                    unsigned v = tot;
#pragma unroll
                    for (int o = 1; o < 64; o <<= 1) { const unsigned up = __shfl_down(v, o); if (tid + o < 64) v += up; }
                    const unsigned above = v - tot, c3 = above + h3, c2 = c3 + h2, c1 = c2 + h1, c0 = c1 + h0;
                    const bool f3 = (c3 >= kneed) & (above < kneed), f2 = (c2 >= kneed) & (c3 < kneed), f1 = (c1 >= kneed) & (c2 < kneed), f0 = (c0 >= kneed) & (c1 < kneed);
                    const unsigned dsel = 4u * tid + (f3 ? 3u : f2 ? 2u : f1 ? 1u : 0u), below = f3 ? above : f2 ? c3 : f1 ? c2 : c1;
                    if (f3 | f2 | f1 | f0) { misc[0] = dsel; misc[1] = kneed - below; }
                }
                __syncthreads();
                prefix = (prefix << 8) | misc[0]; kneed = misc[1];
            }
            unsigned base = 0u;
#pragma unroll 1
            for (int s0 = 0; s0 < n; s0 += 512) {
                const int s = s0 + tid; const bool f = (s < n) && (comp[s] >= prefix);
                const unsigned long long bal = __ballot(f);
                if (F.lane == 0) misc[8 + F.wave] = (unsigned)__popcll(bal);
                __syncthreads();
                unsigned off = base, tot = 0u;
#pragma unroll
                for (int w = 0; w < 8; ++w) { const unsigned c = misc[8 + w]; if (w < F.wave) off += c; tot += c; }
                if (f) { const unsigned pos = off + (unsigned)__popcll(bal & ((1ull << F.lane) - 1ull)); if (pos < TOPK) sel[pos] = (unsigned)s; }
                base += tot;
                __syncthreads();
            }
            nsel = TOPK;
        } else { if (tid < n) sel[tid] = (unsigned)tid; nsel = n; }
        __syncthreads();
        {
            const int k = tid & 255, hh = tid >> 8; float a0 = 0.f, a1 = 0.f, a2 = 0.f, a3 = 0.f;
            if (k < nsel) { const v4u* kp = (const v4u*)(KB + (size_t)(b * SEQ + (int)sel[k]) * 64); const LAS float* qh = qs + hh * 256;
#pragma unroll 1
                for (int j = 0; j < 8; ++j) { const v4u kv = kp[j]; const float kf[8] = {bflo(kv.x), bfhi(kv.x), bflo(kv.y), bfhi(kv.y), bflo(kv.z), bfhi(kv.z), bflo(kv.w), bfhi(kv.w)};
#pragma unroll
                    for (int e = 0; e < 8; ++e) { const int d = 8 * j + e; a0 += qh[d] * kf[e]; a1 += qh[64 + d] * kf[e]; a2 += qh[128 + d] * kf[e]; a3 += qh[192 + d] * kf[e]; } } }
            const float ninf = -__builtin_inff(); const bool ok = k < nsel;
            lg[(4 * hh + 0) * 256 + k] = ok ? a0 : ninf; lg[(4 * hh + 1) * 256 + k] = ok ? a1 : ninf; lg[(4 * hh + 2) * 256 + k] = ok ? a2 : ninf; lg[(4 * hh + 3) * 256 + k] = ok ? a3 : ninf;
        }
        __syncthreads();
        {
            LAS float* lh = lg + F.wave * 256; float v0 = lh[F.lane], v1 = lh[F.lane + 64], v2 = lh[F.lane + 128], v3 = lh[F.lane + 192];
            const float mx = wave_max(fmaxf(fmaxf(v0, v1), fmaxf(v2, v3)));
            v0 = __builtin_amdgcn_exp2f(v0 - mx); v1 = __builtin_amdgcn_exp2f(v1 - mx); v2 = __builtin_amdgcn_exp2f(v2 - mx); v3 = __builtin_amdgcn_exp2f(v3 - mx);
            const float inv = 1.0f / wave_sum((v0 + v1) + (v2 + v3));
            lh[F.lane] = v0 * inv; lh[F.lane + 64] = v1 * inv; lh[F.lane + 128] = v2 * inv; lh[F.lane + 192] = v3 * inv;
        }
        __syncthreads();
        {
            const LAS float* ph = lg + F.wave * 256; const bf16* vb = VB + (size_t)b * SEQ * 64 + F.lane; float o = 0.f;
#pragma unroll 2
            for (int k = 0; k < nsel; k += 4) { const float x0 = bf2f(vb[(size_t)sel[k] * 64]), x1 = bf2f(vb[(size_t)sel[k + 1] * 64]), x2 = bf2f(vb[(size_t)sel[k + 2] * 64]), x3 = bf2f(vb[(size_t)sel[k + 3] * 64]);
                o += ph[k] * x0 + ph[k + 1] * x1 + ph[k + 2] * x2 + ph[k + 3] * x3; }
            const float ss = wave_sum(o * o);
            if (F.lane == 0) red[F.wave] = ss;
            __syncthreads();
            float tot = 0.f;
#pragma unroll
            for (int w = 0; w < 8; ++w) tot += red[w];
            const float rs = __builtin_amdgcn_rsqf(tot * (1.f / ATTN_W) + EPS);
            MIX[(size_t)r * DM + tid] = (bf16)f2bf(o * rs * again[tid]);
        }
        __syncthreads();
    }
}
#endif

typedef short bf16x8v __attribute__((ext_vector_type(8)));
typedef short v4i16_t __attribute__((ext_vector_type(4)));
typedef float f32x16 __attribute__((ext_vector_type(16)));
constexpr int AQ = 32, ACAP = 1024, ATRIG = 768;
constexpr int A_CNT = LDSCTL_OFF + 1024, A_THR = A_CNT + 128, A_HIST = LDSCTL_OFF + 2048, A_SEL = LDSCTL_OFF + 10240;
constexpr int A_OK = A_THR + 128;
constexpr int A_DUMP = A_SEL;
constexpr int V_RS = 144;
static_assert(A_SEL + AQ * 256 * 2 <= LDS_BYTES, "attention LDS map");
constexpr float QK_SCALE = 0.125f * 1.4426950408889634f;

__device__ __forceinline__ unsigned ord_of(unsigned c) { const unsigned m = (unsigned)((int)c >> 31); return c ^ ((m & 0x7FFFE000u) | 0x80000000u); }
#define DPPU(old, x, ctrl, rm) ((unsigned)__builtin_amdgcn_update_dpp((int)(old), (int)(x), ctrl, rm, 0xF, false))
__device__ __forceinline__ unsigned wave_scan_add(unsigned x) {
    x += DPPU(0u, x, 0x111, 0xF); x += DPPU(0u, x, 0x112, 0xF); x += DPPU(0u, x, 0x114, 0xF); x += DPPU(0u, x, 0x118, 0xF);
    x += DPPU(0u, x, 0x142, 0xA); x += DPPU(0u, x, 0x143, 0xC); return x; }
__device__ __forceinline__ unsigned wave_red_max(unsigned x) {
    x = max(x, DPPU(0u, x, 0x111, 0xF)); x = max(x, DPPU(0u, x, 0x112, 0xF)); x = max(x, DPPU(0u, x, 0x114, 0xF)); x = max(x, DPPU(0u, x, 0x118, 0xF));
    x = max(x, DPPU(0u, x, 0x142, 0xA)); x = max(x, DPPU(0u, x, 0x143, 0xC)); return (unsigned)__builtin_amdgcn_readlane((int)x, 63); }
__device__ __forceinline__ unsigned wave_red_min(unsigned x) {
    x = min(x, DPPU(~0u, x, 0x111, 0xF)); x = min(x, DPPU(~0u, x, 0x112, 0xF)); x = min(x, DPPU(~0u, x, 0x114, 0xF)); x = min(x, DPPU(~0u, x, 0x118, 0xF));
    x = min(x, DPPU(~0u, x, 0x142, 0xA)); x = min(x, DPPU(~0u, x, 0x143, 0xC)); return (unsigned)__builtin_amdgcn_readlane((int)x, 63); }
__device__ __forceinline__ unsigned append_step(unsigned& mask, unsigned& slot, const unsigned target, const unsigned dumpa) {
    unsigned a = target; unsigned long long cdummy;
    asm volatile("v_add_co_u32 %0, vcc, %0, %0\n\tv_cndmask_b32 %2, %4, %2, vcc\n\tv_addc_co_u32 %1, %3, 0, %1, vcc" : "+v"(mask), "+v"(slot), "+v"(a), "=&s"(cdummy) : "v"(dumpa) : "vcc");
    return a;
}
__device__ __forceinline__ unsigned lane_count_ge(const unsigned (&o)[16], const unsigned mid) {
    unsigned c0 = 0u, c1 = 0u, c2 = 0u, c3 = 0u;
#pragma unroll
    for (int j = 0; j < 16; j += 4) { unsigned long long m0, m1, m2, m3, d0, d1, d2, d3;
        asm volatile("v_cmp_le_u32 %4, %12, %13\n\tv_cmp_le_u32 %5, %12, %14\n\tv_cmp_le_u32 %6, %12, %15\n\tv_cmp_le_u32 %7, %12, %16\n\t"
                     "v_addc_co_u32 %0, %8, 0, %0, %4\n\tv_addc_co_u32 %1, %9, 0, %1, %5\n\tv_addc_co_u32 %2, %10, 0, %2, %6\n\tv_addc_co_u32 %3, %11, 0, %3, %7"
                     : "+v"(c0), "+v"(c1), "+v"(c2), "+v"(c3), "=&s"(m0), "=&s"(m1), "=&s"(m2), "=&s"(m3), "=&s"(d0), "=&s"(d1), "=&s"(d2), "=&s"(d3)
                     : "s"(mid), "v"(o[j]), "v"(o[j + 1]), "v"(o[j + 2]), "v"(o[j + 3])); }
    return (c0 + c1) + (c2 + c3);
}
template <int MODE, unsigned KTH_> __device__ __forceinline__ void wave_select(LAS unsigned* cand, LAS unsigned* cntp, LAS float* thrp, LAS unsigned* H, unsigned short* selq, const int lane, const int qx, const unsigned kth_rt = KTH_, const unsigned kmax_rt = 384u) {
    const unsigned KTH = (MODE == 0) ? kth_rt : KTH_, KMAX = (MODE == 0) ? kmax_rt : (MODE == 1) ? KTH_ : KTH_ + 16u;
    const int m = __builtin_amdgcn_readfirstlane((int)*cntp);
    unsigned e[16], o[16]; unsigned mx = 0u, mn = ~0u;
    const int qlo = qx & 3, qhi = qx & ~3;
#pragma unroll
    for (int j = 0; j < 4; ++j) { const int i0 = 4 * (lane + 64 * j), sb = i0 ^ qhi; v4u q = (v4u){0u, 0u, 0u, 0u}; if (256 * j < m) q = *(LAS v4u*)(cand + i0);
#pragma unroll
        for (int k = 0; k < 4; ++k) { const bool v = sb < m - (k ^ qlo); e[4 * j + k] = q[k]; const unsigned ok = ord_of(q[k]); o[4 * j + k] = v ? ok : 0u; mx = max(mx, v ? ok : 0u); mn = min(mn, v ? ok : ~0u); } }
    mx = wave_red_max(mx); mn = wave_red_min(mn);
    unsigned lo = mn, hi = mx + 1u, T = mn;
    bool done = false;
    if (MODE == 1 && (unsigned)m > KMAX) {
        unsigned slo = mn >> 13, shi = (mx >> 13) + 1u, clo = (unsigned)m, chi = 0u;
#pragma unroll 1
        while (shi - slo > 1u) {
            const unsigned smid = slo + ((shi - slo) >> 1), mid = smid << 13;
            unsigned cl = 0u;
            cl = lane_count_ge(o, mid);
            const unsigned c = (unsigned)__builtin_amdgcn_readlane((int)wave_scan_add(cl), 63);
            if (c >= KTH) { slo = smid; clo = c; } else { shi = smid; chi = c; }
        }
        lo = slo << 13; hi = shi << 13;
        if (clo == KTH) { T = lo; done = true; }
        else if (KTH - chi <= 4u) {
            unsigned Tc = hi;
#pragma unroll 1
            for (unsigned i = chi; i < KTH; ++i) { unsigned bm = 0u;
#pragma unroll
                for (int j = 0; j < 16; ++j) { const unsigned v = (o[j] >= lo && o[j] < Tc) ? o[j] : 0u; bm = max(bm, v); }
                Tc = wave_red_max(bm); }
            T = Tc; done = true;
        }
    }
    if (!done && (unsigned)m > KMAX) {
#pragma unroll 1
        for (int it = 0; it < 40; ++it) {
            const unsigned mid = lo + ((hi - lo) >> 1);
            unsigned cl = 0u;
            cl = lane_count_ge(o, mid);
            const unsigned c = (unsigned)__builtin_amdgcn_readlane((int)wave_scan_add(cl), 63);
            if (c > KMAX) lo = mid; else if (c < KTH) hi = mid; else { T = mid; break; }
            if (hi - lo <= 1u) { T = lo; break; }
        }
    }
    if (MODE == 2) {
        if (lane == 0) { *cntp = 0u; const unsigned cb = (T & 0x80000000u) ? (T & 0x7FFFE000u) : ((T ^ 0xFFFFE000u) | 0x1FFFu); *thrp = __builtin_bit_cast(float, cb); }
    } else if (MODE == 0) {
        unsigned fm = 0u;
#pragma unroll
        for (int j = 0; j < 16; ++j) asm volatile("v_cmp_le_u32 vcc, %1, %2\n\tv_addc_co_u32 %0, vcc, %0, %0, vcc" : "+v"(fm) : "s"(T), "v"(o[j]) : "vcc");
        const unsigned kc = (unsigned)__popc(fm), incl = wave_scan_add(kc), base = (unsigned)__builtin_amdgcn_readlane((int)incl, 63);
        unsigned pos = incl - kc; LAS unsigned* const dumpw = H + lane;
        { unsigned mk = fm << 16; const unsigned cb_ = (unsigned)(size_t)cand, db_ = (unsigned)(size_t)dumpw;
#pragma unroll
          for (int j = 0; j < 16; ++j) { const unsigned a = append_step(mk, pos, cb_ + ((pos ^ (unsigned)qx) << 2), db_); *(LAS unsigned*)(size_t)a = e[j]; } }
        if (lane == 0) { *cntp = base; const unsigned cb = (T & 0x80000000u) ? (T & 0x7FFFE000u) : ((T ^ 0xFFFFE000u) | 0x1FFFu); *thrp = __builtin_bit_cast(float, cb); }
    } else {
        LAS unsigned* BM = H;
        *(LAS v4u*)(BM + 4 * lane) = (v4u){0u, 0u, 0u, 0u};
#pragma unroll
        for (int j = 0; j < 16; ++j) { const bool f = o[j] >= T; const unsigned key = 8191u - (e[j] & 0x1FFFu);
            if (f) __hip_atomic_fetch_or(&BM[key >> 5], 1u << (key & 31u), __ATOMIC_RELAXED, __HIP_MEMORY_SCOPE_WAVEFRONT); }
        const v4u w4 = *(LAS v4u*)(BM + 4 * lane);
        const unsigned tot = __popc(w4.x) + __popc(w4.y) + __popc(w4.z) + __popc(w4.w);
        unsigned pos = wave_scan_add(tot) - tot;
        LAS unsigned short* st = (LAS unsigned short*)H;
#pragma unroll 1
        for (int k = 0; k < 4; ++k) { unsigned ww = (k == 0) ? w4.x : (k == 1) ? w4.y : (k == 2) ? w4.z : w4.w;
            while (ww) { const unsigned bit = (unsigned)__builtin_ctz(ww); ww &= ww - 1u; st[pos] = (unsigned short)(128u * lane + 32u * k + bit); ++pos; } }
        *((unsigned long long*)selq + lane) = *((LAS unsigned long long*)st + lane);
    }
}

__device__ __forceinline__ void lds_barrier() { asm volatile("s_waitcnt lgkmcnt(0)\n\ts_barrier" ::: "memory"); }
__device__ __forceinline__ int attn_unit_of(const Frame& F, int ui) {
    if (F.G == 256) { const int b = F.vcu >> 6, j = F.vcu & 63; const int qt = (ui == 0) ? j : (ui == 1) ? 127 - j : (ui == 2) ? 128 + j : 255 - j; return 4 * qt + b; }
    const int u = F.vcu + ui * F.G; return u < 1024 ? u : -1;
}
__device__ __forceinline__ void idx_tile(const bf16x8v (&Ak)[4], const bf16x8v (&Bq)[4][4], const float (&lo)[4], const float (&hi)[4], const int t, const int h2, const float thr_r,
                                         LAS unsigned* cntq, LAS unsigned* myc, LAS unsigned* dump, const unsigned qx) {
    float sc[16];
#pragma unroll
    for (int hd = 0; hd < 4; ++hd) { f32x16 acc;
#pragma unroll
        for (int i = 0; i < 16; ++i) acc[i] = 0.f;
#pragma unroll
        for (int kk = 0; kk < 4; ++kk) acc = __builtin_amdgcn_mfma_f32_32x32x16_bf16(Ak[kk], Bq[hd][kk], acc, 0, 0, 0);
#pragma unroll
        for (int i = 0; i < 16; ++i) { const float mclamp = __builtin_amdgcn_fmed3f(acc[i], lo[hd], hi[hd]); sc[i] = (hd == 0) ? mclamp : sc[i] + mclamp; } }
    const unsigned Bt = (unsigned)(8191 - 32 * t) ^ (unsigned)(4 * h2);
    unsigned c[16]; unsigned pm = 0u;
#pragma unroll
    for (int i = 0; i < 16; ++i) { const unsigned rowc = (unsigned)((i & 3) + 8 * (i >> 2));
        c[i] = (__builtin_bit_cast(unsigned, sc[i]) & 0xFFFFE000u) | (Bt ^ rowc);
        asm volatile("v_cmp_le_f32 vcc, %1, %2\n\tv_addc_co_u32 %0, vcc, %0, %0, vcc" : "+v"(pm) : "v"(thr_r), "v"(c[i]) : "vcc"); }
    if (pm) {
        unsigned slot = __hip_atomic_fetch_add(cntq, (unsigned)__popc(pm), __ATOMIC_RELAXED, __HIP_MEMORY_SCOPE_WORKGROUP);
        { unsigned mk = pm << 16; const unsigned mycb = (unsigned)(size_t)myc, dumpb = (unsigned)(size_t)dump;
#pragma unroll
          for (int i = 0; i < 16; ++i) { const unsigned a = append_step(mk, slot, mycb + ((slot ^ qx) << 2), dumpb); *(LAS unsigned*)(size_t)a = c[i]; } }
    }
}
template <int MODE> __device__ __forceinline__ void attn_index_phase(Frame& F, const int ui, const bf16* QI, const bf16* KI, const float* WI, unsigned short* SEL, const int safe = 0) {
    const int tid = F.tid, lane = F.lane, wave = F.wave;
    LAS unsigned* const cand = (LAS unsigned*)F.lds;
    LAS unsigned* const cnt = (LAS unsigned*)(F.lds + A_CNT);
    LAS float* const thr = (LAS float*)(F.lds + A_THR);
    LAS unsigned* const H = (LAS unsigned*)(F.lds + A_HIST) + wave * 256;
    const int r32 = lane & 31, h2 = lane >> 5;
    {
        const int u = attn_unit_of(F, ui); if (u < 0) return;
        const int b = u & 3, qt = u >> 2, t0 = qt * AQ, q0 = b * SEQ + t0, n = ((t0 >> 6) + 1) << 6;
        unsigned short* const sel = SEL + (size_t)q0 * 256;
        if (n <= TOPK) { if (MODE == 1 && tid == 0) *(LAS unsigned*)(F.lds + A_OK) = 1u; return; }
        if constexpr (MODE == 0) {
        if (tid < AQ) { cnt[tid] = 0u; thr[tid] = -__builtin_inff(); }
        __syncthreads();
        {
            bf16x8v Bq[4][4]; float lo[4], hi[4];
            { const f32x4 wv = *(const f32x4*)(WI + (size_t)(q0 + r32) * 4);
#pragma unroll
              for (int hd = 0; hd < 4; ++hd) { const float w = wv[hd]; lo[hd] = (w >= 0.f) ? 0.f : -__builtin_inff(); hi[hd] = (w >= 0.f) ? __builtin_inff() : 0.f;
#pragma unroll
                  for (int kk = 0; kk < 4; ++kk) { const v4u qv = *(const v4u*)(QI + (size_t)q0 * 256 + (size_t)(((hd * 8 + 2 * kk + h2) * 32 + r32) * 8));
                      v4u o; o.x = pk2(bflo(qv.x) * w, bfhi(qv.x) * w); o.y = pk2(bflo(qv.y) * w, bfhi(qv.y) * w); o.z = pk2(bflo(qv.z) * w, bfhi(qv.z) * w); o.w = pk2(bflo(qv.w) * w, bfhi(qv.w) * w);
                      Bq[hd][kk] = __builtin_bit_cast(bf16x8v, o); } } }
            const int ntile = n >> 5, nround = (ntile + 7) >> 3;
            const bf16* kib = KI + (size_t)b * SEQ * 64 + (size_t)((h2 * 32 + r32) * 8);
            float thr_r = -__builtin_inff();
            bool first = true; unsigned kspec = (unsigned)(SPEC_NUM * 1024) / (unsigned)n; kspec = (safe || kspec > (unsigned)TOPK) ? (unsigned)TOPK : (kspec < 32u ? 32u : kspec);
            LAS unsigned* const myc = cand + r32 * ACAP;
            LAS unsigned* const dump = (LAS unsigned*)(F.lds + A_DUMP) + tid;
            bf16x8v Ak[4];
            { const int t = wave; if (t < ntile) {
#pragma unroll
                for (int kk = 0; kk < 4; ++kk) Ak[kk] = *(const bf16x8v*)(kib + (size_t)t * 32 * 64 + 512 * kk); } }
            bf16x8v An[4];
#pragma unroll
            for (int kk = 0; kk < 4; ++kk) An[kk] = Ak[kk];
#pragma unroll 1
            for (int rd = 0; rd < nround; ++rd) {
                const int t = 8 * rd + wave;
                if (t < ntile) {
#pragma unroll
                    for (int kk = 0; kk < 4; ++kk) Ak[kk] = An[kk];
                    const int tn = t + 8;
                    if (tn < ntile) {
#pragma unroll
                        for (int kk = 0; kk < 4; ++kk) An[kk] = *(const bf16x8v*)(kib + (size_t)tn * 32 * 64 + 512 * kk); }
                    idx_tile(Ak, Bq, lo, hi, t, h2, thr_r, cnt + r32, myc, dump, (unsigned)r32);
                    if (PROBE_DUP == 11) idx_tile(Ak, Bq, lo, hi, t, h2, __builtin_inff(), cnt + r32, myc, dump, (unsigned)r32);
                }
                lds_barrier();
                if (PROBE_DUP == 10) { lds_barrier(); lds_barrier(); }
                const unsigned cq = (lane < AQ) ? cnt[lane] : 0u;
                const unsigned need = (unsigned)__ballot(cq > (unsigned)ATRIG), comp = (unsigned)__ballot(cq > 448u);
                lds_barrier();
                if (DEBUG_STAT == 9 && need && tid == 0) atomicAdd((unsigned*)(F.ws + WS_CTL) + 32768 + 8, 1u);
                if (need) {
                    const unsigned kth = first ? kspec : (unsigned)TOPK, kmax = kth + (kth >> 1);
#pragma unroll 1
                    for (int q = wave; q < AQ; q += 8) if ((comp >> q) & 1u) { if (DEBUG_STAT == 8 && lane == 0) atomicAdd((unsigned*)(F.ws + WS_CTL) + 32768 + 7, 1u); wave_select<0, TOPK>(cand + q * ACAP, cnt + q, thr + q, H, sel + q * 256, lane, q, kth, kmax); }
                    lds_barrier();
                    first = false;
                }
                thr_r = thr[r32];
            }
        }
        } else {
            { const unsigned cq = (lane < AQ) ? cnt[lane] : (unsigned)TOPK; const bool bad = __ballot(cq < (unsigned)TOPK) != 0ull;
              if (tid == 0) *(LAS unsigned*)(F.lds + A_OK) = bad ? 0u : 1u;
              if (bad) return; }
#pragma unroll 1
            for (int q = wave; q < AQ; q += 8) wave_select<1, TOPK>(cand + q * ACAP, cnt + q, thr + q, H, sel + q * 256, lane, q);
            __syncthreads();
        }
    }
}
__device__ __forceinline__ void attn_gather_phase(Frame& F, const bf16* Q, const bf16* KB, const bf16* VB, const unsigned short* SEL, const float* again, bf16* MIX) {
    const int lane = F.lane, wave = F.wave;
    const int hd = lane & 15, kq = lane >> 4;
    LAS unsigned char* const vb = F.lds + wave * (64 * V_RS);
    LAS unsigned short* const sq = (LAS unsigned short*)(F.lds + 8 * 64 * V_RS) + wave * 256;
    LAS unsigned char* const kb = vb;
#pragma unroll 1
    for (int ui = 0; ui < 4; ++ui) {
        const int u = attn_unit_of(F, ui); if (u < 0) break;
        const int b = u & 3, qt = u >> 2, t0 = qt * AQ, q0 = b * SEQ + t0, n = ((t0 >> 6) + 1) << 6;
        const int nsel = n < TOPK ? n : TOPK, nchunk = nsel >> 6;
        const bf16* const kbat = KB + (size_t)b * SEQ * 64; const bf16* const vbat = VB + (size_t)b * SEQ * 64;
#pragma unroll 1
        for (int qq = wave; qq < AQ; qq += 8) {
            const int r = q0 + qq;
            if (n > TOPK) { const unsigned long long iv = *((const unsigned long long*)(SEL + (size_t)r * 256) + lane); *((LAS unsigned long long*)sq + lane) = iv; }
            else { const unsigned i0 = 4u * lane; *((LAS unsigned long long*)sq + lane) = (unsigned long long)(i0 | ((i0 + 1u) << 16)) | ((unsigned long long)((i0 + 2u) | ((i0 + 3u) << 16)) << 32); }
            asm volatile("s_waitcnt lgkmcnt(0)" ::: "memory");
            bf16x8v bq0, bq1;
            { v4u z = (v4u){0u, 0u, 0u, 0u}; const v4u a0 = (hd < 8) ? *(const v4u*)(Q + (size_t)r * ATTN_W + hd * 64 + 8 * kq) : z, a1 = (hd < 8) ? *(const v4u*)(Q + (size_t)r * ATTN_W + hd * 64 + 32 + 8 * kq) : z;
              bq0 = __builtin_bit_cast(bf16x8v, a0); bq1 = __builtin_bit_cast(bf16x8v, a1); }
            f32x4 lg[16];
#pragma unroll
            for (int hb2 = 0; hb2 < 2; ++hb2) {
                v4u kk[2][8];
#pragma unroll
                for (int c2 = 0; c2 < 2; ++c2) { const int c = 2 * hb2 + c2; if (c < nchunk) {
#pragma unroll
                    for (int jj = 0; jj < 8; ++jj) { const unsigned off = (unsigned)sq[64 * c + (lane >> 3) + 8 * jj] * 128u + 16u * (lane & 7); kk[c2][jj] = *(const v4u*)((const char*)kbat + off); } } }
#pragma unroll
                for (int c2 = 0; c2 < 2; ++c2) { const int c = 2 * hb2 + c2;
                    if (c < nchunk) {
#pragma unroll
                        for (int jj = 0; jj < 8; ++jj) *(LAS v4u*)(kb + ((lane >> 3) + 8 * jj) * V_RS + (lane & 7) * 16) = kk[c2][jj];
                        asm volatile("s_waitcnt lgkmcnt(0)" ::: "memory");
#pragma unroll
                        for (int g = 0; g < 4; ++g) { const bf16x8v k0 = *(const LAS bf16x8v*)(kb + (16 * g + hd) * V_RS + 16 * kq), k1 = *(const LAS bf16x8v*)(kb + (16 * g + hd) * V_RS + 64 + 16 * kq);
                            f32x4 a = (f32x4){0.f, 0.f, 0.f, 0.f}; a = __builtin_amdgcn_mfma_f32_16x16x32_bf16(k0, bq0, a, 0, 0, 0); a = __builtin_amdgcn_mfma_f32_16x16x32_bf16(k1, bq1, a, 0, 0, 0); lg[4 * c + g] = a; }
                        asm volatile("s_waitcnt lgkmcnt(0)" ::: "memory");
                    } else {
                        const float ni = -__builtin_inff();
#pragma unroll
                        for (int g = 0; g < 4; ++g) lg[4 * c + g] = (f32x4){ni, ni, ni, ni};
                    }
                }
            }
            float mxv = -__builtin_inff();
#pragma unroll
            for (int g = 0; g < 16; ++g) { mxv = __builtin_fmaxf(__builtin_fmaxf(mxv, lg[g][0]), lg[g][1]); mxv = __builtin_fmaxf(__builtin_fmaxf(mxv, lg[g][2]), lg[g][3]); }
            mxv = fmaxf(mxv, __shfl_xor(mxv, 16)); mxv = fmaxf(mxv, __shfl_xor(mxv, 32));
            float sum = 0.f; bf16x8v pb[8];
#pragma unroll
            for (int ks = 0; ks < 8; ++ks) { float p[8];
#pragma unroll
                for (int e = 0; e < 4; ++e) { p[e] = __builtin_amdgcn_exp2f(lg[2 * ks][e] - mxv); p[4 + e] = __builtin_amdgcn_exp2f(lg[2 * ks + 1][e] - mxv); }
#pragma unroll
                for (int e = 0; e < 8; ++e) sum += p[e];
                v4u o; o.x = pk2(p[0], p[1]); o.y = pk2(p[2], p[3]); o.z = pk2(p[4], p[5]); o.w = pk2(p[6], p[7]); pb[ks] = __builtin_bit_cast(bf16x8v, o); }
            sum += __shfl_xor(sum, 16); sum += __shfl_xor(sum, 32);
            asm volatile("" ::: "memory");
            f32x4 O[4];
#pragma unroll
            for (int mt = 0; mt < 4; ++mt) O[mt] = (f32x4){0.f, 0.f, 0.f, 0.f};
#pragma unroll
            for (int hb2 = 0; hb2 < 2; ++hb2) {
                v4u vv[2][8];
#pragma unroll
                for (int c2 = 0; c2 < 2; ++c2) { const int c = 2 * hb2 + c2; if (c < nchunk) {
#pragma unroll
                    for (int j = 0; j < 8; ++j) { const unsigned off = (unsigned)sq[64 * c + (lane >> 3) + 8 * j] * 128u + 16u * (lane & 7); vv[c2][j] = *(const v4u*)((const char*)vbat + off); } } }
#pragma unroll
                for (int c2 = 0; c2 < 2; ++c2) { const int c = 2 * hb2 + c2;
                    if (c < nchunk) {
#pragma unroll
                        for (int j = 0; j < 8; ++j) *(LAS v4u*)(vb + ((lane >> 3) + 8 * j) * V_RS + (lane & 7) * 16) = vv[c2][j];
                        asm volatile("s_waitcnt lgkmcnt(0)" ::: "memory");
#pragma unroll
                        for (int ksl = 0; ksl < 2; ++ksl) {
                            const int rowa = 32 * ksl + 4 * kq + (hd >> 2);
#pragma unroll
                            for (int mt = 0; mt < 4; ++mt) {
                                const v4i16_t alo = __builtin_amdgcn_ds_read_tr16_b64_v4i16((LAS v4i16_t*)(vb + rowa * V_RS + (16 * mt + 4 * (hd & 3)) * 2));
                                const v4i16_t ahi = __builtin_amdgcn_ds_read_tr16_b64_v4i16((LAS v4i16_t*)(vb + (rowa + 16) * V_RS + (16 * mt + 4 * (hd & 3)) * 2));
                                bf16x8v A; A[0] = alo[0]; A[1] = alo[1]; A[2] = alo[2]; A[3] = alo[3]; A[4] = ahi[0]; A[5] = ahi[1]; A[6] = ahi[2]; A[7] = ahi[3];
                                O[mt] = __builtin_amdgcn_mfma_f32_16x16x32_bf16(A, pb[2 * c + ksl], O[mt], 0, 0, 0);
                            }
                        }
                        asm volatile("s_waitcnt lgkmcnt(0)" ::: "memory");
                    }
                }
            }
            const float inv = 1.0f / sum; float ss = 0.f;
#pragma unroll
            for (int mt = 0; mt < 4; ++mt) { O[mt] = O[mt] * inv; ss += (O[mt][0] * O[mt][0] + O[mt][1] * O[mt][1]) + (O[mt][2] * O[mt][2] + O[mt][3] * O[mt][3]); }
            ss = wave_sum((hd < 8) ? ss : 0.f);
            const float rs = __builtin_amdgcn_rsqf(ss * (1.f / ATTN_W) + EPS);
            if (hd < 8) {
#pragma unroll
                for (int mt = 0; mt < 4; ++mt) { const int col = hd * 64 + 16 * mt + 4 * kq; const f32x4 gn = *(const f32x4*)(again + col); const f32x4 y = O[mt] * rs * gn;
                    *(unsigned long long*)(MIX + (size_t)r * DM + col) = (unsigned long long)pk2(y[0], y[1]) | ((unsigned long long)pk2(y[2], y[3]) << 32); }
            }
        }
    }
}

constexpr int PH_PER_LAYER = 15, N_PHASES = 2 + DEPTH * PH_PER_LAYER;
#define NOINL __attribute__((noinline, not_tail_called))
typedef LAS unsigned char* ldsp_t;
__device__ __forceinline__ Frame make_frame(ldsp_t lds, const CArgs* A) {
    const unsigned ldsw = (unsigned)(size_t)lds;
    Frame F; F.lds = (ldsp_t)(size_t)(ldsw & 0xFFFFFFu); F.ws = A->ws; F.wave = __builtin_amdgcn_readfirstlane((int)(ldsw >> 24)); F.lane = (int)__builtin_amdgcn_mbcnt_hi(~0u, __builtin_amdgcn_mbcnt_lo(~0u, 0u)); F.tid = (int)(ldsw >> 24) * 64 + F.lane;
    __builtin_assume(F.lane >= 0 && F.lane < 64); __builtin_assume(F.wave >= 0 && F.wave < 8); __builtin_assume(F.tid >= 0 && F.tid < 512);
    F.G = gridDim.x; { const int bx = blockIdx.x; F.vcu = (F.G % 8 == 0) ? (bx % 8) * (F.G / 8) + bx / 8 : bx; }
    return F;
}
__device__ NOINL void ph_grid_bar(const CArgs* A0, ldsp_t lds_w) { const CArgs* A = karg(A0); const unsigned ldsw = (unsigned)__builtin_amdgcn_readfirstlane((int)(unsigned)(size_t)lds_w); const ldsp_t lds = (ldsp_t)(size_t)(ldsw & 0xFFFFFFu);
    const bool t0 = (ldsw >> 24) == 0u && __builtin_amdgcn_mbcnt_hi(~0u, __builtin_amdgcn_mbcnt_lo(~0u, 0u)) == 0u; XcdBarrier b; b.bar = (unsigned*)(A->ws + WS_CTL) + CW_BAR; b.x = xb_xcc_id(); b.st = (volatile LAS unsigned*)(lds + MISC_OFF) + 8; xcd_barrier(b, t0); }
__device__ NOINL void ph_pro_ssm(const CArgs* A0, ldsp_t lds) { const CArgs* A = karg(A0); Frame F = make_frame(lds, A); pro_ssm(A, F); }
__device__ NOINL void ph_pro_mod(const CArgs* A0, ldsp_t lds) { const CArgs* A = karg(A0); Frame F = make_frame(lds, A); pro_mod(A, F); }
__device__ NOINL void ph_pro_wt(const CArgs* A0, ldsp_t lds) { const CArgs* A = karg(A0); Frame F = make_frame(lds, A); pro_wt(A, F); }
__device__ NOINL void ph_pro_rope(const CArgs* A0, ldsp_t lds) { const CArgs* A = karg(A0); Frame F = make_frame(lds, A); pro_rope(A, F); }
__device__ NOINL void ph_norm(const CArgs* A0, ldsp_t lds, int l, int which, int first) { l = __builtin_amdgcn_readfirstlane(l); which = __builtin_amdgcn_readfirstlane(which); first = __builtin_amdgcn_readfirstlane(first); const CArgs* A = karg(A0); Frame F = make_frame(lds, A); unsigned char* ws = A->ws;
    const float* g = (const float*)A->in[5] + (size_t)(l * 3 + which) * DM; const float* modl = (const float*)(ws + WS_MOD) + (size_t)l * NB * NMOD * DM; bf16* XB = (bf16*)(ws + WS_XB);
    if (first) norm_mod_phase<true, false>(F, A->in[0], g, modl, 3 * which, (bf16*)(ws + WS_H), XB);
    else if (which == 1) norm_mod_phase<false, true>(F, XB, g, modl, 3 * which, (bf16*)(ws + WS_H), XB);
    else norm_mod_phase<true, true>(F, XB, g, modl, 3 * which, (bf16*)(ws + WS_H), XB); }
__device__ NOINL void ph_ffn_up(const CArgs* A0, ldsp_t lds, int l, int f) { l = __builtin_amdgcn_readfirstlane(l); f = __builtin_amdgcn_readfirstlane(f); const CArgs* A = karg(A0); unsigned char* ws = A->ws;
    typedef pg8::GemmF8<DM, DM, DM / 128, 124> GP; typedef pg8::StaticOrder<MTOK / 256, NFF1 / 256> SO; GP g{ws + WS_H, ws + WS_W13 + (size_t)(l * 2 + f) * NFF1 * DM}; SO S; S.init(gridDim.x, (int)blockIdx.x);
    EpiSwiGLU E{ws + WS_R}; pg8::gemm_phase<GP, EpiSwiGLU, SO, FFN_ALIGN, FFN_SP2>(lds, g, S, E); }
#if PROBE_DUP >= 13 && PROBE_DUP <= 16
__device__ NOINL void ph_ffn_up_p(const CArgs* A0, ldsp_t lds, int l, int f) { l = __builtin_amdgcn_readfirstlane(l); f = __builtin_amdgcn_readfirstlane(f); const CArgs* A = karg(A0); unsigned char* ws = A->ws;
    typedef pg8::GemmF8<DM, DM, DM / 128, 124, 0, 0, PROBE_DUP - 13> GP; typedef pg8::StaticOrder<MTOK / 256, NFF1 / 256> SO; GP g{ws + WS_H, ws + WS_W13 + (size_t)(l * 2 + f) * NFF1 * DM}; SO S; S.init(gridDim.x, (int)blockIdx.x);
    EpiSwiGLU E{ws + WS_R + 96 * MiB}; pg8::gemm_phase<GP, EpiSwiGLU, SO, FFN_ALIGN, FFN_SP2>(lds, g, S, E); }
#endif
__device__ NOINL void ph_ffn_down(const CArgs* A0, ldsp_t lds, int l, int f, int first) { l = __builtin_amdgcn_readfirstlane(l); f = __builtin_amdgcn_readfirstlane(f); first = __builtin_amdgcn_readfirstlane(first); const CArgs* A = karg(A0); unsigned char* ws = A->ws;
    typedef pg8::GemmF8<DFF, DFF, DFF / 128, 124> GP; typedef pg8::StaticOrder<MTOK / 256, DM / 256> SO; GP g{ws + WS_R, ws + WS_W2 + (size_t)(l * 2 + f) * DM * DFF}; SO S; S.init(gridDim.x, (int)blockIdx.x);
    EpiResid E{(const bf16*)(ws + WS_XB), (bf16*)(ws + WS_XB), (const float*)(ws + WS_MOD) + (size_t)l * NB * NMOD * DM + (2 + 6 * f) * DM, 0.5f}; pg8::gemm_phase<GP, EpiResid, SO, true, true>(lds, g, S, E); }
__device__ NOINL void ph_win(const CArgs* A0, ldsp_t lds, int l) { const CArgs* A = karg(A0); unsigned char* ws = A->ws;
    typedef pg8::GemmRM<DM, DM, DM / 64> GP; typedef pg8::StaticOrder<MTOK / 256, NWIN / 256> SO; GP g{(const bf16*)(ws + WS_H), (const bf16*)(ws + WS_WIN) + (size_t)l * NWIN * DM}; SO S; S.init(gridDim.x, (int)blockIdx.x);
    EpiWin E{ws}; pg8::gemm_phase<GP, EpiWin, SO, true, true>(lds, g, S, E); }
#if ATTN_FAST
__device__ NOINL void ph_attn_a(const CArgs* A0, ldsp_t lds, int ui, int safe) { ui = __builtin_amdgcn_readfirstlane(ui); safe = __builtin_amdgcn_readfirstlane(safe); const CArgs* A = karg(A0); Frame F = make_frame(lds, A); unsigned char* ws = A->ws;
    attn_index_phase<0>(F, ui, (const bf16*)(ws + R_QI), (const bf16*)(ws + R_KI), (const float*)(ws + R_WI), (unsigned short*)(ws + R_SEL), safe); }
__device__ NOINL void ph_attn_b(const CArgs* A0, ldsp_t lds, int ui) { ui = __builtin_amdgcn_readfirstlane(ui); const CArgs* A = karg(A0); Frame F = make_frame(lds, A); unsigned char* ws = A->ws;
    attn_index_phase<1>(F, ui, (const bf16*)(ws + R_QI), (const bf16*)(ws + R_KI), (const float*)(ws + R_WI), (unsigned short*)(ws + R_SEL));
    asm volatile("s_waitcnt vmcnt(0)" ::: "memory"); __syncthreads(); }
#else
__device__ NOINL void ph_attn(const CArgs* A0, ldsp_t lds, int l) { l = __builtin_amdgcn_readfirstlane(l); const CArgs* A = karg(A0); Frame F = make_frame(lds, A); unsigned char* ws = A->ws;
    attn_simple_phase(F, (const bf16*)(ws + R_Q), (const bf16*)(ws + R_KB), (const bf16*)(ws + R_VB), (const bf16*)(ws + R_QI), (const bf16*)(ws + R_KI), (const float*)(ws + R_WI), (const float*)A->in[14] + (size_t)l * ATTN_W, (bf16*)(ws + WS_H)); }
#endif
__device__ NOINL void ph_attn2(const CArgs* A0, ldsp_t lds, int l) { l = __builtin_amdgcn_readfirstlane(l); const CArgs* A = karg(A0); Frame F = make_frame(lds, A); unsigned char* ws = A->ws;
    attn_gather_phase(F, (const bf16*)(ws + R_Q), (const bf16*)(ws + R_KB), (const bf16*)(ws + R_VB), (const unsigned short*)(ws + R_SEL), (const float*)A->in[14] + (size_t)l * ATTN_W, (bf16*)(ws + WS_H)); }
__device__ NOINL void ph_ssm_state(const CArgs* A0, ldsp_t lds, int l) { l = __builtin_amdgcn_readfirstlane(l); const CArgs* A = karg(A0); unsigned char* ws = A->ws;
    typedef pg8::GemmSsm<KSS, KT, KT / 64, 128> GP; typedef pg8::StaticOrder<SG * NCHK / 256, 1> SO; GP g{(const bf16*)(ws + R_UG), (const bf16*)(ws + WS_BW) + (size_t)l * SG * 128 * KT}; SO S; S.init(gridDim.x, (int)blockIdx.x);
    EpiSsmState E{(float*)(ws + R_SINC)}; pg8::gemm_phase<GP, EpiSsmState, SO, true, true>(lds, g, S, E); }
__device__ NOINL void ph_ssm_scan(const CArgs* A0, ldsp_t lds, int l) { l = __builtin_amdgcn_readfirstlane(l); const CArgs* A = karg(A0); Frame F = make_frame(lds, A); unsigned char* ws = A->ws;
    ssm_scan_phase(F, (const float*)(ws + WS_AL) + (size_t)l * SG * SP * 2, (const float*)(ws + R_SINC), (bf16*)(ws + R_UG)); }
__device__ NOINL void ph_ssm_out(const CArgs* A0, ldsp_t lds, int l) { l = __builtin_amdgcn_readfirstlane(l); const CArgs* A = karg(A0); unsigned char* ws = A->ws;
    typedef pg8::GemmSsm<KSS, KSS, KSS / 64, KT> GP; typedef pg8::StaticOrder<SG * NCHK / 256, KT / 256> SO; GP g{(const bf16*)(ws + R_UG), (const bf16*)(ws + WS_BTV) + (size_t)l * SG * KT * KSS}; SO S; S.init(gridDim.x, (int)blockIdx.x);
    EpiSsmOut E{(bf16*)(ws + R_YG)}; pg8::gemm_phase<GP, EpiSsmOut, SO, true, true>(lds, g, S, E); }
__device__ NOINL void ph_glu(const CArgs* A0, ldsp_t lds, int l) { l = __builtin_amdgcn_readfirstlane(l); const CArgs* A = karg(A0); unsigned char* ws = A->ws;
    pg8::GemmGlu g{(const bf16*)(ws + R_YG), (const bf16*)(ws + WS_GLU) + (size_t)l * SSM_W * SSM_W}; typedef pg8::StaticOrder<MTOK / 256, SSM_W / 256> SO; SO S; S.init(gridDim.x, (int)blockIdx.x);
    EpiGlu E{(const bf16*)(ws + R_YG), (bf16*)(ws + R_Y2), (const float*)A->in[25] + (size_t)l * SSM_W}; pg8::gemm_phase<pg8::GemmGlu, EpiGlu, SO, true, true>(lds, g, S, E); }
__device__ NOINL void ph_ssm_norm(const CArgs* A0, ldsp_t lds, int l) { l = __builtin_amdgcn_readfirstlane(l); const CArgs* A = karg(A0); Frame F = make_frame(lds, A); unsigned char* ws = A->ws;
    ssm_norm_phase(F, (const bf16*)(ws + R_Y2), (const float*)A->in[15] + (size_t)l * SSM_W, (bf16*)(ws + WS_H)); }
__device__ NOINL void ph_wout(const CArgs* A0, ldsp_t lds, int l) { l = __builtin_amdgcn_readfirstlane(l); const CArgs* A = karg(A0); unsigned char* ws = A->ws;
    typedef pg8::GemmRM<DM, DM, DM / 64> GP; typedef pg8::StaticOrder<MTOK / 256, DM / 256> SO; GP g{(const bf16*)(ws + WS_H), (const bf16*)(ws + WS_WOUT) + (size_t)l * DM * DM}; SO S; S.init(gridDim.x, (int)blockIdx.x);
    EpiResid E{(const bf16*)(ws + WS_XB), (bf16*)(ws + WS_XB), (const float*)(ws + WS_MOD) + (size_t)l * NB * NMOD * DM + 5 * DM, 1.0f}; pg8::gemm_phase<GP, EpiResid, SO, true, true>(lds, g, S, E); }
__device__ NOINL void ph_final(const CArgs* A0, ldsp_t lds) { const CArgs* A = karg(A0); Frame F = make_frame(lds, A); final_norm_phase(F, (const bf16*)(F.ws + WS_XB), (const float*)A->in[26], A->out);
#if DEBUG_STAT
    { const unsigned* ctr = (const unsigned*)(F.ws + WS_CTL) + 32768; const float den = (DEBUG_STAT == 8) ? 131072.0f : (DEBUG_STAT == 9) ? 4096.0f : 1.0f;
      const float k = 1.0f + (float)ctr[DEBUG_STAT - 1] / den;
      asm volatile("s_waitcnt vmcnt(0)" ::: "memory"); __syncthreads();
      const int gw = F.vcu * 8 + F.wave, NGW = F.G * 8;
      for (int r = gw; r < MTOK; r += NGW) { f32x4* o = (f32x4*)(A->out + (size_t)r * DM) + F.lane; for (int j = 0; j < 4; ++j) o[64 * j] = o[64 * j] * k; } }
#endif
}

__global__ void __launch_bounds__(512, 2) fwd(Args args) {
    extern __shared__ __attribute__((aligned(16))) unsigned char lds_raw[];
    const ldsp_t lds = (ldsp_t)lds_raw;
    const CArgs* const KA = (const CArgs*)__builtin_amdgcn_kernarg_segment_ptr();
    for (int u = threadIdx.x; u < (LDS_BYTES - LDSCTL_OFF) / 4; u += 512) ((LAS unsigned*)(lds + LDSCTL_OFF))[u] = 0u;
    __syncthreads();
    const int lo = args.ph_lo, hi = args.ph_hi;
    if (hi - lo > 1) (void)xcd_barrier_post((unsigned*)(args.ws + WS_CTL) + CW_BAR, (volatile LAS unsigned*)(lds + MISC_OFF) + 8);
    const ldsp_t lw = (ldsp_t)(size_t)((unsigned)(size_t)lds | ((unsigned)__builtin_amdgcn_readfirstlane((int)threadIdx.x >> 6) << 24));
#define IN(k) (lo <= (k) && (k) < hi)
#define SEAM(k) do { if (IN(k) && IN((k) + 1)) ph_grid_bar(KA, lw); } while (0)
    if (IN(0)) { for (int rep = 0; rep < (PROBE_DUP == 7 ? 2 : 1); ++rep) { ph_pro_ssm(KA, lw); ph_pro_mod(KA, lw); ph_pro_wt(KA, lw); ph_pro_rope(KA, lw); __syncthreads(); } }
    SEAM(0);
    for (int sl = 0; sl < 3 * DEPTH; ++sl) {
        const int l = sl / 3, ty = sl - 3 * l, f = ty >> 1;
        if (ty != 1) {
            const int pf = 1 + l * PH_PER_LAYER + (f ? 12 : 0);
            if (IN(pf)) { ph_norm(KA, lw, l, 2 * f, sl == 0); if (PROBE_DUP == 6) ph_norm(KA, lw, l, 2 * f, sl == 0); }
            SEAM(pf);
            if (IN(pf + 1)) { ph_ffn_up(KA, lw, l, f); if (PROBE_DUP == 3) ph_ffn_up(KA, lw, l, f);
#if PROBE_DUP >= 13 && PROBE_DUP <= 16
                ph_ffn_up_p(KA, lw, l, f);
#endif
            }
            SEAM(pf + 1);
            if (IN(pf + 2)) ph_ffn_down(KA, lw, l, f, sl == 0);
            SEAM(pf + 2);
        } else {
            const int p0 = 1 + l * PH_PER_LAYER;
            if (IN(p0 + 3)) { ph_norm(KA, lw, l, 1, 0); if (PROBE_DUP == 6) ph_norm(KA, lw, l, 1, 0); }
            SEAM(p0 + 3);
            if (IN(p0 + 4)) { ph_win(KA, lw, l); if (PROBE_DUP == 4) ph_win(KA, lw, l); }
            SEAM(p0 + 4);
#if ATTN_FAST
            if (IN(p0 + 5)) { for (int rep = 0; rep < (PROBE_DUP == 1 ? 2 : 1); ++rep) for (int ui = 0; ui < 4; ++ui) {
                                  ph_attn_a(KA, lw, ui, 0); if (PROBE_DUP == 12) ph_attn_a(KA, lw, ui, 0);
                                  ph_attn_b(KA, lw, ui);
                                  __syncthreads(); const unsigned okv = (unsigned)__builtin_amdgcn_readfirstlane((int)*(volatile LAS unsigned*)(lds + A_OK)); __syncthreads();
                                  if (!okv) { ph_attn_a(KA, lw, ui, 1); ph_attn_b(KA, lw, ui); }
                                  if (PROBE_DUP == 9) ph_attn_b(KA, lw, ui); }
                              for (int rep = 0; rep < (PROBE_DUP == 2 ? 2 : 1); ++rep) ph_attn2(KA, lw, l); }
#else
            if (IN(p0 + 5)) ph_attn(KA, lw, l);
#endif
            if (PROBE_DUP == 5) SEAM(p0 + 5); else __syncthreads();
            for (int rep = 0; rep < (PROBE_DUP == 5 ? 2 : 1); ++rep) {
            if (IN(p0 + 6)) ph_ssm_state(KA, lw, l);
            SEAM(p0 + 6);
            if (IN(p0 + 7)) ph_ssm_scan(KA, lw, l);
            SEAM(p0 + 7);
            if (IN(p0 + 8)) ph_ssm_out(KA, lw, l);
            SEAM(p0 + 8);
            if (IN(p0 + 9)) ph_glu(KA, lw, l);
            SEAM(p0 + 9);
            if (IN(p0 + 10)) ph_ssm_norm(KA, lw, l);
            SEAM(p0 + 10);
            }
            if (IN(p0 + 11)) ph_wout(KA, lw, l);
            SEAM(p0 + 11);
        }
    }
    if (IN(N_PHASES - 1)) ph_final(KA, lw);
#undef IN
#undef SEAM
}

extern "C" void kernel_launch(void* const* d_in, const int* in_sizes, int n_in, void* d_out, int out_size, void* d_ws, size_t ws_size, hipStream_t stream) {
    static int grid = 0;
    if (grid == 0) {
        if (n_in != 27 || in_sizes[0] != MTOK * DM || out_size != MTOK * DM || ws_size < WS_END) { fprintf(stderr, "kernel_launch: unexpected shapes (n_in %d, in0 %d, out %d, ws %zu < %zu)\n", n_in, n_in > 0 ? in_sizes[0] : -1, out_size, ws_size, (size_t)WS_END); grid = -1; return; }
        int dev = 0, cus = 0;
        if (hipGetDevice(&dev) != hipSuccess || hipDeviceGetAttribute(&cus, hipDeviceAttributeMultiprocessorCount, dev) != hipSuccess) { grid = -1; return; }
        if (hipFuncSetAttribute((const void*)fwd, hipFuncAttributeMaxDynamicSharedMemorySize, LDS_BYTES) != hipSuccess) { fprintf(stderr, "kernel_launch: hipFuncSetAttribute failed\n"); grid = -1; return; }
        int per_cu = 0;
        if (hipOccupancyMaxActiveBlocksPerMultiprocessor(&per_cu, (const void*)fwd, 512, LDS_BYTES) != hipSuccess || per_cu < 1) fprintf(stderr, "kernel_launch: occupancy query reports %d\n", per_cu);
        (void)hipGetLastError();
        grid = cus;
    }
    if (grid < 0) return;
    (void)hipMemsetAsync((char*)d_ws + WS_CTL, 0, CTL_ZERO_BYTES, stream);
    Args a{};
    for (int i = 0; i < 27; ++i) a.in[i] = d_in[i];
    a.out = (float*)d_out; a.ws = (unsigned char*)d_ws;
#if MK_ONE_LAUNCH
    a.ph_lo = 0; a.ph_hi = N_PHASES;
    hipLaunchKernelGGL(fwd, dim3(grid), dim3(512), LDS_BYTES, stream, a);
#else
    for (int p = 0; p < N_PHASES; ++p) { a.ph_lo = p; a.ph_hi = p + 1; hipLaunchKernelGGL(fwd, dim3(grid), dim3(512), LDS_BYTES, stream, a); }
#endif
}
```
